# Optimizing an MI355X kernel written in HIP

```python
import math
import jax, jax.numpy as jnp
from jax import lax
import numpy as np

D_MODEL = 2048
BATCH = 1
SEQ = 8192
DEPTH = 1

HEAD_DIM = 128
DIFF_HEADS = D_MODEL // 512
DIFF_V_DIM = 2 * HEAD_DIM
FOX_HEADS = D_MODEL // 256
Q_BLOCK = 128
ROPE_THETA = 10000.0
N_GROUPS = 4
EXPERTS_PER_GROUP = 8
N_EXPERTS = N_GROUPS * EXPERTS_PER_GROUP
TOP_K = 2
EXPERT_FF = D_MODEL // 4
MOE_BLOCK = 128
LN_EPS = 1e-5
DEEPNORM_ALPHA = (2 * DEPTH) ** 0.25
DEEPNORM_BETA = (8 * DEPTH) ** -0.25

DIFF_QK_COLS = DIFF_HEADS * 2 * HEAD_DIM
DIFF_V_COLS = DIFF_HEADS * DIFF_V_DIM
FOX_QK_COLS = FOX_HEADS * HEAD_DIM
FOX_V_COLS = FOX_HEADS * HEAD_DIM
GATE_COLS = 2 * D_MODEL
IN_SIZES = (DIFF_QK_COLS, DIFF_QK_COLS, DIFF_V_COLS, FOX_QK_COLS, FOX_QK_COLS, FOX_V_COLS, FOX_HEADS, GATE_COLS)
IN_COLS = sum(IN_SIZES)
IN_SPLITS = tuple(np.cumsum(IN_SIZES)[:-1].tolist())
VALUE_SEGMENTS = (2, 5)

kernel_name = "hybrid_diffattn_fox_hmoe_deepnorm"


def _layer_norm(x, g, b):
    xf = x.astype(jnp.float32)
    mu = jnp.mean(xf, -1, keepdims=True)
    var = jnp.mean(jnp.square(xf - mu), -1, keepdims=True)
    y = (xf - mu) * lax.rsqrt(var + LN_EPS) * g.astype(jnp.float32) + b.astype(jnp.float32)
    return y.astype(x.dtype)


def _rope(t, cos, sin):
    half = t.shape[-1] // 2
    tf = t.astype(jnp.float32)
    t1, t2 = tf[..., :half], tf[..., half:]
    return jnp.concatenate([t1 * cos - t2 * sin, t1 * sin + t2 * cos], -1).astype(t.dtype)


def _heads(t, n):
    b, s, _ = t.shape
    return t.reshape(b, s, n, -1).transpose(0, 2, 1, 3)


def _to_blocks(t):
    b, h, s, e = t.shape
    return jnp.moveaxis(t.reshape(b, h, s // Q_BLOCK, Q_BLOCK, e), 2, 0)


def _from_blocks(t):
    nb, b, h, q, e = t.shape
    return jnp.moveaxis(t, 0, 2).reshape(b, h, nb * q, e).transpose(0, 2, 1, 3)


def _causal_block_attention(dq1, dq2, dk1, dk2, dv, lam, fq, fk, fv, fcum):
    b, hf, seq = fcum.shape
    nb = seq // Q_BLOCK
    k_pos = jnp.arange(seq)
    scale = HEAD_DIM ** -0.5
    fcum_q = jnp.moveaxis(fcum.reshape(b, hf, nb, Q_BLOCK), 2, 0)

    def probs(q, k, causal, bias=None):
        s = jnp.einsum("bhqd,bhkd->bhqk", q, k, preferred_element_type=jnp.float32) * scale
        if bias is not None:
            s = s + bias
        return jax.nn.softmax(jnp.where(causal, s, -jnp.inf), axis=-1)

    def one_block(args):
        i, q1, q2, qf, cq = args
        q_pos = i * Q_BLOCK + jnp.arange(Q_BLOCK)
        causal = q_pos[:, None] >= k_pos[None, :]
        a_diff = probs(q1, dk1, causal) - lam * probs(q2, dk2, causal)
        o_diff = jnp.einsum("bhqk,bhke->bhqe", a_diff.astype(dv.dtype), dv)
        decay = cq[..., :, None] - fcum[..., None, :]
        a_fox = probs(qf, fk, causal, decay)
        o_fox = jnp.einsum("bhqk,bhke->bhqe", a_fox.astype(fv.dtype), fv)
        return o_diff, o_fox

    o_diff, o_fox = lax.map(one_block, (jnp.arange(nb), _to_blocks(dq1), _to_blocks(dq2), _to_blocks(fq), fcum_q))
    return _from_blocks(o_diff), _from_blocks(o_fox)


def _hybrid_mixer(h, w_in, b_forget, lam_q1, lam_k1, lam_q2, lam_k2, diff_norm_g,
                  w_proj_diff, w_proj_fox, w_out, lam_init):
    f32 = jnp.float32
    b, s, _ = h.shape
    dq, dk, dv, fq, fk, fv, f_logit, gate_logit = jnp.split(h @ w_in, IN_SPLITS, axis=-1)
    inv_freq = ROPE_THETA ** (-jnp.arange(0, HEAD_DIM, 2, dtype=f32) / HEAD_DIM)
    ang = jnp.arange(s, dtype=f32)[:, None] * inv_freq[None, :]
    cos, sin = jnp.cos(ang), jnp.sin(ang)
    dq = _rope(_heads(dq, 2 * DIFF_HEADS), cos, sin)
    dk = _rope(_heads(dk, 2 * DIFF_HEADS), cos, sin)
    dq1, dq2 = dq[:, 0::2], dq[:, 1::2]
    dk1, dk2 = dk[:, 0::2], dk[:, 1::2]
    dv = _heads(dv, DIFF_HEADS)
    lam = (jnp.exp(jnp.sum(lam_q1.astype(f32) * lam_k1.astype(f32)))
           - jnp.exp(jnp.sum(lam_q2.astype(f32) * lam_k2.astype(f32))) + lam_init)
    fq, fk, fv = _heads(fq, FOX_HEADS), _heads(fk, FOX_HEADS), _heads(fv, FOX_HEADS)
    log_f = jax.nn.log_sigmoid(f_logit.astype(f32) + b_forget.astype(f32))
    fcum = jnp.cumsum(log_f, axis=1).transpose(0, 2, 1)
    o_diff, o_fox = _causal_block_attention(dq1, dq2, dk1, dk2, dv, lam, fq, fk, fv, fcum)
    of = o_diff.astype(f32)
    of = of * lax.rsqrt(jnp.mean(jnp.square(of), -1, keepdims=True) + LN_EPS) * diff_norm_g.astype(f32) * (1.0 - lam_init)
    u_diff = of.astype(h.dtype).reshape(b, s, DIFF_V_COLS) @ w_proj_diff
    u_fox = o_fox.reshape(b, s, FOX_V_COLS) @ w_proj_fox
    g_diff, g_fox = jnp.split(jax.nn.sigmoid(gate_logit), 2, axis=-1)
    return (g_diff * u_diff + g_fox * u_fox) @ w_out


def _hierarchical_moe(h, w_rg, b_rg, w_re, b_re, w_gate, w_up, w_down):
    f32 = jnp.float32
    b, s, d = h.shape
    t = b * s
    xt = h.reshape(t, d)
    p_group = jax.nn.softmax((xt @ w_rg).astype(f32) + b_rg.astype(f32), axis=-1)
    top_gp, top_g = lax.top_k(p_group, 1)
    exp_logits = jnp.einsum("td,gde->tge", xt, w_re).astype(f32) + b_re.astype(f32)
    sel_logits = exp_logits[jnp.arange(t), top_g[:, 0]]
    top_el, top_e = lax.top_k(sel_logits, TOP_K)
    weights = top_gp * jax.nn.softmax(top_el, axis=-1)
    expert_ids = top_g * EXPERTS_PER_GROUP + top_e
    a = t * TOP_K
    flat_e = expert_ids.reshape(a)
    flat_tok = jnp.repeat(jnp.arange(t), TOP_K)
    order = jnp.argsort(flat_e)
    s_e, s_tok, s_w = flat_e[order], flat_tok[order], weights.reshape(a)[order]
    counts = jnp.bincount(flat_e, length=N_EXPERTS)
    group_start = jnp.cumsum(counts) - counts
    padded = (counts + MOE_BLOCK - 1) // MOE_BLOCK * MOE_BLOCK
    pad_end = jnp.cumsum(padded)
    pad_start = pad_end - padded
    dest = pad_start[s_e] + jnp.arange(a) - group_start[s_e]
    n_blocks = -(-a // MOE_BLOCK) + N_EXPERTS
    rows = n_blocks * MOE_BLOCK
    xs = jnp.zeros((rows, d), xt.dtype).at[dest].set(xt[s_tok])
    block_expert = jnp.minimum(jnp.searchsorted(pad_end, jnp.arange(n_blocks) * MOE_BLOCK, side="right"), N_EXPERTS - 1)

    def expert_block(args):
        xb, e = args
        return (jax.nn.silu(xb @ w_gate[e]) * (xb @ w_up[e])) @ w_down[e]

    ys = lax.map(expert_block, (xs.reshape(n_blocks, MOE_BLOCK, d), block_expert)).reshape(rows, d)
    contrib = ys[dest] * s_w[:, None].astype(ys.dtype)
    return jax.ops.segment_sum(contrib, s_tok, num_segments=t).reshape(b, s, d)


def setup_inputs(seed: int = 0) -> dict:
    key = jax.random.key(seed)
    ks = jax.random.split(key, 24)
    f32 = jnp.float32

    def nrm(k, shape, scale):
        return jax.random.normal(k, shape, f32) * scale

    col_scale = jnp.concatenate([jnp.full((n,), DEEPNORM_BETA if i in VALUE_SEGMENTS else 1.0, f32)
                                 for i, n in enumerate(IN_SIZES)])
    return {
        "x": nrm(ks[0], (BATCH, SEQ, D_MODEL), 1.0),
        "w_in": nrm(ks[1], (DEPTH, D_MODEL, IN_COLS), D_MODEL ** -0.5) * col_scale,
        "b_forget": jax.random.uniform(ks[2], (DEPTH, FOX_HEADS), f32, 1.0, 4.0),
        "lam_q1": nrm(ks[3], (DEPTH, HEAD_DIM), 0.1),
        "lam_k1": nrm(ks[4], (DEPTH, HEAD_DIM), 0.1),
        "lam_q2": nrm(ks[5], (DEPTH, HEAD_DIM), 0.1),
        "lam_k2": nrm(ks[6], (DEPTH, HEAD_DIM), 0.1),
        "diff_norm_g": 1.0 + nrm(ks[7], (DEPTH, DIFF_HEADS, DIFF_V_DIM), 0.02),
        "w_proj_diff": nrm(ks[8], (DEPTH, DIFF_V_COLS, D_MODEL), DIFF_V_COLS ** -0.5 * DEEPNORM_BETA),
        "w_proj_fox": nrm(ks[9], (DEPTH, FOX_V_COLS, D_MODEL), FOX_V_COLS ** -0.5 * DEEPNORM_BETA),
        "w_out": nrm(ks[10], (DEPTH, D_MODEL, D_MODEL), D_MODEL ** -0.5 * DEEPNORM_BETA),
        "ln1_g": 1.0 + nrm(ks[11], (DEPTH, D_MODEL), 0.02),
        "ln1_b": nrm(ks[12], (DEPTH, D_MODEL), 0.02),
        "w_router_group": nrm(ks[13], (DEPTH, D_MODEL, N_GROUPS), D_MODEL ** -0.5),
        "b_router_group": nrm(ks[14], (DEPTH, N_GROUPS), 0.01),
        "w_router_expert": nrm(ks[15], (DEPTH, N_GROUPS, D_MODEL, EXPERTS_PER_GROUP), D_MODEL ** -0.5),
        "b_router_expert": nrm(ks[16], (DEPTH, N_GROUPS, EXPERTS_PER_GROUP), 0.01),
        "w_gate": nrm(ks[17], (DEPTH, N_EXPERTS, D_MODEL, EXPERT_FF), D_MODEL ** -0.5),
        "w_up": nrm(ks[18], (DEPTH, N_EXPERTS, D_MODEL, EXPERT_FF), D_MODEL ** -0.5 * DEEPNORM_BETA),
        "w_down": nrm(ks[19], (DEPTH, N_EXPERTS, EXPERT_FF, D_MODEL), EXPERT_FF ** -0.5 * DEEPNORM_BETA),
        "ln2_g": 1.0 + nrm(ks[20], (DEPTH, D_MODEL), 0.02),
        "ln2_b": nrm(ks[21], (DEPTH, D_MODEL), 0.02),
    }


def reference(x, w_in, b_forget, lam_q1, lam_k1, lam_q2, lam_k2, diff_norm_g, w_proj_diff, w_proj_fox,
              w_out, ln1_g, ln1_b, w_router_group, b_router_group, w_router_expert, b_router_expert,
              w_gate, w_up, w_down, ln2_g, ln2_b):
    for layer in range(DEPTH):
        lam_init = 0.8 - 0.6 * math.exp(-0.3 * layer)
        mix = _hybrid_mixer(x, w_in[layer], b_forget[layer], lam_q1[layer], lam_k1[layer], lam_q2[layer],
                            lam_k2[layer], diff_norm_g[layer], w_proj_diff[layer], w_proj_fox[layer],
                            w_out[layer], lam_init)
        x = _layer_norm(DEEPNORM_ALPHA * x + mix, ln1_g[layer], ln1_b[layer])
        ffn = _hierarchical_moe(x, w_router_group[layer], b_router_group[layer], w_router_expert[layer],
                                b_router_expert[layer], w_gate[layer], w_up[layer], w_down[layer])
        x = _layer_norm(DEEPNORM_ALPHA * x + ffn, ln2_g[layer], ln2_b[layer])
    return x
```

```cpp
#include <hip/hip_runtime.h>
#include <cstdio>
#include <cstdint>
#include <cmath>

namespace nv {
constexpr int S = 8192, DM = 2048, INC = 10248, PQC = 6152, NEXP = 32, FF = 512;
constexpr float ALPHA = 1.189207115002721f;
constexpr float LN_EPS = 1e-5f;
constexpr float LAM_INIT = 0.2f;

template <class LA, class LB, class EP>
__global__ __launch_bounds__(256) void gemm_naive(int M, int N, int K, LA la, LB lb, EP ep) {
    __shared__ float As[16][68], Bs[16][68];
    const int tid = threadIdx.x, tx = tid & 15, ty = tid >> 4;
    const int m0 = blockIdx.y * 64, n0 = blockIdx.x * 64;
    float acc[4][4];
#pragma unroll
    for (int i = 0; i < 4; ++i)
#pragma unroll
        for (int j = 0; j < 4; ++j) acc[i][j] = 0.f;
    for (int k0 = 0; k0 < K; k0 += 16) {
#pragma unroll
        for (int r = 0; r < 4; ++r) { const int i = tid + r * 256; const int mm = i >> 4, kk = i & 15; As[kk][mm] = (m0 + mm < M) ? la(m0 + mm, k0 + kk) : 0.f; }
#pragma unroll
        for (int r = 0; r < 4; ++r) { const int i = tid + r * 256; const int kk = i >> 6, nn = i & 63; Bs[kk][nn] = (n0 + nn < N) ? lb(k0 + kk, n0 + nn) : 0.f; }
        __syncthreads();
#pragma unroll
        for (int kk = 0; kk < 16; ++kk) {
            float a[4], b[4];
#pragma unroll
            for (int i = 0; i < 4; ++i) { a[i] = As[kk][ty * 4 + i]; b[i] = Bs[kk][tx * 4 + i]; }
#pragma unroll
            for (int i = 0; i < 4; ++i)
#pragma unroll
                for (int j = 0; j < 4; ++j) acc[i][j] = fmaf(a[i], b[j], acc[i][j]);
        }
        __syncthreads();
    }
#pragma unroll
    for (int i = 0; i < 4; ++i)
#pragma unroll
        for (int j = 0; j < 4; ++j) { const int m = m0 + ty * 4 + i, n = n0 + tx * 4 + j; if (m < M && n < N) ep(m, n, acc[i][j]); }
}

__global__ void rope_kernel(float* PQ) {
    const long idx = (long)blockIdx.x * blockDim.x + threadIdx.x;
    if (idx >= (long)S * 16 * 64) return;
    const int j = (int)(idx & 63), head = (int)((idx >> 6) & 15), s = (int)(idx >> 10);
    const int base = head < 8 ? head * 128 : 1024 + (head - 8) * 128;
    const double ang = (double)s * pow(10000.0, -(double)j / 64.0);
    const float c = (float)cos(ang), sn = (float)sin(ang);
    float* p = PQ + (size_t)s * PQC + base;
    const float t1 = p[j], t2 = p[j + 64];
    p[j] = t1 * c - t2 * sn; p[j + 64] = t1 * sn + t2 * c;
}

__global__ void fcum_kernel(const float* PQ, const float* b_forget, float* FC) {
    const int h = threadIdx.x; if (h >= 8) return;
    double cum = 0.0; const double b = (double)b_forget[h];
    for (int s = 0; s < S; ++s) {
        const double z = (double)PQ[(size_t)s * PQC + 6144 + h] + b;
        const double ls = (z < 0.0 ? z : 0.0) - log1p(exp(-fabs(z)));
        cum += ls; FC[(size_t)h * S + s] = (float)cum;
    }
}

__global__ __launch_bounds__(256) void attn_naive(const float* PQ, const float* FC, float* OATT) {
    extern __shared__ float sm[];
    float* Qs = sm;
    float* Ks = Qs + 64 * 129;
    float* Vs = Ks + 64 * 129;
    float* Ss = Vs + 64 * 128;
    float* mrow = Ss + 64 * 65;
    float* lrow = mrow + 64;
    float* arow = lrow + 64;
    const int tid = threadIdx.x, tx = tid & 15, ty = tid >> 4;
    const int qb = gridDim.x - 1 - blockIdx.x, u = blockIdx.y;
    int qc, kc, vc; const float* bias = nullptr;
    if (u < 16) { const int m = u >> 1, c = u & 1; qc = m * 128; kc = 1024 + m * 128; vc = 2048 + (m >> 1) * 256 + c * 128; }
    else { const int h = u - 16; qc = 3072 + h * 128; kc = 4096 + h * 128; vc = 5120 + h * 128; bias = FC + (size_t)h * S; }
    const int q0 = qb * 64;
    for (int i = tid; i < 64 * 128; i += 256) { const int r = i >> 7, d = i & 127; Qs[r * 129 + d] = PQ[(size_t)(q0 + r) * PQC + qc + d]; }
    if (tid < 64) { mrow[tid] = -1e30f; lrow[tid] = 0.f; }
    float o[4][8];
#pragma unroll
    for (int i = 0; i < 4; ++i)
#pragma unroll
        for (int j = 0; j < 8; ++j) o[i][j] = 0.f;
    const float scale = 0.08838834764831845f;
    __syncthreads();
    for (int kb = 0; kb <= qb; ++kb) {
        const int k0 = kb * 64;
        for (int i = tid; i < 64 * 128; i += 256) { const int r = i >> 7, d = i & 127; Ks[r * 129 + d] = PQ[(size_t)(k0 + r) * PQC + kc + d]; Vs[r * 128 + d] = PQ[(size_t)(k0 + r) * PQC + vc + d]; }
        __syncthreads();
        float sc[4][4];
#pragma unroll
        for (int i = 0; i < 4; ++i)
#pragma unroll
            for (int j = 0; j < 4; ++j) sc[i][j] = 0.f;
        for (int d = 0; d < 128; ++d) {
            float a[4], b[4];
#pragma unroll
            for (int i = 0; i < 4; ++i) { a[i] = Qs[(ty * 4 + i) * 129 + d]; b[i] = Ks[(tx * 4 + i) * 129 + d]; }
#pragma unroll
            for (int i = 0; i < 4; ++i)
#pragma unroll
                for (int j = 0; j < 4; ++j) sc[i][j] = fmaf(a[i], b[j], sc[i][j]);
        }
#pragma unroll
        for (int i = 0; i < 4; ++i)
#pragma unroll
            for (int j = 0; j < 4; ++j) {
                const int qi = q0 + ty * 4 + i, ki = k0 + tx * 4 + j;
                float v = sc[i][j] * scale;
                if (bias) v += bias[qi] - bias[ki];
                if (ki > qi) v = -INFINITY;
                Ss[(ty * 4 + i) * 65 + tx * 4 + j] = v;
            }
        __syncthreads();
        if (tid < 64) {
            float mx = mrow[tid];
            for (int c = 0; c < 64; ++c) mx = fmaxf(mx, Ss[tid * 65 + c]);
            const float al = __expf(mrow[tid] - mx);
            float sum = 0.f;
            for (int c = 0; c < 64; ++c) { const float p = __expf(Ss[tid * 65 + c] - mx); Ss[tid * 65 + c] = p; sum += p; }
            lrow[tid] = lrow[tid] * al + sum; mrow[tid] = mx; arow[tid] = al;
        }
        __syncthreads();
#pragma unroll
        for (int i = 0; i < 4; ++i) { const float al = arow[ty * 4 + i];
#pragma unroll
            for (int j = 0; j < 8; ++j) o[i][j] *= al; }
        for (int c = 0; c < 64; ++c) {
            float p[4], v[8];
#pragma unroll
            for (int i = 0; i < 4; ++i) p[i] = Ss[(ty * 4 + i) * 65 + c];
#pragma unroll
            for (int j = 0; j < 8; ++j) v[j] = Vs[c * 128 + tx * 8 + j];
#pragma unroll
            for (int i = 0; i < 4; ++i)
#pragma unroll
                for (int j = 0; j < 8; ++j) o[i][j] = fmaf(p[i], v[j], o[i][j]);
        }
        __syncthreads();
    }
#pragma unroll
    for (int i = 0; i < 4; ++i) { const float inv = 1.f / lrow[ty * 4 + i];
#pragma unroll
        for (int j = 0; j < 8; ++j) OATT[((size_t)u * S + q0 + ty * 4 + i) * 128 + tx * 8 + j] = o[i][j] * inv; }
}

__global__ __launch_bounds__(256) void combine_kernel(const float* OATT, const float* lq1, const float* lk1, const float* lq2, const float* lk2, const float* g, float* OF) {
    __shared__ float red[256]; __shared__ float lam_s;
    const int s = blockIdx.x, h = blockIdx.y, d = threadIdx.x;
    if (d == 0) { float a = 0.f, b = 0.f; for (int i = 0; i < 128; ++i) { a += lq1[i] * lk1[i]; b += lq2[i] * lk2[i]; } lam_s = expf(a) - expf(b) + LAM_INIT; }
    __syncthreads();
    const float lam = lam_s; const int c = d >> 7, dd = d & 127;
    const float o1 = OATT[((size_t)(4 * h + c) * S + s) * 128 + dd], o2 = OATT[((size_t)(4 * h + 2 + c) * S + s) * 128 + dd];
    const float v = o1 - lam * o2;
    red[d] = v * v; __syncthreads();
    for (int st = 128; st > 0; st >>= 1) { if (d < st) red[d] += red[d + st]; __syncthreads(); }
    const float r = rsqrtf(red[0] * (1.f / 256.f) + LN_EPS);
    OF[(size_t)s * DM + h * 256 + d] = v * r * g[h * 256 + d] * (1.f - LAM_INIT);
    OF[(size_t)s * DM + 1024 + h * 256 + d] = OATT[((size_t)(16 + 2 * h + c) * S + s) * 128 + dd];
}

__global__ __launch_bounds__(256) void ln_kernel(const float* in, const float* g, const float* b, float* out) {
    __shared__ float red[256];
    const int s = blockIdx.x, t = threadIdx.x;
    float v[8]; float sum = 0.f;
#pragma unroll
    for (int i = 0; i < 8; ++i) { v[i] = in[(size_t)s * DM + t + 256 * i]; sum += v[i]; }
    red[t] = sum; __syncthreads();
    for (int st = 128; st > 0; st >>= 1) { if (t < st) red[t] += red[t + st]; __syncthreads(); }
    const float mean = red[0] * (1.f / DM); __syncthreads();
    float q = 0.f;
#pragma unroll
    for (int i = 0; i < 8; ++i) { v[i] -= mean; q += v[i] * v[i]; }
    red[t] = q; __syncthreads();
    for (int st = 128; st > 0; st >>= 1) { if (t < st) red[t] += red[t + st]; __syncthreads(); }
    const float rstd = rsqrtf(red[0] * (1.f / DM) + LN_EPS);
#pragma unroll
    for (int i = 0; i < 8; ++i) { const int c = t + 256 * i; out[(size_t)s * DM + c] = v[i] * rstd * g[c] + b[c]; }
}

__global__ __launch_bounds__(64) void router_kernel(const float* X1, const float* wrg, const float* brg, const float* wre, const float* bre, int* RE, float* RW) {
    const int s = blockIdx.x, lane = threadIdx.x;
    float acc[36];
#pragma unroll
    for (int c = 0; c < 36; ++c) acc[c] = 0.f;
    for (int k = lane; k < DM; k += 64) {
        const float xv = X1[(size_t)s * DM + k];
#pragma unroll
        for (int c = 0; c < 4; ++c) acc[c] = fmaf(xv, wrg[k * 4 + c], acc[c]);
#pragma unroll
        for (int gi = 0; gi < 4; ++gi)
#pragma unroll
            for (int e = 0; e < 8; ++e) acc[4 + gi * 8 + e] = fmaf(xv, wre[((size_t)gi * DM + k) * 8 + e], acc[4 + gi * 8 + e]);
    }
#pragma unroll
    for (int c = 0; c < 36; ++c) {
#pragma unroll
        for (int o = 1; o < 64; o <<= 1) acc[c] += __shfl_xor(acc[c], o);
    }
    __shared__ float L[36];
    if (lane == 0) {
#pragma unroll
        for (int c = 0; c < 36; ++c) L[c] = acc[c];
    }
    __syncthreads();
    if (lane == 0) {
        int g = 0; float gm = L[0] + brg[0];
        for (int c = 1; c < 4; ++c) { const float v = L[c] + brg[c]; if (v > gm) { gm = v; g = c; } }
        float den = 0.f;
        for (int c = 0; c < 4; ++c) den += expf(L[c] + brg[c] - gm);
        const float top_gp = 1.f / den;
        int e1 = 0; float l1 = L[4 + g * 8] + bre[g * 8];
        for (int e = 1; e < 8; ++e) { const float v = L[4 + g * 8 + e] + bre[g * 8 + e]; if (v > l1) { l1 = v; e1 = e; } }
        int e2 = -1; float l2 = -INFINITY;
        for (int e = 0; e < 8; ++e) { const float v = L[4 + g * 8 + e] + bre[g * 8 + e]; if (e != e1 && v > l2) { l2 = v; e2 = e; } }
        const float w1 = 1.f / (1.f + expf(l2 - l1));
        RE[s * 2] = g * 8 + e1; RE[s * 2 + 1] = g * 8 + e2;
        RW[s * 2] = top_gp * w1; RW[s * 2 + 1] = top_gp * (1.f - w1);
    }
}

__global__ __launch_bounds__(256) void moe_naive(const float* X1, const int* RE, const float* RW, const float* wg, const float* wu, const float* wd, float* Z2) {
    __shared__ float xs[DM]; __shared__ float hs[FF];
    const int s = blockIdx.x, t = threadIdx.x;
    for (int i = t; i < DM; i += 256) xs[i] = X1[(size_t)s * DM + i];
    float out[8];
#pragma unroll
    for (int i = 0; i < 8; ++i) out[i] = 0.f;
    __syncthreads();
    for (int slot = 0; slot < 2; ++slot) {
        const int e = RE[s * 2 + slot]; const float w = RW[s * 2 + slot];
        const float* G = wg + (size_t)e * DM * FF; const float* U = wu + (size_t)e * DM * FF; const float* Dn = wd + (size_t)e * FF * DM;
        float g0 = 0.f, g1 = 0.f, u0 = 0.f, u1 = 0.f;
        for (int k = 0; k < DM; ++k) { const float xv = xs[k];
            g0 = fmaf(xv, G[(size_t)k * FF + t], g0); g1 = fmaf(xv, G[(size_t)k * FF + t + 256], g1);
            u0 = fmaf(xv, U[(size_t)k * FF + t], u0); u1 = fmaf(xv, U[(size_t)k * FF + t + 256], u1); }
        __syncthreads();
        hs[t] = g0 / (1.f + expf(-g0)) * u0; hs[t + 256] = g1 / (1.f + expf(-g1)) * u1;
        __syncthreads();
        float y[8];
#pragma unroll
        for (int i = 0; i < 8; ++i) y[i] = 0.f;
        for (int j = 0; j < FF; ++j) { const float hv = hs[j];
#pragma unroll
            for (int i = 0; i < 8; ++i) y[i] = fmaf(hv, Dn[(size_t)j * DM + t + 256 * i], y[i]); }
#pragma unroll
        for (int i = 0; i < 8; ++i) out[i] += w * y[i];
    }
#pragma unroll
    for (int i = 0; i < 8; ++i) Z2[(size_t)s * DM + t + 256 * i] = ALPHA * xs[t + 256 * i] + out[i];
}
}

extern "C" void kernel_launch(void* const* d_in, const int* in_sizes, int n_in, void* d_out, int out_size, void* d_ws, size_t ws_size, hipStream_t stream) {
    using namespace nv;
    constexpr size_t MiB = 1u << 20;
    if (n_in != 22 || in_sizes[0] != S * DM || out_size != S * DM || ws_size < 500 * MiB) { fprintf(stderr, "kernel_launch: unexpected shapes (n_in %d, ws %zu)\n", n_in, ws_size); return; }
    const float* x = (const float*)d_in[0]; const float* w_in = (const float*)d_in[1]; const float* b_forget = (const float*)d_in[2];
    const float* lq1 = (const float*)d_in[3]; const float* lk1 = (const float*)d_in[4]; const float* lq2 = (const float*)d_in[5]; const float* lk2 = (const float*)d_in[6];
    const float* dng = (const float*)d_in[7]; const float* wpd = (const float*)d_in[8]; const float* wpf = (const float*)d_in[9]; const float* wout = (const float*)d_in[10];
    const float* ln1g = (const float*)d_in[11]; const float* ln1b = (const float*)d_in[12]; const float* wrg = (const float*)d_in[13]; const float* brg = (const float*)d_in[14];
    const float* wre = (const float*)d_in[15]; const float* bre = (const float*)d_in[16]; const float* wg = (const float*)d_in[17]; const float* wu = (const float*)d_in[18];
    const float* wd = (const float*)d_in[19]; const float* ln2g = (const float*)d_in[20]; const float* ln2b = (const float*)d_in[21];
    char* ws = (char*)d_ws; float* out = (float*)d_out;
    float* PQ = (float*)(ws);
    float* GATE = (float*)(ws + 196 * MiB);
    float* OATT = (float*)(ws + 324 * MiB);
    float* OF = (float*)(ws + 420 * MiB);
    float* FC = (float*)(ws + 484 * MiB);
    int* RE = (int*)(ws + 485 * MiB); float* RW = (float*)(ws + 486 * MiB);
    float* Mb = PQ; float* Z = OATT; float* X1 = OATT + (size_t)S * DM / 2 * 0; float* Z2 = GATE;

    {
        auto la = [=] __device__(int m, int k) { return x[(size_t)m * DM + k]; };
        auto lb = [=] __device__(int k, int n) { return w_in[(size_t)k * INC + n]; };
        auto ep = [=] __device__(int m, int n, float v) { if (n < PQC) PQ[(size_t)m * PQC + n] = v; else GATE[(size_t)m * 4096 + (n - PQC)] = 1.f / (1.f + __expf(-v)); };
        gemm_naive<<<dim3((INC + 63) / 64, S / 64), 256, 0, stream>>>(S, INC, DM, la, lb, ep);
    }
    rope_kernel<<<(S * 16 * 64) / 256, 256, 0, stream>>>(PQ);
    fcum_kernel<<<1, 64, 0, stream>>>(PQ, b_forget, FC);
    {
        static bool attr = false; constexpr int LDSB = (64 * 129 * 2 + 64 * 128 + 64 * 65 + 192) * 4;
        if (!attr) { attr = true; (void)hipFuncSetAttribute((const void*)attn_naive, hipFuncAttributeMaxDynamicSharedMemorySize, LDSB); }
        attn_naive<<<dim3(S / 64, 24), 256, LDSB, stream>>>(PQ, FC, OATT);
    }
    combine_kernel<<<dim3(S, 4), 256, 0, stream>>>(OATT, lq1, lk1, lq2, lk2, dng, OF);
    {
        auto la = [=] __device__(int m, int k) { return OF[(size_t)m * DM + k]; };
        auto lb = [=] __device__(int k, int n) { return wpd[(size_t)k * DM + n]; };
        auto ep = [=] __device__(int m, int n, float v) { Mb[(size_t)m * DM + n] = GATE[(size_t)m * 4096 + n] * v; };
        gemm_naive<<<dim3(DM / 64, S / 64), 256, 0, stream>>>(S, DM, 1024, la, lb, ep);
        auto la2 = [=] __device__(int m, int k) { return OF[(size_t)m * DM + 1024 + k]; };
        auto lb2 = [=] __device__(int k, int n) { return wpf[(size_t)k * DM + n]; };
        auto ep2 = [=] __device__(int m, int n, float v) { Mb[(size_t)m * DM + n] += GATE[(size_t)m * 4096 + 2048 + n] * v; };
        gemm_naive<<<dim3(DM / 64, S / 64), 256, 0, stream>>>(S, DM, 1024, la2, lb2, ep2);
    }
    {
        auto la = [=] __device__(int m, int k) { return Mb[(size_t)m * DM + k]; };
        auto lb = [=] __device__(int k, int n) { return wout[(size_t)k * DM + n]; };
        auto ep = [=] __device__(int m, int n, float v) { Z[(size_t)m * DM + n] = ALPHA * x[(size_t)m * DM + n] + v; };
        gemm_naive<<<dim3(DM / 64, S / 64), 256, 0, stream>>>(S, DM, DM, la, lb, ep);
    }
    ln_kernel<<<S, 256, 0, stream>>>(Z, ln1g, ln1b, X1);
    router_kernel<<<S, 64, 0, stream>>>(X1, wrg, brg, wre, bre, RE, RW);
    moe_naive<<<S, 256, 0, stream>>>(X1, RE, RW, wg, wu, wd, Z2);
    ln_kernel<<<S, 256, 0, stream>>>(Z2, ln2g, ln2b, out);
}
```

```cpp
#include <hip/hip_runtime.h>
#include <hip/hip_bf16.h>
#include <cstdio>
#include <cstdint>
#include <cmath>

#ifndef PH_MASK
#define PH_MASK 0x7ff
#endif
#ifndef MK_N_LAUNCHES
#define MK_N_LAUNCHES 1
#endif

constexpr int S = 8192, DM = 2048, INC = 10248, NIN = 10240, NEXP = 32, FF = 512;
constexpr float ALPHA = 1.189207115002721f;
constexpr float LN_EPS = 1e-5f;
constexpr float LAM_INIT = 0.2f;
constexpr float INV_SCALE = 11.313708498984761f;
constexpr float FOX_THR_RAW = 36.f * 11.313708498984761f;

#define LAS __attribute__((address_space(3)))
#define GAS __attribute__((address_space(1)))
typedef unsigned short bf16_t;
typedef short bf16x8 __attribute__((ext_vector_type(8)));
typedef short s16x4 __attribute__((ext_vector_type(4)));
typedef float f32x4 __attribute__((ext_vector_type(4)));
typedef float f32x2 __attribute__((ext_vector_type(2)));
typedef float f32x16 __attribute__((ext_vector_type(16)));
typedef unsigned u32x4 __attribute__((ext_vector_type(4)));
typedef unsigned u32x2 __attribute__((ext_vector_type(2)));
typedef GAS unsigned gu32;

typedef __bf16 bf16x2_t __attribute__((ext_vector_type(2)));
__device__ __forceinline__ unsigned cvt_pk_bf16(float lo, float hi) { f32x2 v = {lo, hi}; bf16x2_t b = __builtin_convertvector(v, bf16x2_t); return __builtin_bit_cast(unsigned, b); }
__device__ __forceinline__ float bf_lo(unsigned w) { return __uint_as_float(w << 16); }
__device__ __forceinline__ float bf_hi(unsigned w) { return __uint_as_float(w & 0xffff0000u); }
__device__ __forceinline__ float wave_sum(float v) {
#pragma unroll
    for (int o = 1; o < 64; o <<= 1) v += __shfl_xor(v, o);
    return v;
}

namespace pg8 {
constexpr int BM = 256, BK = 64, HALF = 128, HTB = HALF * BK * 2, STAGE_BYTES = 8 * HTB, NXCD = 8, WGM = 8;
__host__ __device__ __forceinline__ int lds_byte(int r, int c) { const int st = (r >> 4) * 2 + (c >> 5), rr = r & 15, cc = c & 31, ob = rr * 64 + cc * 2; return st * 1024 + (ob ^ (((ob >> 9) & 1) << 5)); }
__host__ __device__ __forceinline__ void stage_rc(int b, int& R, int& C) { const int st = b / 1024, sb = b % 1024, swz = sb ^ (((sb >> 9) & 1) << 5); R = (st >> 1) * 16 + swz / 64; C = (st & 1) * 32 + (swz % 64) / 2; }
__host__ __device__ __forceinline__ int perm32(int rho) { const int n = rho >> 4, i = rho & 15; return 8 * (i >> 2) + 4 * n + (i & 3); }

struct Unit { int pm, pn; };
struct Gemm { const bf16_t* A; const bf16_t* Bt; int K, lda, ldb; const LAS int* rowidx; };

struct StaticOrder {
    int nM, nN, nwg, G, c;
    __device__ void init(int M, int N, int G_, int c_) { nM = M / BM; nN = N / BM; nwg = nM * nN; G = G_; c = c_; }
    __device__ bool next(int i, Unit& u) const {
        const long L = (long)i * G + c; if (L >= nwg) return false;
        int wgid = (int)L; { const int q = nwg / NXCD, r = nwg % NXCD, xcd = wgid % NXCD, off = wgid / NXCD; wgid = (xcd < r ? xcd * (q + 1) : r * (q + 1) + (xcd - r) * q) + off; }
        const int nig = WGM * nN, gid = wgid / nig, fm = gid * WGM, gsz = (nM - fm) < WGM ? (nM - fm) : WGM;
        u.pm = fm + ((wgid % nig) % gsz); u.pn = (wgid % nig) / gsz; return true;
    }
};
struct SingleUnit { Unit u; __device__ bool next(int i, Unit& o) const { if (i) return false; o = u; return true; } };

typedef f32x4 Acc[2][2][4][2];

template <class Epi, class Sched, bool GATHER, bool HOOK = false>
__device__ __forceinline__ void gemm_phase(LAS unsigned char* lds, const Gemm g, const Sched& S, const Epi& E) {
    int tid = threadIdx.x; asm volatile("" : "+v"(tid));
    const int wid = __builtin_amdgcn_readfirstlane(tid >> 6), lane = tid & 63, wr = wid >> 2, wc = wid & 3, fr = lane & 15, fq = lane >> 4;
    const int K = g.K, nt = K / BK;
    unsigned voffA[2], voffA1[2], voffB[2];
#pragma unroll
    for (int i = 0; i < 2; ++i) { int R, C; stage_rc(tid * 16 + i * 8192, R, C); const int Rb = (R & ~31) + perm32(R & 31);
        if constexpr (GATHER) { voffA[i] = (unsigned)(g.rowidx[R] * g.lda + C) * 2u; voffA1[i] = (unsigned)(g.rowidx[HALF + R] * g.lda + C) * 2u; }
        else { voffA[i] = (unsigned)(R * g.lda + C) * 2u; voffA1[i] = 0u; }
        voffB[i] = (unsigned)(Rb * g.ldb + C) * 2u; }
    const size_t kstep = (size_t)(BK * 2);
    const size_t hstepA = GATHER ? 0 : (size_t)HALF * g.lda * 2, hstepB = (size_t)HALF * g.ldb * 2;
    const size_t tstepA = GATHER ? 0 : 2 * hstepA, tstepB = 2 * hstepB;
    const unsigned ldsw = (unsigned)wid * 1024u;
    const int aoff = lds_byte(wr * 64 + fr, fq * 8), boff = lds_byte(wc * 32 + fr, fq * 8);
#define PG8_SA(b, h) (((b) * 2 + (h)) * HTB)
#define PG8_SB(b, h) ((4 + (b) * 2 + (h)) * HTB)
#define PG8_STAGE(bufoff, gbase, voff) do { _Pragma("unroll") for (int _i = 0; _i < 2; ++_i) \
        __builtin_amdgcn_global_load_lds((const unsigned*)((const char*)(gbase) + (voff)[_i]), (LAS unsigned*)(lds + (bufoff) + ldsw + _i * 8192), 16, 0, 0); } while (0)
#define PG8_STAGE_A0(bufoff, gbase) PG8_STAGE(bufoff, gbase, voffA)
#define PG8_STAGE_A1(bufoff, gbase) do { if constexpr (GATHER) { PG8_STAGE(bufoff, gbase, voffA1); } else { PG8_STAGE(bufoff, (gbase) + hstepA, voffA); } } while (0)
#define PG8_LDA(dst, b, h) do { _Pragma("unroll") for (int m = 0; m < 4; ++m) _Pragma("unroll") for (int k = 0; k < 2; ++k) dst[m][k] = *(const LAS bf16x8*)(lds + PG8_SA(b, h) + aoff + m * 2048 + k * 1024); } while (0)
#define PG8_LDB(dst, b, h) do { _Pragma("unroll") for (int n = 0; n < 2; ++n) _Pragma("unroll") for (int k = 0; k < 2; ++k) dst[n][k] = *(const LAS bf16x8*)(lds + PG8_SB(b, h) + boff + n * 2048 + k * 1024); } while (0)
#define PG8_MMA(ai, bj, At, Bt) do { __builtin_amdgcn_s_setprio(1); _Pragma("unroll") for (int m = 0; m < 4; ++m) _Pragma("unroll") for (int n = 0; n < 2; ++n) _Pragma("unroll") for (int k = 0; k < 2; ++k) \
        acc[ai][bj][m][n] = __builtin_amdgcn_mfma_f32_16x16x32_bf16(Bt[n][k], At[m][k], acc[ai][bj][m][n], 0, 0, 0); __builtin_amdgcn_s_setprio(0); } while (0)
#define PG8_WAIT_V(n) asm volatile("s_waitcnt vmcnt(" #n ")" ::: "memory")
#define PG8_WAIT_L(n) asm volatile("s_waitcnt lgkmcnt(" #n ")" ::: "memory")
#define PG8_BAR __builtin_amdgcn_s_barrier()
#define PG8_SCHED __builtin_amdgcn_sched_barrier(0)
    Unit cur, nxt; int ui = 0;
    if (!S.next(0, cur)) return;
    Acc acc;
#pragma unroll
    for (int a = 0; a < 2; ++a)
#pragma unroll
        for (int b = 0; b < 2; ++b)
#pragma unroll
            for (int m = 0; m < 4; ++m)
#pragma unroll
                for (int n = 0; n < 2; ++n) acc[a][b][m][n] = (f32x4){0.f, 0.f, 0.f, 0.f};
    bf16x8 At[4][2], B0[2][2], B1[2][2];
    const char* cA = (const char*)g.A + (size_t)cur.pm * tstepA; const char* cB = (const char*)g.Bt + (size_t)cur.pn * tstepB;
    PG8_STAGE(PG8_SB(0, 0), cB, voffB); PG8_STAGE(PG8_SB(0, 1), cB + hstepB, voffB); PG8_STAGE_A0(PG8_SA(0, 0), cA); PG8_STAGE_A1(PG8_SA(0, 1), cA);
    if (wr == 1) PG8_BAR;
    PG8_WAIT_V(2); PG8_BAR;
    PG8_STAGE(PG8_SB(1, 0), cB + kstep, voffB); PG8_STAGE_A0(PG8_SA(1, 0), cA + kstep); PG8_STAGE(PG8_SB(1, 1), cB + hstepB + kstep, voffB);
    PG8_WAIT_V(6); PG8_BAR;
    for (;;) {
        const bool has_next = S.next(ui + 1, nxt);
        const char* nA = has_next ? (const char*)g.A + (size_t)nxt.pm * tstepA : cA; const char* nB = has_next ? (const char*)g.Bt + (size_t)nxt.pn * tstepB : cB;
        for (int t = 0; t < nt; t += 2) {
            if constexpr (HOOK) { if (t == nt / 2) { E.hook(acc, cur, wr, wc, fr, fq); PG8_SCHED; } }
            const bool last = (t == nt - 2);
            const char* a1 = cA + (size_t)(t + 1) * kstep;
            const char* a2 = last ? nA : cA + (size_t)(t + 2) * kstep; const char* b2 = last ? nB : cB + (size_t)(t + 2) * kstep;
            const char* a3 = a2 + kstep; const char* b3 = b2 + kstep;
            PG8_LDB(B0, 0, 0); PG8_LDB(B1, 0, 1); PG8_SCHED; PG8_LDA(At, 0, 0); PG8_STAGE_A1(PG8_SA(1, 1), a1);
            PG8_WAIT_V(8); PG8_WAIT_L(0); PG8_BAR; PG8_MMA(0, 0, At, B0); PG8_MMA(0, 1, At, B1); PG8_BAR; PG8_SCHED;
            PG8_LDA(At, 0, 1); PG8_STAGE(PG8_SB(0, 0), b2, voffB); PG8_STAGE(PG8_SB(0, 1), b2 + hstepB, voffB); PG8_STAGE_A0(PG8_SA(0, 0), a2);
            PG8_WAIT_V(8); PG8_WAIT_L(0); PG8_BAR; PG8_MMA(1, 0, At, B0); PG8_MMA(1, 1, At, B1); PG8_BAR; PG8_SCHED;
            PG8_LDB(B0, 1, 0); PG8_LDB(B1, 1, 1); PG8_SCHED; PG8_LDA(At, 1, 0); PG8_STAGE_A1(PG8_SA(0, 1), a2);
            PG8_WAIT_V(8); PG8_WAIT_L(0); PG8_BAR; PG8_MMA(0, 0, At, B0); PG8_MMA(0, 1, At, B1); PG8_BAR; PG8_SCHED;
            PG8_LDA(At, 1, 1); PG8_STAGE(PG8_SB(1, 0), b3, voffB); PG8_STAGE(PG8_SB(1, 1), b3 + hstepB, voffB); PG8_STAGE_A0(PG8_SA(1, 0), a3);
            PG8_WAIT_V(8); PG8_WAIT_L(0); PG8_BAR; PG8_MMA(1, 0, At, B0); PG8_MMA(1, 1, At, B1); PG8_BAR; PG8_SCHED;
        }
        if (wr == 0) PG8_BAR;
        E(acc, cur, wr, wc, fr, fq);
        if (!has_next) break;
#pragma unroll
        for (int a = 0; a < 2; ++a)
#pragma unroll
            for (int b = 0; b < 2; ++b)
#pragma unroll
                for (int m = 0; m < 4; ++m)
#pragma unroll
                    for (int n = 0; n < 2; ++n) acc[a][b][m][n] = (f32x4){0.f, 0.f, 0.f, 0.f};
        cur = nxt; cA = nA; cB = nB; ++ui;
        if (wr == 1) PG8_BAR;
    }
    PG8_WAIT_V(0);
    PG8_BAR;
#undef PG8_SA
#undef PG8_SB
#undef PG8_STAGE
#undef PG8_STAGE_A0
#undef PG8_STAGE_A1
#undef PG8_LDA
#undef PG8_LDB
#undef PG8_MMA
#undef PG8_WAIT_V
#undef PG8_WAIT_L
#undef PG8_BAR
#undef PG8_SCHED
}

__device__ __forceinline__ u32x4 pack8(f32x4 a, f32x4 b) { u32x4 w; w.x = cvt_pk_bf16(a[0], a[1]); w.y = cvt_pk_bf16(a[2], a[3]); w.z = cvt_pk_bf16(b[0], b[1]); w.w = cvt_pk_bf16(b[2], b[3]); return w; }
__device__ __forceinline__ f32x4 sigmoid4(f32x4 v) { f32x4 r;
#pragma unroll
    for (int i = 0; i < 4; ++i) r[i] = __builtin_amdgcn_rcpf(1.f + __builtin_amdgcn_exp2f(-1.4426950408889634f * v[i])); return r; }

struct EpiInProj {
    bf16_t* QKV; bf16_t* G; const float* rope; float* NP;
    __device__ __forceinline__ void operator()(const Acc& acc, const Unit& u, int wr, int wc, int fr, int fq) const {
        const int row0 = u.pm * BM + wr * 64 + fr;
        if (u.pn < 8) {
            const int g4 = 4 * (4 * wc + fq);
#pragma unroll
            for (int ai = 0; ai < 2; ++ai)
#pragma unroll
                for (int m = 0; m < 4; ++m) { const int r = row0 + ai * HALF + m * 16;
                    const f32x4 cs = *(const f32x4*)(rope + (size_t)r * 128 + g4), sn = *(const f32x4*)(rope + (size_t)r * 128 + 64 + g4);
#pragma unroll
                    for (int bj = 0; bj < 2; ++bj) { const f32x4 t1 = acc[ai][bj][m][0], t2 = acc[ai][bj][m][1];
                        const f32x4 o1 = t1 * cs - t2 * sn, o2 = t1 * sn + t2 * cs;
                        bf16_t* dst = QKV + ((size_t)(2 * u.pn + bj) * S + r) * 128;
                        u32x2 w1, w2; w1.x = cvt_pk_bf16(o1[0], o1[1]); w1.y = cvt_pk_bf16(o1[2], o1[3]); w2.x = cvt_pk_bf16(o2[0], o2[1]); w2.y = cvt_pk_bf16(o2[2], o2[3]);
                        *(u32x2*)(dst + g4) = w1; *(u32x2*)(dst + 64 + g4) = w2; } }
        } else if (u.pn < 24) {
#pragma unroll
            for (int ai = 0; ai < 2; ++ai)
#pragma unroll
                for (int m = 0; m < 4; ++m) { const int r = row0 + ai * HALF + m * 16;
#pragma unroll
                    for (int bj = 0; bj < 2; ++bj) *(u32x4*)(QKV + ((size_t)(2 * u.pn + bj) * S + r) * 128 + wc * 32 + 8 * fq) = pack8(acc[ai][bj][m][0], acc[ai][bj][m][1]); }
            if (u.pn >= 12 && u.pn < 20) {
#pragma unroll
                for (int ai = 0; ai < 2; ++ai)
#pragma unroll
                    for (int bj = 0; bj < 2; ++bj) { float mx = 0.f;
#pragma unroll
                        for (int m = 0; m < 4; ++m) { const f32x4 a = acc[ai][bj][m][0], b = acc[ai][bj][m][1];
                            float ss = (a[0] * a[0] + a[1] * a[1]) + (a[2] * a[2] + a[3] * a[3]) + (b[0] * b[0] + b[1] * b[1]) + (b[2] * b[2] + b[3] * b[3]);
                            ss += __shfl_xor(ss, 16); ss += __shfl_xor(ss, 32); mx = fmaxf(mx, ss); }
                        mx = fmaxf(mx, __shfl_xor(mx, 1)); mx = fmaxf(mx, __shfl_xor(mx, 2)); mx = fmaxf(mx, __shfl_xor(mx, 4)); mx = fmaxf(mx, __shfl_xor(mx, 8));
                        if (fr == 0 && fq == 0) NP[((size_t)(2 * u.pn + bj - 24) * 128 + 4 * u.pm + 2 * ai + wr) * 4 + wc] = mx; }
            }
        } else {
            const int col0 = (u.pn - 24) * BM + wc * 32 + 8 * fq;
#pragma unroll
            for (int ai = 0; ai < 2; ++ai)
#pragma unroll
                for (int m = 0; m < 4; ++m) { const int r = row0 + ai * HALF + m * 16;
#pragma unroll
                    for (int bj = 0; bj < 2; ++bj) *(u32x4*)(G + (size_t)r * 4096 + col0 + bj * HALF) = pack8(sigmoid4(acc[ai][bj][m][0]), sigmoid4(acc[ai][bj][m][1])); }
        }
    }
};
struct EpiGateT {
    float* T; const bf16_t* G;
    __device__ __forceinline__ void operator()(const Acc& acc, const Unit& u, int wr, int wc, int fr, int fq) const {
        const int row0 = u.pm * BM + wr * 64 + fr, col0 = u.pn * BM + wc * 32 + 8 * fq;
#pragma unroll
        for (int ai = 0; ai < 2; ++ai)
#pragma unroll
            for (int m = 0; m < 4; ++m) { const int r = row0 + ai * HALF + m * 16;
#pragma unroll
                for (int bj = 0; bj < 2; ++bj) { const int c = col0 + bj * HALF; const u32x4 gw = *(const u32x4*)(G + (size_t)r * 4096 + c);
                    const f32x4 g0 = {bf_lo(gw.x), bf_hi(gw.x), bf_lo(gw.y), bf_hi(gw.y)}, g1 = {bf_lo(gw.z), bf_hi(gw.z), bf_lo(gw.w), bf_hi(gw.w)};
                    *(f32x4*)(T + (size_t)r * DM + c) = acc[ai][bj][m][0] * g0; *(f32x4*)(T + (size_t)r * DM + c + 4) = acc[ai][bj][m][1] * g1; } }
    }
};
struct EpiGateM {
    const float* T; const bf16_t* G; bf16_t* MB;
    __device__ __forceinline__ void operator()(const Acc& acc, const Unit& u, int wr, int wc, int fr, int fq) const {
        const int row0 = u.pm * BM + wr * 64 + fr, col0 = u.pn * BM + wc * 32 + 8 * fq;
#pragma unroll
        for (int ai = 0; ai < 2; ++ai)
#pragma unroll
            for (int m = 0; m < 4; ++m) { const int r = row0 + ai * HALF + m * 16;
#pragma unroll
                for (int bj = 0; bj < 2; ++bj) { const int c = col0 + bj * HALF; const u32x4 gw = *(const u32x4*)(G + (size_t)r * 4096 + 2048 + c);
                    const f32x4 g0 = {bf_lo(gw.x), bf_hi(gw.x), bf_lo(gw.y), bf_hi(gw.y)}, g1 = {bf_lo(gw.z), bf_hi(gw.z), bf_lo(gw.w), bf_hi(gw.w)};
                    const f32x4 t0 = *(const f32x4*)(T + (size_t)r * DM + c), t1 = *(const f32x4*)(T + (size_t)r * DM + c + 4);
                    *(u32x4*)(MB + (size_t)r * DM + c) = pack8(t0 + acc[ai][bj][m][0] * g0, t1 + acc[ai][bj][m][1] * g1); } }
    }
};
struct EpiGateHook {
    const bf16_t* G; bf16_t* MB;
    __device__ __forceinline__ void hook(Acc& acc, const Unit& u, int wr, int wc, int fr, int fq) const {
        int row0 = u.pm * BM + wr * 64 + fr, col0 = u.pn * BM + wc * 32 + 8 * fq;
        asm volatile("" : "+v"(row0), "+v"(col0));
#pragma unroll
        for (int ai = 0; ai < 2; ++ai)
#pragma unroll
            for (int m = 0; m < 4; ++m) { int r = row0 + ai * HALF + m * 16; asm volatile("" : "+v"(r));
#pragma unroll
                for (int bj = 0; bj < 2; ++bj) { const int c = col0 + bj * HALF; const u32x4 gd = *(const u32x4*)(G + (size_t)r * 4096 + c), gf = *(const u32x4*)(G + (size_t)r * 4096 + 2048 + c);
                    const f32x4 d0 = {bf_lo(gd.x), bf_hi(gd.x), bf_lo(gd.y), bf_hi(gd.y)}, d1 = {bf_lo(gd.z), bf_hi(gd.z), bf_lo(gd.w), bf_hi(gd.w)};
                    f32x4 f0 = {bf_lo(gf.x), bf_hi(gf.x), bf_lo(gf.y), bf_hi(gf.y)}, f1 = {bf_lo(gf.z), bf_hi(gf.z), bf_lo(gf.w), bf_hi(gf.w)};
#pragma unroll
                    for (int i = 0; i < 4; ++i) { f0[i] = __builtin_amdgcn_rcpf(fmaxf(f0[i], 1e-30f)); f1[i] = __builtin_amdgcn_rcpf(fmaxf(f1[i], 1e-30f)); }
                    acc[ai][bj][m][0] = acc[ai][bj][m][0] * (d0 * f0); acc[ai][bj][m][1] = acc[ai][bj][m][1] * (d1 * f1); }
                asm volatile("" ::: "memory"); }
    }
    __device__ __forceinline__ void operator()(const Acc& acc, const Unit& u, int wr, int wc, int fr, int fq) const {
        const int row0 = u.pm * BM + wr * 64 + fr, col0 = u.pn * BM + wc * 32 + 8 * fq;
#pragma unroll
        for (int ai = 0; ai < 2; ++ai)
#pragma unroll
            for (int m = 0; m < 4; ++m) { const int r = row0 + ai * HALF + m * 16;
#pragma unroll
                for (int bj = 0; bj < 2; ++bj) { const int c = col0 + bj * HALF; const u32x4 gw = *(const u32x4*)(G + (size_t)r * 4096 + 2048 + c);
                    const f32x4 g0 = {bf_lo(gw.x), bf_hi(gw.x), bf_lo(gw.y), bf_hi(gw.y)}, g1 = {bf_lo(gw.z), bf_hi(gw.z), bf_lo(gw.w), bf_hi(gw.w)};
                    *(u32x4*)(MB + (size_t)r * DM + c) = pack8(acc[ai][bj][m][0] * g0, acc[ai][bj][m][1] * g1); } }
    }
};
struct EpiZ {
    const float* X; float* Z;
    __device__ __forceinline__ void operator()(const Acc& acc, const Unit& u, int wr, int wc, int fr, int fq) const {
        const int row0 = u.pm * BM + wr * 64 + fr, col0 = u.pn * BM + wc * 32 + 8 * fq;
#pragma unroll
        for (int ai = 0; ai < 2; ++ai)
#pragma unroll
            for (int m = 0; m < 4; ++m) { const int r = row0 + ai * HALF + m * 16;
#pragma unroll
                for (int bj = 0; bj < 2; ++bj) { const size_t o = (size_t)r * DM + col0 + bj * HALF;
                    const f32x4 x0 = *(const f32x4*)(X + o), x1 = *(const f32x4*)(X + o + 4);
                    *(f32x4*)(Z + o) = x0 * ALPHA + acc[ai][bj][m][0]; *(f32x4*)(Z + o + 4) = x1 * ALPHA + acc[ai][bj][m][1]; } }
    }
};
struct EpiSwiGLU {
    bf16_t* H;
    __device__ __forceinline__ void operator()(const Acc& acc, const Unit& u, int wr, int wc, int fr, int fq) const {
        const int row0 = u.pm * BM + wr * 64 + fr, col0 = u.pn * HALF + wc * 32 + 8 * fq;
#pragma unroll
        for (int ai = 0; ai < 2; ++ai)
#pragma unroll
            for (int m = 0; m < 4; ++m) { const int r = row0 + ai * HALF + m * 16; f32x4 h[2];
#pragma unroll
                for (int n = 0; n < 2; ++n) { const f32x4 gt = acc[ai][0][m][n], up = acc[ai][1][m][n]; h[n] = gt * sigmoid4(gt) * up; }
                *(u32x4*)(H + (size_t)r * FF + col0) = pack8(h[0], h[1]); }
    }
};
struct EpiY {
    bf16_t* Y;
    __device__ __forceinline__ void operator()(const Acc& acc, const Unit& u, int wr, int wc, int fr, int fq) const {
        const int row0 = u.pm * BM + wr * 64 + fr, col0 = (u.pn & 7) * BM + wc * 32 + 8 * fq;
#pragma unroll
        for (int ai = 0; ai < 2; ++ai)
#pragma unroll
            for (int m = 0; m < 4; ++m) { const int r = row0 + ai * HALF + m * 16;
#pragma unroll
                for (int bj = 0; bj < 2; ++bj) *(u32x4*)(Y + (size_t)r * DM + col0 + bj * HALF) = pack8(acc[ai][bj][m][0], acc[ai][bj][m][1]); }
    }
};
}

namespace att {
using bf16 = __hip_bfloat16;
constexpr int D = 128, NW = 8, QBLK = 32, KVBLK = 64, QB = NW * QBLK;
constexpr int SHM_V = KVBLK * D * 2, SHM_K = KVBLK * D * 2;
constexpr int LDS_WS_OFF = 2 * SHM_V + 2 * SHM_K, LDS_BIAS_OFF = LDS_WS_OFF + NW * 64 * 4, LDS_BYTES = LDS_BIAS_OFF + 512;
constexpr float SCALE = 0.08838834764831845f;
constexpr float THR = 8.f;
#define KSWZ(row, colB) ((row) * 256 + ((colB) ^ (((row) & 7) << 4)))
#define SBAR() __builtin_amdgcn_sched_barrier(0)
__device__ __forceinline__ int v_st(int k, int c) { const int kk = (k & ~0xC) | ((k & 4) << 1) | ((k & 8) >> 1); return ((kk >> 3) * 4 + (c >> 5)) * 512 + ((kk & 7) * 32 + (c & 31)) * 2; }
__device__ __forceinline__ int v_rd_base(int lane) { return ((lane & 3) << 3) | (((lane >> 2) & 3) << 6) | (((lane >> 4) & 1) << 5) | (((lane >> 5) & 1) << 8); }
constexpr int v_rd_off(int d0, int ks, int half) { return d0 * 512 + ks * 4096 + half * 2048; }
__device__ __forceinline__ int crow(int r, int hi) { return (r & 3) + 8 * (r >> 2) + 4 * hi; }
__device__ __forceinline__ unsigned cvtpk(float lo, float hi) { unsigned r; asm volatile("v_cvt_pk_bf16_f32 %0, %1, %2" : "=v"(r) : "v"(lo), "v"(hi)); return r; }
__device__ __forceinline__ bf16x8 load8(const bf16* p) { return *reinterpret_cast<const bf16x8*>(p); }
__device__ __forceinline__ void mask_tile(f32x16& p0, f32x16& p1, int dq) {
    const float NEG = -__builtin_inff();
#pragma unroll
    for (int r = 0; r < 16; ++r) { const int c = (r & 3) + 8 * (r >> 2); if (dq - c < 0) p0[r] = NEG; if (dq - c - 32 < 0) p1[r] = NEG; }
}
__device__ __forceinline__ void partialSM(f32x16& p0, f32x16& p1, float& m_reg, float& mn, float& alpha) {
    float pmax = p0[0];
#pragma unroll
    for (int r = 1; r < 16; ++r) pmax = fmaxf(pmax, p0[r]);
#pragma unroll
    for (int r = 0; r < 16; ++r) pmax = fmaxf(pmax, p1[r]);
    { auto rr = __builtin_amdgcn_permlane32_swap(__float_as_uint(pmax), __float_as_uint(pmax), false, false); pmax = fmaxf(__uint_as_float(rr[0]), __uint_as_float(rr[1])); }
    constexpr float C2 = 1.4426950408889634f * SCALE;
    if (__builtin_expect(__all((pmax - m_reg) * SCALE <= THR), 1)) { mn = m_reg; alpha = 1.f; }
    else { mn = fmaxf(m_reg, pmax); alpha = __builtin_amdgcn_exp2f((m_reg - mn) * C2); m_reg = mn; }
    const float mnL = -mn * C2;
#pragma unroll
    for (int r = 0; r < 16; ++r) p0[r] = fmaf(p0[r], C2, mnL);
#pragma unroll
    for (int r = 0; r < 16; ++r) p1[r] = fmaf(p1[r], C2, mnL);
#pragma unroll
    for (int r = 0; r < 16; ++r) p0[r] = __builtin_amdgcn_exp2f(p0[r]);
}
__device__ __forceinline__ void finishSM(f32x16& p0, f32x16& p1, float alpha, float& l_reg, bf16x8& pa0, bf16x8& pa1, bf16x8& pa2, bf16x8& pa3) {
#pragma unroll
    for (int r = 0; r < 16; ++r) p1[r] = __builtin_amdgcn_exp2f(p1[r]);
    float ps = 0;
#pragma unroll
    for (int r = 0; r < 16; ++r) ps += p0[r];
#pragma unroll
    for (int r = 0; r < 16; ++r) ps += p1[r];
    { auto rr = __builtin_amdgcn_permlane32_swap(__float_as_uint(ps), __float_as_uint(ps), false, false); ps = __uint_as_float(rr[0]) + __uint_as_float(rr[1]); }
    l_reg = l_reg * alpha + ps;
#define PK4(P, B_, OUT) do { unsigned a0 = cvtpk(P[B_+0], P[B_+1]), a1 = cvtpk(P[B_+2], P[B_+3]);                          \
        unsigned b0 = cvtpk(P[B_+4], P[B_+5]), b1 = cvtpk(P[B_+6], P[B_+7]);                                             \
        auto r0 = __builtin_amdgcn_permlane32_swap(a0, b0, false, false); auto r1 = __builtin_amdgcn_permlane32_swap(a1, b1, false, false); \
        u32x4 w = {r0[0], r1[0], r0[1], r1[1]}; OUT = *reinterpret_cast<bf16x8*>(&w); } while (0)
    PK4(p0, 0, pa0); PK4(p0, 8, pa1); PK4(p1, 0, pa2); PK4(p1, 8, pa3);
#undef PK4
}
template <int KB>
__device__ __forceinline__ void qkt(f32x16& p0, f32x16& p1, const char* K_lds, const char* B_lds, int r32, int hi, const bf16x8* qr) {
    const float* bl = (const float*)(B_lds + KB * 256) + 4 * hi;
#pragma unroll
    for (int g = 0; g < 4; ++g) { const f32x4 b0 = *(const f32x4*)(bl + 8 * g), b1 = *(const f32x4*)(bl + 32 + 8 * g);
#pragma unroll
        for (int i = 0; i < 4; ++i) { p0[4 * g + i] = b0[i]; p1[4 * g + i] = b1[i]; } }
    const char* kb[4];
#pragma unroll
    for (int dd = 0; dd < 4; ++dd) kb[dd] = K_lds + KB * SHM_K + KSWZ(r32, (dd * 16 + hi * 8) * 2);
#pragma unroll
    for (int d0 = 0; d0 < 8; ++d0) { const char* a = kb[d0 & 3] + (d0 >> 2) * 128;
        bf16x8 b0 = *reinterpret_cast<const bf16x8*>(a);
        bf16x8 b1 = *reinterpret_cast<const bf16x8*>(a + 32 * 256);
        p0 = __builtin_amdgcn_mfma_f32_32x32x16_bf16(b0, qr[d0], p0, 0, 0, 0);
        p1 = __builtin_amdgcn_mfma_f32_32x32x16_bf16(b1, qr[d0], p1, 0, 0, 0); }
}
template <int VB>
__device__ __forceinline__ void pv_tile(f32x16* o, int vb0, bf16x8 pa0, bf16x8 pa1, bf16x8 pa2, bf16x8 pa3) {
#define TRRD(dst, off) asm volatile("ds_read_b64_tr_b16 %0, %1 offset:%2" : "=&v"(dst) : "v"(vb0), "i"(off) : "memory")
#define PV_D0(d0) do { s16x4 l0, l1, l2, l3, h0, h1, h2, h3; constexpr int b_ = VB * SHM_V + v_rd_off(d0, 0, 0); \
        TRRD(l0, b_); TRRD(h0, b_ + 2048); TRRD(l1, b_ + 4096); TRRD(h1, b_ + 6144); TRRD(l2, b_ + 8192); TRRD(h2, b_ + 10240); TRRD(l3, b_ + 12288); TRRD(h3, b_ + 14336); \
        asm volatile("s_waitcnt lgkmcnt(0)" ::: "memory"); SBAR();   \
        o[d0] = __builtin_amdgcn_mfma_f32_32x32x16_bf16(pa0, (bf16x8){l0[0], l0[1], l0[2], l0[3], h0[0], h0[1], h0[2], h0[3]}, o[d0], 0, 0, 0);   \
        o[d0] = __builtin_amdgcn_mfma_f32_32x32x16_bf16(pa1, (bf16x8){l1[0], l1[1], l1[2], l1[3], h1[0], h1[1], h1[2], h1[3]}, o[d0], 0, 0, 0);   \
        o[d0] = __builtin_amdgcn_mfma_f32_32x32x16_bf16(pa2, (bf16x8){l2[0], l2[1], l2[2], l2[3], h2[0], h2[1], h2[2], h2[3]}, o[d0], 0, 0, 0);   \
        o[d0] = __builtin_amdgcn_mfma_f32_32x32x16_bf16(pa3, (bf16x8){l3[0], l3[1], l3[2], l3[3], h3[0], h3[1], h3[2], h3[3]}, o[d0], 0, 0, 0); } while (0)
    PV_D0(0); PV_D0(1); PV_D0(2); PV_D0(3);
#undef PV_D0
#undef TRRD
}
struct BlockRef { const bf16* Q; const bf16* K; const bf16* V; const float* B; bf16* O; int ostride; int P0; int jlo; };
struct Seam { bf16x8 qr[8]; bf16x8 st_v0, st_v1, st_k0, st_k1; };
#define ROW(p, k0, rr) ((p) + (size_t)((k0) + (rr)) * D + sc)
#define VMW() asm volatile("s_waitcnt vmcnt(0)" ::: "memory")
#define VMWN(n) asm volatile("s_waitcnt vmcnt(%0)" :: "i"(n) : "memory")
#define SLOAD_H(Kp, Vp, k0) do { S.st_v0 = load8(ROW(Vp, k0, sr)); S.st_v1 = load8(ROW(Vp, k0, 32 + sr));              \
                         S.st_k0 = load8(ROW(Kp, k0, sr)); S.st_k1 = load8(ROW(Kp, k0, 32 + sr)); } while (0)
#define BLOAD(Bp, k0, bf) do { if (wid == 0) __builtin_amdgcn_global_load_lds((const unsigned*)((Bp) + (k0) + lane), (LAS unsigned*)(lds3 + LDS_BIAS_OFF + (bf) * 256), 4, 0, 0); } while (0)
#define SWRITE_HK(bf) do { *(bf16x8*)(K_lds + (bf) * SHM_K + kws) = S.st_k0; *(bf16x8*)(K_lds + (bf) * SHM_K + kws + 32 * 256) = S.st_k1; } while (0)
#define SWRITE_HV(bf) do { *(bf16x8*)(V_lds + (bf) * SHM_V + vst0) = S.st_v0; *(bf16x8*)(V_lds + (bf) * SHM_V + vst1) = S.st_v1; } while (0)
#define SWRITE_H(bf) do { SWRITE_HV(bf); SWRITE_HK(bf); } while (0)
__device__ __forceinline__ void attn_prime(const BlockRef& cur, char* lds, LAS unsigned char* lds3, Seam& S) {
    int tid = threadIdx.x; asm volatile("" : "+v"(tid)); const int wid = __builtin_amdgcn_readfirstlane(tid >> 6), lane = tid & 63, r32 = lane & 31, hi = lane >> 5;
    const int sr = tid >> 4, sc = (tid & 15) * 8, kws = KSWZ(sr, sc * 2); char* K_lds = lds + 2 * SHM_V;
#pragma unroll
    for (int d0 = 0; d0 < 8; ++d0) S.qr[d0] = load8(cur.Q + (size_t)(wid * QBLK + r32) * D + d0 * 16 + hi * 8);
    SLOAD_H(cur.K, cur.V, 0); BLOAD(cur.B, 0, 0); VMW(); SWRITE_HK(0);
    __syncthreads();
}
__device__ __forceinline__ void attn_block(const BlockRef& cur, const BlockRef& nxt, char* lds, LAS unsigned char* lds3, Seam& S) {
    int tid = threadIdx.x; asm volatile("" : "+v"(tid)); const int wid = __builtin_amdgcn_readfirstlane(tid >> 6), lane = tid & 63, r32 = lane & 31, hi = lane >> 5;
    const int NT = (cur.P0 + QB) / KVBLK - cur.jlo;
    const int qlo = cur.P0 + wid * QBLK, qm = qlo + r32 - 4 * hi;
    char* V_lds = lds; char* K_lds = lds + 2 * SHM_V; const char* B_lds = lds + LDS_BIAS_OFF;
    float* ws = (float*)(lds + LDS_WS_OFF) + wid * 64; float* li_l = ws, * al_l = ws + 32;
    float m_reg = -1e30f, l_reg = 0; f32x16 o[4] = {};
    const int sr = tid >> 4, sc = (tid & 15) * 8, vst0 = v_st(sr, sc), vst1 = v_st(32 + sr, sc), kws = KSWZ(sr, sc * 2);
    const int vb0 = (int)(uintptr_t)V_lds + v_rd_base(lane);
    const bf16* Kh = cur.K; const bf16* Vh = cur.V; const float* Bh = cur.B;
#define RESC(a) do { if (__any((a) < 1.f)) { if (hi == 0) al_l[r32] = (a); asm volatile("s_waitcnt lgkmcnt(0)" ::: "memory");              \
                     _Pragma("unroll") for (int d_ = 0; d_ < 4; ++d_) _Pragma("unroll") for (int r = 0; r < 16; ++r) o[d_][r] *= al_l[crow(r, hi)]; } } while (0)
#define KBASE(t) ((t) * KVBLK)
#define MASKT(P0_, P1_, t) do { const int kb_ = KBASE((t) + cur.jlo); if (kb_ + KVBLK - 1 > qlo) mask_tile(P0_, P1_, qm - kb_); } while (0)
    f32x16 pA0, pA1, pB0, pB1; float mnA, mnB, alA, alB; bf16x8 pa0, pa1, pa2, pa3;
    SWRITE_HV(0); SBAR();
    SLOAD_H(Kh, Vh, KBASE(1)); BLOAD(Bh, KBASE(1), 1);
    SBAR(); qkt<0>(pA0, pA1, K_lds, B_lds, r32, hi, S.qr);
    MASKT(pA0, pA1, 0); partialSM(pA0, pA1, m_reg, mnA, alA);
    VMW(); SWRITE_H(1);
    __syncthreads();
#define HALF_STEP(PX0, PX1, mnX, alX, PY0, PY1, alY, t, KB, VB, SB) do {                                                      \
        SBAR(); qkt<KB>(PX0, PX1, K_lds, B_lds, r32, hi, S.qr);                                                               \
        finishSM(PY0, PY1, alY, l_reg, pa0, pa1, pa2, pa3); SBAR();                                                           \
        if ((t) + 1 < NT) { SLOAD_H(Kh, Vh, KBASE((t) + 1)); BLOAD(Bh, KBASE((t) + 1), SB); SBAR(); }                        \
        pv_tile<VB>(o, vb0, pa0, pa1, pa2, pa3); MASKT(PX0, PX1, (t)); partialSM(PX0, PX1, m_reg, mnX, alX);                  \
        __syncthreads();                                                                                                      \
        if ((t) + 1 < NT) { VMW(); SWRITE_H(SB); }                                                                            \
        RESC(alX); __syncthreads(); } while (0)
    for (int t = 1; t + 1 < NT; t += 2) {
        HALF_STEP(pB0, pB1, mnB, alB, pA0, pA1, alA, t, 1, 0, 0);
        HALF_STEP(pA0, pA1, mnA, alA, pB0, pB1, alB, t + 1, 0, 1, 1);
    }
    SBAR(); qkt<1>(pB0, pB1, K_lds, B_lds, r32, hi, S.qr); SBAR();
    SLOAD_H(nxt.K, nxt.V, 0); BLOAD(nxt.B, 0, 0); SBAR();
#pragma unroll
    for (int d0 = 0; d0 < 8; ++d0) S.qr[d0] = load8(nxt.Q + (size_t)(wid * QBLK + r32) * D + d0 * 16 + hi * 8);
    SBAR();
    finishSM(pA0, pA1, alA, l_reg, pa0, pa1, pa2, pa3); SBAR();
    pv_tile<0>(o, vb0, pa0, pa1, pa2, pa3);
    MASKT(pB0, pB1, NT - 1); partialSM(pB0, pB1, m_reg, mnB, alB); __syncthreads(); RESC(alB);
    finishSM(pB0, pB1, alB, l_reg, pa0, pa1, pa2, pa3); SBAR(); pv_tile<1>(o, vb0, pa0, pa1, pa2, pa3);
    SBAR(); VMWN(8); SWRITE_HK(0); SBAR();
    if (hi == 0) li_l[r32] = l_reg; asm volatile("s_waitcnt lgkmcnt(0)" ::: "memory");
    float rli[16];
#pragma unroll
    for (int r = 0; r < 16; ++r) rli[r] = __builtin_amdgcn_rcpf(li_l[crow(r, hi)]);
    bf16* Ow = cur.O + (size_t)(wid * QBLK) * cur.ostride;
#pragma unroll
    for (int r = 0; r < 16; ++r) { const int orow = crow(r, hi);
#pragma unroll
        for (int d0 = 0; d0 < 4; ++d0) { const float v = o[d0][r] * rli[r];
            const float vn = __shfl_xor(v, 1);
            if ((r32 & 1) == 0) *(unsigned*)(Ow + (size_t)orow * cur.ostride + d0 * 32 + r32) = cvtpk(v, vn); } }
    __syncthreads();
#undef RESC
#undef KBASE
#undef MASKT
#undef HALF_STEP
}

constexpr int DK_OFF = 49152, DWS_OFF = 81920, DV1_OFF = 83968, DP_OFF = 133120, DATT_LDS_END = DP_OFF + 16384;
struct DRef { const bf16* Q; const bf16* K; const bf16* V0; const bf16* V1; bf16* O0; bf16* O1; int P0; };
struct DSeam { bf16x8 r[12]; };
template <int KB>
__device__ __forceinline__ void qkt0(f32x16& p0, f32x16& p1, const char* K_lds, int r32, int hi, const bf16x8* qr) {
    p0 = f32x16{}; p1 = f32x16{};
    const char* kb[4];
#pragma unroll
    for (int dd = 0; dd < 4; ++dd) kb[dd] = K_lds + KB * SHM_K + KSWZ(r32, (dd * 16 + hi * 8) * 2);
#pragma unroll
    for (int d0 = 0; d0 < 8; ++d0) { const char* a = kb[d0 & 3] + (d0 >> 2) * 128;
        bf16x8 b0 = *reinterpret_cast<const bf16x8*>(a);
        bf16x8 b1 = *reinterpret_cast<const bf16x8*>(a + 32 * 256);
        p0 = __builtin_amdgcn_mfma_f32_32x32x16_bf16(b0, qr[d0], p0, 0, 0, 0);
        p1 = __builtin_amdgcn_mfma_f32_32x32x16_bf16(b1, qr[d0], p1, 0, 0, 0); }
}
#define D_KLOAD(Kp, k0) do { _Pragma("unroll") for (int j_ = 0; j_ < 4; ++j_) S.r[8 + j_] = load8((Kp) + (size_t)((k0) + sr + 16 * j_) * D + sc); } while (0)
#define D_KWRITE(bf) do { _Pragma("unroll") for (int j_ = 0; j_ < 4; ++j_) *(bf16x8*)(K_lds + (bf) * SHM_K + kws + j_ * 4096) = S.r[8 + j_]; } while (0)
#define D_VLOAD(V0p, V1p, k0) do { unsigned vo_ = (unsigned)(sr * D + sc) * 2u; asm volatile("" : "+v"(vo_));   \
        _Pragma("unroll") for (int j_ = 0; j_ < 4; ++j_) { S.r[j_] = load8((const bf16*)((const char*)((V0p) + (size_t)((k0) + 16 * j_) * D) + vo_)); S.r[4 + j_] = load8((const bf16*)((const char*)((V1p) + (size_t)((k0) + 16 * j_) * D) + vo_)); } } while (0)
#define D_VWRITE(sl_) do { _Pragma("unroll") for (int j_ = 0; j_ < 4; ++j_) { *(bf16x8*)(V_lds + (sl_) * SHM_V + vst[j_]) = S.r[j_]; *(bf16x8*)(V1_lds + (sl_) * SHM_V + vst[j_]) = S.r[4 + j_]; } } while (0)
#define D_PEXPORT() do { bf16x8* pp_ = (bf16x8*)P_lds + lane; pp_[0] = pa0; pp_[64] = pa1; pp_[128] = pa2; pp_[192] = pa3; } while (0)
#define D_PIMPORT() do { const bf16x8* pp_ = (const bf16x8*)P_lds + lane; pa0 = pp_[0]; pa1 = pp_[64]; pa2 = pp_[128]; pa3 = pp_[192]; } while (0)
#define D_AEXPORT(par, a) do { if (hi == 0) al_l[(par) * 32 + r32] = (a); } while (0)
#define D_RESC(par) do { const float* ap_ = al_l + (par) * 32; const float a_ = ap_[r32]; if (__any(a_ < 1.f)) { _Pragma("unroll") for (int d_ = 0; d_ < 4; ++d_) _Pragma("unroll") for (int r = 0; r < 16; ++r) { const float f_ = ap_[crow(r, hi)]; o0[d_][r] *= f_; o1[d_][r] *= f_; } } } while (0)
#define D_OSTORE(Op, oo) do { bf16* Ow = (Op) + (size_t)((wid & 3) * QBLK) * D; \
        _Pragma("unroll") for (int r = 0; r < 16; ++r) { const int orow = crow(r, hi); \
            const float rl_ = __builtin_amdgcn_rcpf(li_l[orow]); \
            _Pragma("unroll") for (int d0 = 0; d0 < 4; ++d0) { const float v = oo[d0][r] * rl_; const float vn = __shfl_xor(v, 1); \
                if ((r32 & 1) == 0) *(unsigned*)(Ow + (size_t)orow * D + d0 * 32 + r32) = cvtpk(v, vn); } } } while (0)
__device__ __forceinline__ void dattn_prime(const DRef& cur, char* lds, DSeam& S) {
    int tid = threadIdx.x; asm volatile("" : "+v"(tid)); const int wid = __builtin_amdgcn_readfirstlane(tid >> 6), lane = tid & 63, r32 = lane & 31, hi = lane >> 5;
    const int t8 = tid & 255, sr = t8 >> 4, sc = (t8 & 15) * 8, kws = KSWZ(sr, sc * 2); char* K_lds = lds + DK_OFF;
    if (wid < 4) {
#pragma unroll
        for (int d0 = 0; d0 < 8; ++d0) S.r[d0] = load8(cur.Q + (size_t)(wid * QBLK + r32) * D + d0 * 16 + hi * 8);
        D_KLOAD(cur.K, 0); VMW(); D_KWRITE(0);
    } else { D_VLOAD(cur.V0, cur.V1, 0); }
    __syncthreads();
}
__device__ __forceinline__ void dattn_block(const DRef& cur, const DRef& nxt, char* lds, DSeam& S) {
    int tid = threadIdx.x; asm volatile("" : "+v"(tid)); const int wid = __builtin_amdgcn_readfirstlane(tid >> 6), lane = tid & 63, r32 = lane & 31, hi = lane >> 5;
    const int NT = (cur.P0 + 128) / KVBLK;
    const int t8 = tid & 255, sr = t8 >> 4, sc = (t8 & 15) * 8;
    char* V_lds = lds; char* K_lds = lds + DK_OFF; char* V1_lds = lds + DV1_OFF; char* P_lds = lds + DP_OFF + (wid & 3) * 4096;
    float* ws = (float*)(lds + DWS_OFF) + (wid & 3) * 128; float* li_l = ws, * al_l = ws + 32;
    bf16x8 pa0, pa1, pa2, pa3;
#define KBASE(t) ((t) * KVBLK)
    if (wid < 4) {
        const int qlo = cur.P0 + wid * QBLK, qm = qlo + r32 - 4 * hi, kws = KSWZ(sr, sc * 2);
        float m_reg = -1e30f, l_reg = 0; const bf16* Kh = cur.K;
        f32x16 pA0, pA1, pB0, pB1; float mnA, mnB, alA = 1.f, alB = 1.f;
#define MASKT(P0_, P1_, t) do { const int kb_ = KBASE(t); if (kb_ + KVBLK - 1 > qlo) mask_tile(P0_, P1_, qm - kb_); } while (0)
#define SSTEP(PX0, PX1, mnX, alX, PY0, PY1, alY, t, KB, FS) do {                                                              \
        SBAR(); qkt0<KB>(PX0, PX1, K_lds, r32, hi, S.r);                                                                     \
        if (FS) { finishSM(PY0, PY1, alY, l_reg, pa0, pa1, pa2, pa3); D_PEXPORT(); } SBAR();                                  \
        if ((t) + 1 < NT) { D_KLOAD(Kh, KBASE((t) + 1)); }                                                                    \
        else { D_KLOAD(nxt.K, 0); SBAR();                                                                                     \
               _Pragma("unroll") for (int d0 = 0; d0 < 8; ++d0) S.r[d0] = load8(nxt.Q + (size_t)(wid * QBLK + r32) * D + d0 * 16 + hi * 8); }   \
        SBAR(); __syncthreads();                                                                                     \
        MASKT(PX0, PX1, (t)); partialSM(PX0, PX1, m_reg, mnX, alX); D_AEXPORT(KB, alX);                                       \
        if ((t) + 1 < NT) { VMW(); } else { VMWN(8); }                                                                        \
        D_KWRITE((KB) ^ 1); SBAR();                                                                                           \
        __syncthreads();                                                                                             \
        } while (0)
        SSTEP(pA0, pA1, mnA, alA, pB0, pB1, alB, 0, 0, false);
        for (int t = 1; t < NT; t += 2) {
            SSTEP(pB0, pB1, mnB, alB, pA0, pA1, alA, t, 1, true);
            if (t + 1 < NT) SSTEP(pA0, pA1, mnA, alA, pB0, pB1, alB, t + 1, 0, true);
        }
        finishSM(pB0, pB1, alB, l_reg, pa0, pa1, pa2, pa3); D_PEXPORT(); if (hi == 0) li_l[r32] = l_reg;
        __syncthreads();
        __syncthreads();
#undef MASKT
#undef SSTEP
    } else {
        f32x16 o0[4] = {}, o1[4] = {};
        int vst[4];
#pragma unroll
        for (int j_ = 0; j_ < 4; ++j_) vst[j_] = v_st(sr + 16 * j_, sc);
        const int vb0 = (int)(uintptr_t)V_lds + v_rd_base(lane), vb1 = (int)(uintptr_t)V1_lds + v_rd_base(lane);
        D_VWRITE(0); SBAR();
        int s_prev = 2, s_next = 1;
        for (int t = 0; t < NT; ++t) {
            if (t + 1 < NT) D_VLOAD(cur.V0, cur.V1, KBASE(t + 1)); else D_VLOAD(nxt.V0, nxt.V1, 0);
            __syncthreads();
            if (t + 1 < NT) { VMW(); D_VWRITE(s_next); }
            if (t >= 1) { D_RESC((t - 1) & 1); D_PIMPORT(); asm volatile("s_waitcnt lgkmcnt(0)" ::: "memory");
                pv_tile<0>(o0, vb0 + s_prev * SHM_V, pa0, pa1, pa2, pa3); pv_tile<0>(o1, vb1 + s_prev * SHM_V, pa0, pa1, pa2, pa3); }
            __syncthreads();
            s_prev = (s_prev == 2) ? 0 : s_prev + 1; s_next = (s_next == 2) ? 0 : s_next + 1;
        }
        __syncthreads();
        D_RESC((NT - 1) & 1); D_PIMPORT(); asm volatile("s_waitcnt lgkmcnt(0)" ::: "memory");
        pv_tile<0>(o0, vb0 + s_prev * SHM_V, pa0, pa1, pa2, pa3); pv_tile<0>(o1, vb1 + s_prev * SHM_V, pa0, pa1, pa2, pa3);
        D_OSTORE(cur.O0, o0); D_OSTORE(cur.O1, o1);
        __syncthreads();
    }
#undef KBASE
}
#undef D_KLOAD
#undef D_KWRITE
#undef D_VLOAD
#undef D_VWRITE
#undef D_PEXPORT
#undef D_PIMPORT
#undef D_AEXPORT
#undef D_RESC
#undef D_OSTORE
#undef ROW
#undef VMW
#undef VMWN
#undef SLOAD_H
#undef BLOAD
#undef SWRITE_HK
#undef SWRITE_HV
#undef SWRITE_H
#undef KSWZ
#undef SBAR
}

constexpr size_t MiB = 1u << 20, KiB = 1u << 10;
constexpr size_t WS_CTL = 0, CTL_ZERO_BYTES = 1 * MiB;
constexpr size_t WS_FLOG = 1 * MiB, WS_FBIAS = WS_FLOG + 256 * KiB, WS_ZEROB = WS_FBIAS + 256 * KiB, WS_WRT = WS_ZEROB + 64 * KiB;
constexpr size_t WS_NP = 1920 * KiB;
constexpr size_t WS_TOKINFO = 2 * MiB, WS_LIST = 3 * MiB;
constexpr size_t WS_ROPE = 4 * MiB;
constexpr size_t WS_WPC = 8 * MiB, WS_WOUT = 16 * MiB, WS_WIN = 24 * MiB, WS_WGU = 64 * MiB, WS_WD = 192 * MiB;
constexpr size_t WS_QKV = 256 * MiB, WS_G = 352 * MiB, WS_XB = 416 * MiB, WS_OD = 416 * MiB, WS_ACAT = 448 * MiB;
constexpr size_t WS_MB = 256 * MiB, WS_Z = 288 * MiB, WS_X1B = 352 * MiB, WS_H = 384 * MiB, WS_Y = 408 * MiB, WS_END = 504 * MiB;
constexpr int CW_TMO = 0, CW_BAR = 4096, CW_ATTQ = 8192, CW_ECNT = 12288, CW_QN = 16384, CW_KN = 17408, CW_DQ = 18560;
constexpr int HROWS = 24576;

constexpr int RING_OFF = 0, RING_BYTES = 131072;
constexpr int SM_OFF = 135168;
constexpr int LDSCTL_OFF = 155648, MISC_OFF = LDSCTL_OFF + 320;
constexpr int LDS_BYTES = 163840;
static_assert(att::DATT_LDS_END <= LDSCTL_OFF, "attention LDS map");

#define RLX_AGENT __ATOMIC_RELAXED, __HIP_MEMORY_SCOPE_AGENT
#define LDS_WAIT() asm volatile("s_waitcnt lgkmcnt(0)" ::: "memory")
#define VM_WAIT() asm volatile("s_waitcnt vmcnt(0)" ::: "memory")

#define XB_TMO      128
#define XB_XCNT(j)  (256  + 64 * (j))
#define XB_XSUB(j)  (1280 + 64 * (j))
#define XB_XGEN(j)  (2304 + 64 * (j))
#define XB_TOP      3328
#define XB_TOPGEN   3392
#define XCD_BAR_WORDS 3456
#define XB_SPIN_CAP (1u << 18)
__device__ __forceinline__ unsigned xb_ld(unsigned* p)              { return __hip_atomic_load(p, __ATOMIC_RELAXED, __HIP_MEMORY_SCOPE_AGENT); }
__device__ __forceinline__ unsigned xb_add(unsigned* p, unsigned v) { return __hip_atomic_fetch_add(p, v, __ATOMIC_RELAXED, __HIP_MEMORY_SCOPE_AGENT); }
__device__ __forceinline__ unsigned xb_xcc_id() { return (unsigned)__builtin_amdgcn_s_getreg((3 << 11) | 20) & 0xFu; }
#define XB_SPIN(cond, bar) do { unsigned _sp = 0; while (cond) { __builtin_amdgcn_s_sleep(1); \
    if ((++_sp & 255u) == 0u) { if (xb_ld(&(bar)[XB_TMO])) break; if (_sp > XB_SPIN_CAP) { atomicAdd(&(bar)[XB_TMO], 1u); break; } } } } while (0)
struct XcdBarrier { unsigned* bar; unsigned x; volatile LAS unsigned* st; };
__device__ __forceinline__ XcdBarrier xcd_barrier_post(unsigned* bar, volatile LAS unsigned* st) {
    XcdBarrier b; b.bar = bar; b.x = xb_xcc_id(); b.st = st;
    if (threadIdx.x == 0) (void)xb_add(&bar[XB_XCNT(b.x)], 1u);
    return b;
}
__device__ __forceinline__ void xcd_barrier_complete(unsigned* bar, unsigned x, unsigned& nloc, unsigned& nx) {
    const unsigned G = gridDim.x * gridDim.y * gridDim.z;
    unsigned sum, cnt, mine, sp = 0u;
    for (;;) {
        sum = 0u; cnt = 0u; mine = 0u;
#pragma unroll
        for (unsigned j = 0; j < 16; ++j) { const unsigned c = xb_ld(&bar[XB_XCNT(j)]); sum += c; cnt += (c > 0u) ? 1u : 0u; mine = (j == x) ? c : mine; }
        if (sum == G) break;
        __builtin_amdgcn_s_sleep(1);
        if ((++sp & 255u) == 0u) { if (xb_ld(&bar[XB_TMO])) break; if (sp > XB_SPIN_CAP) { atomicAdd(&bar[XB_TMO], 1u); break; } }
    }
    nloc = mine > 0u ? mine : 1u; nx = cnt > 0u ? cnt : 1u;
}
__device__ __forceinline__ void xcd_barrier(const XcdBarrier& b) {
    asm volatile("s_waitcnt vmcnt(0)" ::: "memory");
    __syncthreads();
    if (threadIdx.x == 0) {
        unsigned* bar = b.bar;
        __builtin_amdgcn_s_waitcnt(0);
        unsigned nloc = b.st[0], nx = b.st[1];
        if (nloc == 0u) { xcd_barrier_complete(bar, b.x, nloc, nx); b.st[0] = nloc; b.st[1] = nx; }
        const unsigned old = xb_add(&bar[XB_XSUB(b.x)], 1u);
        const unsigned gen = old / nloc;
        if (old + 1u == (gen + 1u) * nloc) {
            __builtin_amdgcn_fence(__ATOMIC_RELEASE, "agent");
            asm volatile("s_waitcnt vmcnt(0)" ::: "memory");
            const unsigned og = xb_add(&bar[XB_TOP], 1u);
            const unsigned tg = og / nx;
            if (og + 1u == (tg + 1u) * nx) xb_add(&bar[XB_TOPGEN], 1u);
            else XB_SPIN(xb_ld(&bar[XB_TOPGEN]) == tg, bar);
            __builtin_amdgcn_fence(__ATOMIC_ACQUIRE, "agent");
            xb_add(&bar[XB_XGEN(b.x)], 1u);
            asm volatile("s_waitcnt vmcnt(0)" ::: "memory");
        } else {
            XB_SPIN(xb_ld(&bar[XB_XGEN(b.x)]) == gen, bar);
            __builtin_amdgcn_fence(__ATOMIC_ACQUIRE, "agent");
            asm volatile("s_waitcnt vmcnt(0)" ::: "memory");
        }
    }
    __syncthreads();
}

constexpr int NWAVES = 8, NPHASE = 11;
struct Args { const float* in[22]; float* out; unsigned char* ws; int ph_lo, ph_hi; };
struct Frame {
    LAS unsigned char* lds; volatile LAS unsigned* MISC; unsigned* ctl;
    int tid, lane, wave, vcu, G;
};

template <class RM>
__device__ __forceinline__ void tr_item(const float* W, int N, int k0, int nsrc0, bf16_t* WT, int ldw, int kdst, const RM& rowmap, LAS float* scr, int lane) {
    const int lr = lane >> 4, lc = (lane & 15) * 4;
#pragma unroll 4
    for (int i = 0; i < 16; ++i) { const int kk = 4 * i + lr; const f32x4 v = *(const f32x4*)(W + (size_t)(k0 + kk) * N + nsrc0 + lc);
        scr[kk * 65 + lc] = v[0]; scr[kk * 65 + lc + 1] = v[1]; scr[kk * 65 + lc + 2] = v[2]; scr[kk * 65 + lc + 3] = v[3]; }
    LDS_WAIT(); asm volatile("" ::: "memory");
    const int c = lane & 7;
#pragma unroll
    for (int j = 0; j < 8; ++j) { const int n = (lane >> 3) + 8 * j; const LAS float* s = scr + (8 * c) * 65 + n;
        u32x4 o; o.x = cvt_pk_bf16(s[0 * 65], s[1 * 65]); o.y = cvt_pk_bf16(s[2 * 65], s[3 * 65]); o.z = cvt_pk_bf16(s[4 * 65], s[5 * 65]); o.w = cvt_pk_bf16(s[6 * 65], s[7 * 65]);
        *(u32x4*)(WT + (size_t)rowmap(nsrc0 + n) * ldw + kdst + k0 + 8 * c) = o; }
    LDS_WAIT(); asm volatile("" ::: "memory");
}
struct RmId { __device__ __forceinline__ int operator()(int c) const { return c; } };
struct RmIn { __device__ __forceinline__ int operator()(int c) const {
        if (c < 2048) { const int jj = c & 127, j6 = jj & 63; return (c & ~127) + 8 * (j6 >> 2) + (jj >= 64 ? 4 : 0) + (j6 & 3); }
        return c < 6144 ? c : c - 8; } };
struct RmGate { int up; __device__ __forceinline__ int operator()(int c) const { return 256 * (c >> 7) + 128 * up + (c & 127); } };

__device__ __forceinline__ att::BlockRef mk_ref(int item, int jlo, const bf16_t* QKV, bf16_t* OD, bf16_t* ACAT, const float* FBIAS, const float* ZEROB) {
    att::BlockRef r; const int qb = 31 - item / 24, u = item % 24; int hq, hk, hv;
    if (u < 16) { const int m = u >> 1, c = u & 1; hq = m; hk = 8 + m; hv = 16 + (m >> 1) * 2 + c; r.B = ZEROB; r.O = (att::bf16*)OD + ((size_t)u * S + qb * 256) * 128; r.ostride = 128; }
    else { const int h = u - 16; hq = 24 + h; hk = 32 + h; hv = 40 + h; r.B = FBIAS + (size_t)h * S; r.O = (att::bf16*)ACAT + (size_t)(qb * 256) * DM + 1024 + h * 128; r.ostride = DM; }
    r.Q = (const att::bf16*)QKV + ((size_t)hq * S + qb * 256) * 128; r.K = (const att::bf16*)QKV + ((size_t)hk * S + jlo * 64) * 128; r.V = (const att::bf16*)QKV + ((size_t)hv * S + jlo * 64) * 128; r.B += jlo * 64; r.P0 = qb * 256; r.jlo = jlo; return r;
}
__device__ __forceinline__ att::DRef mk_dref(int item, const bf16_t* QKV, bf16_t* OD) {
    att::DRef r; const int m = item & 7, qb = 63 - (item >> 3);
    r.Q = (const att::bf16*)QKV + ((size_t)m * S + qb * 128) * 128; r.K = (const att::bf16*)QKV + (size_t)(8 + m) * S * 128;
    r.V0 = (const att::bf16*)QKV + (size_t)(16 + (m >> 1) * 2) * S * 128; r.V1 = r.V0 + (size_t)S * 128;
    r.O0 = (att::bf16*)OD + ((size_t)(2 * m) * S + qb * 128) * 128; r.O1 = (att::bf16*)OD + ((size_t)(2 * m + 1) * S + qb * 128) * 128; r.P0 = qb * 128; return r;
}
__global__ void __launch_bounds__(NWAVES * 64, 2) mk_fwd(Args args) {
    extern __shared__ __attribute__((aligned(16))) unsigned char lds[];
    Frame F;
    F.lds = (LAS unsigned char*)lds;
    F.MISC = (volatile LAS unsigned*)(F.lds + MISC_OFF);
    F.tid = threadIdx.x; F.lane = F.tid & 63; F.wave = __builtin_amdgcn_readfirstlane(F.tid >> 6);
    F.G = gridDim.x; { const int bx = blockIdx.x; F.vcu = (F.G % 8 == 0) ? (bx % 8) * (F.G / 8) + bx / 8 : bx; }
    unsigned char* ws = args.ws;
    F.ctl = (unsigned*)(ws + WS_CTL);
    const float* x = args.in[0]; const float* w_in = args.in[1]; const float* b_forget = args.in[2];
    const float* lq1 = args.in[3]; const float* lk1 = args.in[4]; const float* lq2 = args.in[5]; const float* lk2 = args.in[6];
    const float* dng = args.in[7]; const float* wpd = args.in[8]; const float* wpf = args.in[9]; const float* wout = args.in[10];
    const float* ln1g = args.in[11]; const float* ln1b = args.in[12]; const float* wrg = args.in[13]; const float* brg = args.in[14];
    const float* wre = args.in[15]; const float* bre = args.in[16]; const float* wgate = args.in[17]; const float* wup = args.in[18];
    const float* wdown = args.in[19]; const float* ln2g = args.in[20]; const float* ln2b = args.in[21];
    float* FLOG = (float*)(ws + WS_FLOG); float* FBIAS = (float*)(ws + WS_FBIAS); float* ZEROB = (float*)(ws + WS_ZEROB); float* WRT = (float*)(ws + WS_WRT);
    float* NPB = (float*)(ws + WS_NP);
    int* TOKINFO = (int*)(ws + WS_TOKINFO); int* LIST = (int*)(ws + WS_LIST); float* ROPE = (float*)(ws + WS_ROPE);
    bf16_t* WPC = (bf16_t*)(ws + WS_WPC); bf16_t* WOUT = (bf16_t*)(ws + WS_WOUT); bf16_t* WIN = (bf16_t*)(ws + WS_WIN); bf16_t* WGU = (bf16_t*)(ws + WS_WGU); bf16_t* WD = (bf16_t*)(ws + WS_WD);
    bf16_t* QKV = (bf16_t*)(ws + WS_QKV); bf16_t* GB = (bf16_t*)(ws + WS_G); bf16_t* XB = (bf16_t*)(ws + WS_XB); bf16_t* OD = (bf16_t*)(ws + WS_OD); bf16_t* ACAT = (bf16_t*)(ws + WS_ACAT);
    bf16_t* MB = (bf16_t*)(ws + WS_MB); float* Z = (float*)(ws + WS_Z); bf16_t* X1B = (bf16_t*)(ws + WS_X1B); bf16_t* HB = (bf16_t*)(ws + WS_H); bf16_t* YB = (bf16_t*)(ws + WS_Y);

    for (int u = F.tid; u < (LDS_BYTES - LDSCTL_OFF) / 4; u += NWAVES * 64) ((LAS unsigned*)(F.lds + LDSCTL_OFF))[u] = 0u;
    __syncthreads();
    XcdBarrier bar; bar.bar = F.ctl + CW_BAR; bar.x = 0; bar.st = nullptr;
    if (MK_N_LAUNCHES == 1) bar = xcd_barrier_post(F.ctl + CW_BAR, F.MISC + 8);
    const int lo = args.ph_lo, hi = args.ph_hi; constexpr int rep = 0;
#define FRESH() do { int t_ = threadIdx.x; asm volatile("" : "+v"(t_)); F.tid = t_; F.lane = t_ & 63; F.wave = __builtin_amdgcn_readfirstlane(t_ >> 6); } while (0)
#define IN(k) ((((PH_MASK) >> (k)) & 1) && lo <= (k) && (k) < hi)
#define SEAM(k) do { if (IN(k) && IN((k) + 1)) xcd_barrier(bar); } while (0)
#define gw (F.vcu * NWAVES + F.wave)
    const int NGW = F.G * NWAVES;
    LAS int* sm_rowidx = (LAS int*)(F.lds + SM_OFF); LAS int* sm_pre = sm_rowidx + 256; LAS int* sm_cnt = sm_pre + 40;

    if (IN(0)) {
        FRESH();
        LAS float* scr = (LAS float*)(F.lds + F.wave * 16640);
        constexpr int I_IN = 32 * 160, I_P = 16 * 32, I_O = 32 * 32, I_E = 32 * 256, NITEMS = I_IN + 2 * I_P + I_O + 2 * I_E;
        for (int it = gw; it < NITEMS; it += NGW) {
            int r = it;
            if (r < I_IN) { const int kb = r / 160, nb = r % 160; tr_item(w_in, INC, 64 * kb, 64 * nb + (nb >= 96 ? 8 : 0), WIN, DM, 0, RmIn{}, scr, F.lane); continue; } r -= I_IN;
            if (r < I_P) { tr_item(wpd, DM, 64 * (r / 32), 64 * (r % 32), WPC, DM, 0, RmId{}, scr, F.lane); continue; } r -= I_P;
            if (r < I_P) { tr_item(wpf, DM, 64 * (r / 32), 64 * (r % 32), WPC, DM, 1024, RmId{}, scr, F.lane); continue; } r -= I_P;
            if (r < I_O) { tr_item(wout, DM, 64 * (r / 32), 64 * (r % 32), WOUT, DM, 0, RmId{}, scr, F.lane); continue; } r -= I_O;
            if (r < I_E) { const int e = r >> 8, q = r & 255; tr_item(wgate + (size_t)e * DM * FF, FF, 64 * (q >> 3), 64 * (q & 7), WGU + (size_t)e * 1024 * DM, DM, 0, RmGate{0}, scr, F.lane); continue; } r -= I_E;
            { const int e = r >> 8, q = r & 255; tr_item(wup + (size_t)e * DM * FF, FF, 64 * (q >> 3), 64 * (q & 7), WGU + (size_t)e * 1024 * DM, DM, 0, RmGate{1}, scr, F.lane); }
        }
        const int gt = F.vcu * (NWAVES * 64) + F.tid, NGT = F.G * NWAVES * 64;
        for (int i = gt; i < S * 64; i += NGT) { const int pos = i >> 6, j = i & 63; const double ang = (double)pos * pow(10000.0, -(double)j / 64.0);
            ROPE[(size_t)pos * 128 + j] = (float)cos(ang); ROPE[(size_t)pos * 128 + 64 + j] = (float)sin(ang); }
        for (int i = gt; i < 36 * DM; i += NGT) { const int c = i / DM, k = i % DM; WRT[i] = c < 4 ? wrg[k * 4 + c] : wre[((size_t)((c - 4) >> 3) * DM + k) * 8 + ((c - 4) & 7)]; }
        for (int i = gt; i < S; i += NGT) ZEROB[i] = 0.f;
        __syncthreads();
        { LAS float* Wf = (LAS float*)F.lds;
          for (int i = F.tid; i < DM * 2; i += NWAVES * 64) { const int k = i >> 1, h4 = (i & 1) * 4; const f32x4 v = *(const f32x4*)(w_in + (size_t)k * INC + 6144 + h4);
              Wf[(h4 + 0) * DM + k] = v[0]; Wf[(h4 + 1) * DM + k] = v[1]; Wf[(h4 + 2) * DM + k] = v[2]; Wf[(h4 + 3) * DM + k] = v[3]; }
          __syncthreads();
          for (int m = gw; m < S; m += NGW) {
              const f32x4* xr = (const f32x4*)(x + (size_t)m * DM) + F.lane; f32x4 v[8];
#pragma unroll
              for (int j = 0; j < 8; ++j) v[j] = xr[64 * j];
              u32x2* o8 = (u32x2*)(XB + (size_t)m * DM) + F.lane;
#pragma unroll
              for (int j = 0; j < 8; ++j) { u32x2 w; w.x = cvt_pk_bf16(v[j][0], v[j][1]); w.y = cvt_pk_bf16(v[j][2], v[j][3]); o8[64 * j] = w; }
              float fl[8];
#pragma unroll
              for (int c = 0; c < 8; ++c) { float a = 0.f;
#pragma unroll
                  for (int j = 0; j < 8; ++j) { const f32x4 w = *(const LAS f32x4*)(Wf + c * DM + 256 * j + 4 * F.lane); a = fmaf(v[j][0], w[0], fmaf(v[j][1], w[1], fmaf(v[j][2], w[2], fmaf(v[j][3], w[3], a)))); }
                  asm volatile("" ::: "memory");
                  fl[c] = wave_sum(a); asm volatile("" : "+v"(fl[c])); }
              if (F.lane == 0) { *(f32x4*)(FLOG + (size_t)m * 8) = (f32x4){fl[0], fl[1], fl[2], fl[3]}; *(f32x4*)(FLOG + (size_t)m * 8 + 4) = (f32x4){fl[4], fl[5], fl[6], fl[7]}; }
          }
          __syncthreads();
        }
    }
    SEAM(0);

    if (IN(1)) {
        FRESH();
        if (F.vcu < 8) {
            const int h = F.vcu; LAS double* part = (LAS double*)F.lds; const double b = (double)b_forget[h];
            double ls[16]; double run = 0.0;
#pragma unroll
            for (int i = 0; i < 16; ++i) { const double z = (double)FLOG[(size_t)(F.tid * 16 + i) * 8 + h] + b; run += (z < 0.0 ? z : 0.0) - log1p(exp(-fabs(z))); ls[i] = run; }
            part[F.tid] = run; __syncthreads();
            if (F.tid == 0) { double a = 0.0; for (int i = 0; i < NWAVES * 64; ++i) { const double t = part[i]; part[i] = a; a += t; } }
            __syncthreads();
            const double off = part[F.tid];
#pragma unroll
            for (int i = 0; i < 16; ++i) FBIAS[(size_t)h * S + F.tid * 16 + i] = (float)(-(off + ls[i]) * (double)INV_SCALE);
            __syncthreads();
        }
        pg8::Gemm g{XB, WIN, DM, DM, DM, nullptr}; pg8::StaticOrder So; So.init(S, NIN, F.G, (int)blockIdx.x);
        pg8::EpiInProj E{QKV, GB, ROPE, NPB};
        pg8::gemm_phase<pg8::EpiInProj, pg8::StaticOrder, false>(F.lds + RING_OFF, g, So, E);
    }
    SEAM(1);

    if (IN(2)) {
        FRESH();
        constexpr int NITEM = 24 * 32;
        { int dslot = 0;
#define FETCH_D(dst) do { if (F.tid == 0) F.MISC[22 + dslot] = __hip_atomic_fetch_add(F.ctl + CW_ATTQ + 64 * (8 + rep), 1u, RLX_AGENT); __syncthreads(); dst = __builtin_amdgcn_readfirstlane((int)F.MISC[22 + dslot]); dslot ^= 1; } while (0)
          int ditem; FETCH_D(ditem);
          if (ditem < 512) {
              att::DRef dcur = mk_dref(ditem, QKV, OD); att::DSeam Sd;
              att::dattn_prime(dcur, (char*)lds, Sd);
              for (;;) {
                  int dn; FETCH_D(dn);
                  const bool dmore = dn < 512;
                  const att::DRef dnxt = dmore ? mk_dref(dn, QKV, OD) : dcur;
                  att::dattn_block(dcur, dnxt, (char*)lds, Sd);
                  if (!dmore) break;
                  dcur = dnxt;
              }
          }
          VM_WAIT(); __syncthreads();
#undef FETCH_D
        }
        #define ref(item, jl) mk_ref((item), (jl), QKV, OD, ACAT, FBIAS, ZEROB)
        int slot = 0;
#define FETCH(dst, dstj) do { if (F.wave == 0) { unsigned v_ = 0; if (F.lane == 0) { const unsigned i_ = __hip_atomic_fetch_add(F.ctl + CW_ATTQ + 64 * rep, 1u, RLX_AGENT); v_ = i_ < 256u ? (i_ >> 3) * 24u + 16u + (i_ & 7u) : (unsigned)NITEM; } const int it_ = (int)__builtin_amdgcn_readfirstlane(v_); int jl_ = 0; \
        if (it_ < NITEM && (it_ % 24) >= 16) { const int h_ = it_ % 24 - 16, qb_ = 31 - it_ / 24, nt_ = 4 * qb_ + 4; const float* Bh_ = FBIAS + (size_t)h_ * S; \
            float qn_ = 0.f, kd_ = 0.f; \
            for (int d_ = 0; d_ < 4; ++d_) { const f32x4 a_ = *(const f32x4*)(NPB + ((size_t)h_ * 128 + 4 * qb_ + d_) * 4), b_ = *(const f32x4*)(NPB + ((size_t)(8 + h_) * 128 + 4 * qb_ + d_) * 4); \
                qn_ = fmaxf(qn_, (a_[0] + a_[1]) + (a_[2] + a_[3])); kd_ = fmaxf(kd_, (b_[0] + b_[1]) + (b_[2] + b_[3])); } \
            qn_ = sqrtf(qn_) * 1.005f; kd_ = sqrtf(kd_) * 1.005f; \
            const float lowm_ = -qn_ * kd_ * 1.0001f + Bh_[qb_ * 256]; int first_ = nt_; \
            for (int c_ = 0; c_ < 2; ++c_) { const int t_ = c_ * 64 + F.lane; bool keep_ = true; \
                if (t_ < nt_) { const f32x4 b_ = *(const f32x4*)(NPB + ((size_t)(8 + h_) * 128 + t_) * 4); const float kn_ = sqrtf((b_[0] + b_[1]) + (b_[2] + b_[3])) * 1.005f; keep_ = !(qn_ * kn_ * 1.0001f + Bh_[64 * t_ + 63] - lowm_ < -FOX_THR_RAW); } else keep_ = (t_ == nt_); \
                const unsigned long long bm_ = __ballot(keep_ && t_ <= nt_); if (bm_ && first_ == nt_) first_ = c_ * 64 + (int)__builtin_ctzll(bm_); } \
            jl_ = first_ & ~1; if (jl_ > nt_ - 4) jl_ = nt_ - 4; if (jl_ < 0) jl_ = 0; } \
        if (F.lane == 0) { F.MISC[16 + slot] = (unsigned)it_; F.MISC[18 + slot] = (unsigned)jl_; } } \
        __syncthreads(); dst = __builtin_amdgcn_readfirstlane((int)F.MISC[16 + slot]); dstj = __builtin_amdgcn_readfirstlane((int)F.MISC[18 + slot]); slot ^= 1; } while (0)
        int item, jl; FETCH(item, jl);
        if (item < NITEM) {
            att::BlockRef cur = ref(item, jl); att::Seam Sm;
            att::attn_prime(cur, (char*)lds, F.lds, Sm);
            for (;;) {
                int nitem, njl; FETCH(nitem, njl);
                const bool more = nitem < NITEM;
                const att::BlockRef nxt = more ? ref(nitem, njl) : cur;
                att::attn_block(cur, nxt, (char*)lds, F.lds, Sm);
                if (!more) break;
                cur = nxt;
            }
        }
        VM_WAIT(); __syncthreads();
#undef FETCH
#undef ref
    }
    SEAM(2);

    if (IN(3)) {
        FRESH();
        float a = lq1[F.lane] * lk1[F.lane] + lq1[F.lane + 64] * lk1[F.lane + 64], b = lq2[F.lane] * lk2[F.lane] + lq2[F.lane + 64] * lk2[F.lane + 64];
        const float lam = __expf(wave_sum(a)) - __expf(wave_sum(b)) + LAM_INIT;
        const int c = F.lane >> 5, dd = (F.lane & 31) * 4;
        for (int p = gw; p < S * 4; p += NGW) { const int s = p >> 2, h = p & 3;
            const u32x2 w1 = *(const u32x2*)(OD + ((size_t)(4 * h + c) * S + s) * 128 + dd), w2 = *(const u32x2*)(OD + ((size_t)(4 * h + 2 + c) * S + s) * 128 + dd);
            const f32x4 o1 = {bf_lo(w1.x), bf_hi(w1.x), bf_lo(w1.y), bf_hi(w1.y)}, o2 = {bf_lo(w2.x), bf_hi(w2.x), bf_lo(w2.y), bf_hi(w2.y)};
            const f32x4 v = o1 - o2 * lam;
            const float ss = wave_sum(v[0] * v[0] + v[1] * v[1] + v[2] * v[2] + v[3] * v[3]);
            const float r = rsqrtf(ss * (1.f / 256.f) + LN_EPS) * (1.f - LAM_INIT);
            const f32x4 gg = *(const f32x4*)(dng + h * 256 + 4 * F.lane);
            u32x2 w; w.x = cvt_pk_bf16(v[0] * r * gg[0], v[1] * r * gg[1]); w.y = cvt_pk_bf16(v[2] * r * gg[2], v[3] * r * gg[3]);
            *(u32x2*)(ACAT + (size_t)s * DM + h * 256 + 4 * F.lane) = w; }
    }
    SEAM(3);

    if (IN(4)) {
        pg8::Gemm g{ACAT, WPC, DM, DM, DM, nullptr}; pg8::StaticOrder So; So.init(S, DM, F.G, (int)blockIdx.x);
        pg8::EpiGateHook E{GB, MB};
        pg8::gemm_phase<pg8::EpiGateHook, pg8::StaticOrder, false, true>(F.lds + RING_OFF, g, So, E);
    }
    if (IN(4) && IN(6)) xcd_barrier(bar);

    if (IN(6)) {
        pg8::Gemm g{MB, WOUT, DM, DM, DM, nullptr};
        pg8::StaticOrder So; So.init(S, DM, F.G, (int)blockIdx.x);
        pg8::EpiZ E{x, Z};
        pg8::gemm_phase<pg8::EpiZ, pg8::StaticOrder, false>(F.lds + RING_OFF, g, So, E);
    }
    SEAM(6);

    if (IN(7)) {
        FRESH();
        unsigned* ecnt = F.ctl + CW_ECNT + rep * 2048; int* LISTr = rep ? (int*)(ws + WS_H) : LIST; int* TOKr = rep ? (int*)(ws + WS_H + 2 * MiB) : TOKINFO; float* Zw = rep ? (float*)(ws + WS_Y) : Z; bf16_t* X1Bw = rep ? (bf16_t*)(ws + WS_Y + 64 * MiB) : X1B;
        LAS float* Wl = (LAS float*)F.lds;
        LAS float* Lw = (LAS float*)(F.lds + 81920) + F.wave * 128;
#pragma unroll 1
        for (int pr = 0; pr < 2; ++pr) {
            const int rowA = gw * 4 + 2 * pr;
            f32x4 xa[8], xb[8];
            {
                const f32x4* za = (const f32x4*)(Z + (size_t)rowA * DM) + F.lane; const f32x4* zb = za + DM / 4;
                float sa = 0.f, sb = 0.f;
#pragma unroll
                for (int j = 0; j < 8; ++j) { xa[j] = za[64 * j]; xb[j] = zb[64 * j]; sa += (xa[j][0] + xa[j][1]) + (xa[j][2] + xa[j][3]); sb += (xb[j][0] + xb[j][1]) + (xb[j][2] + xb[j][3]); }
                const float ma = wave_sum(sa) * (1.f / DM), mb = wave_sum(sb) * (1.f / DM); float qa = 0.f, qb = 0.f;
#pragma unroll
                for (int j = 0; j < 8; ++j) { xa[j] = xa[j] - ma; xb[j] = xb[j] - mb; qa += (xa[j][0] * xa[j][0] + xa[j][1] * xa[j][1]) + (xa[j][2] * xa[j][2] + xa[j][3] * xa[j][3]);
                    qb += (xb[j][0] * xb[j][0] + xb[j][1] * xb[j][1]) + (xb[j][2] * xb[j][2] + xb[j][3] * xb[j][3]); }
                const float ra = rsqrtf(wave_sum(qa) * (1.f / DM) + LN_EPS), rb = rsqrtf(wave_sum(qb) * (1.f / DM) + LN_EPS);
                f32x4* oa = (f32x4*)(Zw + (size_t)rowA * DM) + F.lane; f32x4* ob = oa + DM / 4;
                u32x2* ha = (u32x2*)(X1Bw + (size_t)rowA * DM) + F.lane; u32x2* hb = ha + DM / 4;
#pragma unroll
                for (int j = 0; j < 8; ++j) { const f32x4 gg = *((const f32x4*)ln1g + F.lane + 64 * j), bb = *((const f32x4*)ln1b + F.lane + 64 * j);
                    xa[j] = xa[j] * ra * gg + bb; xb[j] = xb[j] * rb * gg + bb; oa[64 * j] = xa[j]; ob[64 * j] = xb[j];
                    u32x2 w; w.x = cvt_pk_bf16(xa[j][0], xa[j][1]); w.y = cvt_pk_bf16(xa[j][2], xa[j][3]); ha[64 * j] = w;
                    w.x = cvt_pk_bf16(xb[j][0], xb[j][1]); w.y = cvt_pk_bf16(xb[j][2], xb[j][3]); hb[64 * j] = w; }
            }
            float la[36], lb[36];
#pragma unroll
            for (int c = 0; c < 36; ++c) { la[c] = 0.f; lb[c] = 0.f; }
#define P7_STAGE(j, b) do { unsigned lo_ = (unsigned)F.lane * 16u; asm volatile("" : "+v"(lo_)); _Pragma("unroll") for (int n_ = 0; n_ < 5; ++n_) { const int c_ = F.wave + 8 * n_; if (c_ < 36) { \
        const char* ub_ = (const char*)(WRT + (size_t)c_ * DM + 256 * (j)); __builtin_amdgcn_global_load_lds((const unsigned*)(ub_ + lo_), (LAS unsigned*)(Wl + (b) * 9216 + c_ * 256), 16, 0, 0); } } } while (0)
#define P7_COMMIT(b) do { VM_WAIT(); } while (0)
            __syncthreads();
            P7_STAGE(0, 0); P7_COMMIT(0); __syncthreads();
#pragma unroll
            for (int j = 0; j < 8; ++j) {
                if (j + 1 < 8) P7_STAGE(j + 1, (j + 1) & 1);
                const LAS float* Wb = Wl + (j & 1) * 9216;
#pragma unroll
                for (int cg = 0; cg < 9; ++cg) { f32x4 w[4];
#pragma unroll
                    for (int q = 0; q < 4; ++q) w[q] = *(const LAS f32x4*)(Wb + (4 * cg + q) * 256 + 4 * F.lane);
                    asm volatile("" ::: "memory");
#pragma unroll
                    for (int q = 0; q < 4; ++q) { const int c = 4 * cg + q;
                        la[c] = fmaf(xa[j][0], w[q][0], fmaf(xa[j][1], w[q][1], fmaf(xa[j][2], w[q][2], fmaf(xa[j][3], w[q][3], la[c]))));
                        lb[c] = fmaf(xb[j][0], w[q][0], fmaf(xb[j][1], w[q][1], fmaf(xb[j][2], w[q][2], fmaf(xb[j][3], w[q][3], lb[c]))));
                        asm volatile("" : "+v"(la[c]), "+v"(lb[c])); }
                    asm volatile("" ::: "memory"); __builtin_amdgcn_sched_barrier(0); }
                if (j + 1 < 8) { P7_COMMIT((j + 1) & 1); __syncthreads(); }
                __builtin_amdgcn_sched_barrier(0);
            }
#undef P7_STAGE
#undef P7_COMMIT
#pragma unroll
            for (int c = 0; c < 36; ++c) { la[c] = wave_sum(la[c]); lb[c] = wave_sum(lb[c]); asm volatile("" : "+v"(la[c]), "+v"(lb[c])); }
            if (F.lane == 0) {
#pragma unroll
                for (int c = 0; c < 36; ++c) { Lw[c] = la[c]; Lw[64 + c] = lb[c]; } }
            LDS_WAIT(); asm volatile("" ::: "memory");
            if (F.lane < 2) {
                const LAS float* L = Lw + 64 * F.lane; const int tok = rowA + F.lane;
                int g = 0; float gm = L[0] + brg[0];
                for (int c = 1; c < 4; ++c) { const float v = L[c] + brg[c]; if (v > gm) { gm = v; g = c; } }
                float den = 0.f;
                for (int c = 0; c < 4; ++c) den += expf(L[c] + brg[c] - gm);
                const float top_gp = 1.f / den;
                int e1 = 0; float l1 = L[4 + g * 8] + bre[g * 8];
                for (int e = 1; e < 8; ++e) { const float v = L[4 + g * 8 + e] + bre[g * 8 + e]; if (v > l1) { l1 = v; e1 = e; } }
                int e2 = 0; float l2 = -INFINITY;
                for (int e = 0; e < 8; ++e) { const float v = L[4 + g * 8 + e] + bre[g * 8 + e]; if (e != e1 && v > l2) { l2 = v; e2 = e; } }
                const float w1 = 1.f / (1.f + expf(l2 - l1));
                const int ea = g * 8 + e1, eb = g * 8 + e2;
                const int pa = (int)__hip_atomic_fetch_add(ecnt + 64 * ea, 1u, RLX_AGENT), pb = (int)__hip_atomic_fetch_add(ecnt + 64 * eb, 1u, RLX_AGENT);
                LISTr[(size_t)ea * S + pa] = tok; LISTr[(size_t)eb * S + pb] = tok;
                int* ti = TOKr + (size_t)tok * 8; ti[0] = ea; ti[1] = pa; ti[2] = __float_as_int(top_gp * w1); ti[3] = eb; ti[4] = pb; ti[5] = __float_as_int(top_gp * (1.f - w1));
            }
            asm volatile("" ::: "memory");
        }
    }
    SEAM(7);

    if (IN(8) || IN(9) || IN(10)) {
        FRESH();
        if (F.tid < 32) { const int c = (int)__hip_atomic_load(F.ctl + CW_ECNT + 64 * F.tid, RLX_AGENT); sm_cnt[F.tid] = c; }
        __syncthreads();
        if (F.tid == 0) { int a = 0; for (int e = 0; e < NEXP; ++e) { sm_pre[e] = a; a += (sm_cnt[e] + 255) >> 8; } sm_pre[32] = a; }
        __syncthreads();
    }
    if (IN(8)) {
        FRESH();
        const int nunits = sm_pre[32] * 4;
        for (int u = F.vcu; u < nunits; u += F.G) {
            const int mtile = u >> 2, nt4 = u & 3; int e = 0;
            for (int q = 1; q < NEXP; ++q) if (sm_pre[q] <= mtile) e = q;
            const int mt = mtile - sm_pre[e], cnt = sm_cnt[e];
            if (F.tid < 256) { int r = mt * 256 + F.tid; r = r < cnt ? r : cnt - 1; sm_rowidx[F.tid] = LIST[(size_t)e * S + r]; }
            __syncthreads();
            pg8::Gemm g{X1B, WGU + (size_t)e * 1024 * DM, DM, DM, DM, sm_rowidx}; pg8::SingleUnit Su{{mtile, nt4}};
            pg8::EpiSwiGLU E{HB};
            pg8::gemm_phase<pg8::EpiSwiGLU, pg8::SingleUnit, true>(F.lds + RING_OFF, g, Su, E);
        }
        if (rep == 0) { LAS float* scr = (LAS float*)(F.lds + F.wave * 16640); int sl = 0;
            for (;;) { if (F.tid == 0) F.MISC[20 + sl] = __hip_atomic_fetch_add(F.ctl + CW_DQ, 1u, RLX_AGENT); __syncthreads(); const int batch = (int)F.MISC[20 + sl]; sl ^= 1;
                if (batch >= 1024) break;
                const int r = batch * 8 + F.wave, e = r >> 8, q = r & 255;
                tr_item(wdown + (size_t)e * FF * DM, DM, 64 * (q >> 5), 64 * (q & 31), WD + (size_t)e * DM * FF, FF, 0, RmId{}, scr, F.lane); }
            __syncthreads(); }
    }
    SEAM(8);
    if (IN(9)) {
        FRESH();
        const int nunits = sm_pre[32] * 8;
        for (int u = F.vcu; u < nunits; u += F.G) {
            const int mtile = u >> 3; int e = 0;
            for (int q = 1; q < NEXP; ++q) if (sm_pre[q] <= mtile) e = q;
            pg8::Gemm g{HB, WD, FF, FF, FF, nullptr}; pg8::SingleUnit Su{{mtile, e * 8 + (u & 7)}}; pg8::EpiY E{YB};
            pg8::gemm_phase<pg8::EpiY, pg8::SingleUnit, false>(F.lds + RING_OFF, g, Su, E);
        }
    }
    SEAM(9);
    if (IN(10)) {
        FRESH();
        float* out = args.out;
        for (int m = gw; m < S; m += NGW) {
            const int* ti = TOKINFO + (size_t)m * 8;
            const int ea = ti[0], pa = ti[1], eb = ti[3], pb = ti[4]; float wa = __int_as_float(ti[2]), wb = __int_as_float(ti[5]);
            const size_t ra = (size_t)sm_pre[ea] * 256 + pa, rb = (size_t)sm_pre[eb] * 256 + pb;
            const f32x4* xr = (const f32x4*)(Z + (size_t)m * DM) + F.lane; const u32x2* ya = (const u32x2*)(YB + ra * DM) + F.lane; const u32x2* yb = (const u32x2*)(YB + rb * DM) + F.lane;
            f32x4 v[8]; float s = 0.f;
#pragma unroll
            for (int j = 0; j < 8; ++j) { const f32x4 xv = xr[64 * j]; const u32x2 a = ya[64 * j], b = yb[64 * j];
                const f32x4 fa = {bf_lo(a.x), bf_hi(a.x), bf_lo(a.y), bf_hi(a.y)}, fb = {bf_lo(b.x), bf_hi(b.x), bf_lo(b.y), bf_hi(b.y)};
                v[j] = xv * ALPHA + fa * wa + fb * wb; s += (v[j][0] + v[j][1]) + (v[j][2] + v[j][3]); }
            const float mean = wave_sum(s) * (1.f / DM); float q = 0.f;
#pragma unroll
            for (int j = 0; j < 8; ++j) { v[j] = v[j] - mean; q += (v[j][0] * v[j][0] + v[j][1] * v[j][1]) + (v[j][2] * v[j][2] + v[j][3] * v[j][3]); }
            const float rstd = rsqrtf(wave_sum(q) * (1.f / DM) + LN_EPS);
            f32x4* o = (f32x4*)(out + (size_t)m * DM) + F.lane;
#pragma unroll
            for (int j = 0; j < 8; ++j) { const f32x4 gg = *((const f32x4*)ln2g + F.lane + 64 * j), bb = *((const f32x4*)ln2b + F.lane + 64 * j); o[64 * j] = v[j] * rstd * gg + bb; }
        }
    }
#undef IN
#undef SEAM
#undef gw
#undef FRESH
}

extern "C" void kernel_launch(void* const* d_in, const int* in_sizes, int n_in, void* d_out, int out_size, void* d_ws, size_t ws_size, hipStream_t stream) {
    static int grid = 0;
    if (grid == 0) {
        if (n_in != 22 || in_sizes[0] != S * DM || in_sizes[1] != DM * INC || out_size != S * DM || ws_size < WS_END) {
            fprintf(stderr, "kernel_launch: unexpected shapes (n_in %d, in0 %d, out %d, ws %zu); nothing launched\n", n_in, n_in > 0 ? in_sizes[0] : -1, out_size, ws_size); grid = -1; return; }
        int dev = 0, cus = 0, per_cu = 0;
        if (hipGetDevice(&dev) != hipSuccess || hipDeviceGetAttribute(&cus, hipDeviceAttributeMultiprocessorCount, dev) != hipSuccess) { fprintf(stderr, "kernel_launch: device query failed\n"); grid = -1; return; }
        if (hipFuncSetAttribute((const void*)mk_fwd, hipFuncAttributeMaxDynamicSharedMemorySize, LDS_BYTES) != hipSuccess) { fprintf(stderr, "kernel_launch: hipFuncSetAttribute failed\n"); grid = -1; return; }
        if (hipOccupancyMaxActiveBlocksPerMultiprocessor(&per_cu, (const void*)mk_fwd, NWAVES * 64, LDS_BYTES) != hipSuccess || per_cu < 1) fprintf(stderr, "kernel_launch: occupancy query reports %d\n", per_cu);
        (void)hipGetLastError();
        grid = cus;
        if (grid != 256) fprintf(stderr, "kernel_launch: %d CUs; this build assumes 256\n", grid);
    }
    if (grid < 0) return;
    (void)hipMemsetAsync((char*)d_ws + WS_CTL, 0, CTL_ZERO_BYTES, stream);
    Args a{};
    for (int i = 0; i < 22; ++i) a.in[i] = (const float*)d_in[i];
    a.out = (float*)d_out; a.ws = (unsigned char*)d_ws;
    if (MK_N_LAUNCHES == 1) { a.ph_lo = 0; a.ph_hi = NPHASE; hipLaunchKernelGGL(mk_fwd, dim3(grid), dim3(NWAVES * 64), LDS_BYTES, stream, a); }
    else { for (int p = 0; p < NPHASE; ++p) { a.ph_lo = p; a.ph_hi = p + 1; hipLaunchKernelGGL(mk_fwd, dim3(grid), dim3(NWAVES * 64), LDS_BYTES, stream, a); } }
}
```

```cpp
#include <hip/hip_runtime.h>
#include <hip/hip_bf16.h>
#include <cstdio>
#include <cstdint>
#include <cmath>

#ifndef PH_MASK
#define PH_MASK 0x7ff
#endif
#ifndef MK_N_LAUNCHES
#define MK_N_LAUNCHES 1
#endif

constexpr int S = 8192, DM = 2048, INC = 10248, NIN = 10240, NEXP = 32, FF = 512;
constexpr float ALPHA = 1.189207115002721f;
constexpr float LN_EPS = 1e-5f;
constexpr float LAM_INIT = 0.2f;
constexpr float INV_SCALE = 11.313708498984761f;
constexpr float FOX_THR_RAW = 36.f * 11.313708498984761f;

#define LAS __attribute__((address_space(3)))
#define GAS __attribute__((address_space(1)))
typedef unsigned short bf16_t;
typedef short bf16x8 __attribute__((ext_vector_type(8)));
typedef short s16x4 __attribute__((ext_vector_type(4)));
typedef float f32x4 __attribute__((ext_vector_type(4)));
typedef float f32x2 __attribute__((ext_vector_type(2)));
typedef float f32x16 __attribute__((ext_vector_type(16)));
typedef unsigned u32x4 __attribute__((ext_vector_type(4)));
typedef unsigned u32x2 __attribute__((ext_vector_type(2)));
typedef GAS unsigned gu32;

typedef __bf16 bf16x2_t __attribute__((ext_vector_type(2)));
__device__ __forceinline__ unsigned cvt_pk_bf16(float lo, float hi) { f32x2 v = {lo, hi}; bf16x2_t b = __builtin_convertvector(v, bf16x2_t); return __builtin_bit_cast(unsigned, b); }
__device__ __forceinline__ float bf_lo(unsigned w) { return __uint_as_float(w << 16); }
__device__ __forceinline__ float bf_hi(unsigned w) { return __uint_as_float(w & 0xffff0000u); }
__device__ __forceinline__ float wave_sum(float v) {
#pragma unroll
    for (int o = 1; o < 64; o <<= 1) v += __shfl_xor(v, o);
    return v;
}

namespace pg8 {
constexpr int BM = 256, BK = 64, HALF = 128, HTB = HALF * BK * 2, STAGE_BYTES = 8 * HTB, NXCD = 8, WGM = 8;
__host__ __device__ __forceinline__ int lds_byte(int r, int c) { const int st = (r >> 4) * 2 + (c >> 5), rr = r & 15, cc = c & 31, ob = rr * 64 + cc * 2; return st * 1024 + (ob ^ (((ob >> 9) & 1) << 5)); }
__host__ __device__ __forceinline__ void stage_rc(int b, int& R, int& C) { const int st = b / 1024, sb = b % 1024, swz = sb ^ (((sb >> 9) & 1) << 5); R = (st >> 1) * 16 + swz / 64; C = (st & 1) * 32 + (swz % 64) / 2; }
__host__ __device__ __forceinline__ int perm32(int rho) { const int n = rho >> 4, i = rho & 15; return 8 * (i >> 2) + 4 * n + (i & 3); }

struct Unit { int pm, pn; };
struct Gemm { const bf16_t* A; const bf16_t* Bt; int K, lda, ldb; const LAS int* rowidx; };

struct StaticOrder {
    int nM, nN, nwg, G, c;
    __device__ void init(int M, int N, int G_, int c_) { nM = M / BM; nN = N / BM; nwg = nM * nN; G = G_; c = c_; }
    __device__ bool next(int i, Unit& u) const {
        const long L = (long)i * G + c; if (L >= nwg) return false;
        int wgid = (int)L; { const int q = nwg / NXCD, r = nwg % NXCD, xcd = wgid % NXCD, off = wgid / NXCD; wgid = (xcd < r ? xcd * (q + 1) : r * (q + 1) + (xcd - r) * q) + off; }
        const int nig = WGM * nN, gid = wgid / nig, fm = gid * WGM, gsz = (nM - fm) < WGM ? (nM - fm) : WGM;
        u.pm = fm + ((wgid % nig) % gsz); u.pn = (wgid % nig) / gsz; return true;
    }
};
struct SingleUnit { Unit u; __device__ bool next(int i, Unit& o) const { if (i) return false; o = u; return true; } };

typedef f32x4 Acc[2][2][4][2];

template <class Epi, class Sched, bool GATHER, bool HOOK = false>
__device__ __forceinline__ void gemm_phase(LAS unsigned char* lds, const Gemm g, const Sched& S, const Epi& E) {
    int tid = threadIdx.x; asm volatile("" : "+v"(tid));
    const int wid = __builtin_amdgcn_readfirstlane(tid >> 6), lane = tid & 63, wr = wid >> 2, wc = wid & 3, fr = lane & 15, fq = lane >> 4;
    const int K = g.K, nt = K / BK;
    unsigned voffA[2], voffA1[2], voffB[2];
#pragma unroll
    for (int i = 0; i < 2; ++i) { int R, C; stage_rc(tid * 16 + i * 8192, R, C); const int Rb = (R & ~31) + perm32(R & 31);
        if constexpr (GATHER) { voffA[i] = (unsigned)(g.rowidx[R] * g.lda + C) * 2u; voffA1[i] = (unsigned)(g.rowidx[HALF + R] * g.lda + C) * 2u; }
        else { voffA[i] = (unsigned)(R * g.lda + C) * 2u; voffA1[i] = 0u; }
        voffB[i] = (unsigned)(Rb * g.ldb + C) * 2u; }
    const size_t kstep = (size_t)(BK * 2);
    const size_t hstepA = GATHER ? 0 : (size_t)HALF * g.lda * 2, hstepB = (size_t)HALF * g.ldb * 2;
    const size_t tstepA = GATHER ? 0 : 2 * hstepA, tstepB = 2 * hstepB;
    const unsigned ldsw = (unsigned)wid * 1024u;
    const int aoff = lds_byte(wr * 64 + fr, fq * 8), boff = lds_byte(wc * 32 + fr, fq * 8);
#define PG8_SA(b, h) (((b) * 2 + (h)) * HTB)
#define PG8_SB(b, h) ((4 + (b) * 2 + (h)) * HTB)
#define PG8_STAGE(bufoff, gbase, voff) do { _Pragma("unroll") for (int _i = 0; _i < 2; ++_i) \
        __builtin_amdgcn_global_load_lds((const unsigned*)((const char*)(gbase) + (voff)[_i]), (LAS unsigned*)(lds + (bufoff) + ldsw + _i * 8192), 16, 0, 0); } while (0)
#define PG8_STAGE_A0(bufoff, gbase) PG8_STAGE(bufoff, gbase, voffA)
#define PG8_STAGE_A1(bufoff, gbase) do { if constexpr (GATHER) { PG8_STAGE(bufoff, gbase, voffA1); } else { PG8_STAGE(bufoff, (gbase) + hstepA, voffA); } } while (0)
#define PG8_LDA(dst, b, h) do { _Pragma("unroll") for (int m = 0; m < 4; ++m) _Pragma("unroll") for (int k = 0; k < 2; ++k) dst[m][k] = *(const LAS bf16x8*)(lds + PG8_SA(b, h) + aoff + m * 2048 + k * 1024); } while (0)
#define PG8_LDB(dst, b, h) do { _Pragma("unroll") for (int n = 0; n < 2; ++n) _Pragma("unroll") for (int k = 0; k < 2; ++k) dst[n][k] = *(const LAS bf16x8*)(lds + PG8_SB(b, h) + boff + n * 2048 + k * 1024); } while (0)
#define PG8_MMA(ai, bj, At, Bt) do { __builtin_amdgcn_s_setprio(1); _Pragma("unroll") for (int m = 0; m < 4; ++m) _Pragma("unroll") for (int n = 0; n < 2; ++n) _Pragma("unroll") for (int k = 0; k < 2; ++k) \
        acc[ai][bj][m][n] = __builtin_amdgcn_mfma_f32_16x16x32_bf16(Bt[n][k], At[m][k], acc[ai][bj][m][n], 0, 0, 0); __builtin_amdgcn_s_setprio(0); } while (0)
#define PG8_WAIT_V(n) asm volatile("s_waitcnt vmcnt(" #n ")" ::: "memory")
#define PG8_WAIT_L(n) asm volatile("s_waitcnt lgkmcnt(" #n ")" ::: "memory")
#define PG8_BAR __builtin_amdgcn_s_barrier()
#define PG8_SCHED __builtin_amdgcn_sched_barrier(0)
    Unit cur, nxt; int ui = 0;
    if (!S.next(0, cur)) return;
    Acc acc;
#pragma unroll
    for (int a = 0; a < 2; ++a)
#pragma unroll
        for (int b = 0; b < 2; ++b)
#pragma unroll
            for (int m = 0; m < 4; ++m)
#pragma unroll
                for (int n = 0; n < 2; ++n) acc[a][b][m][n] = (f32x4){0.f, 0.f, 0.f, 0.f};
    bf16x8 At[4][2], B0[2][2], B1[2][2];
    const char* cA = (const char*)g.A + (size_t)cur.pm * tstepA; const char* cB = (const char*)g.Bt + (size_t)cur.pn * tstepB;
    PG8_STAGE(PG8_SB(0, 0), cB, voffB); PG8_STAGE(PG8_SB(0, 1), cB + hstepB, voffB); PG8_STAGE_A0(PG8_SA(0, 0), cA); PG8_STAGE_A1(PG8_SA(0, 1), cA);
    if (wr == 1) PG8_BAR;
    PG8_WAIT_V(2); PG8_BAR;
    PG8_STAGE(PG8_SB(1, 0), cB + kstep, voffB); PG8_STAGE_A0(PG8_SA(1, 0), cA + kstep); PG8_STAGE(PG8_SB(1, 1), cB + hstepB + kstep, voffB);
    PG8_WAIT_V(6); PG8_BAR;
    for (;;) {
        const bool has_next = S.next(ui + 1, nxt);
        const char* nA = has_next ? (const char*)g.A + (size_t)nxt.pm * tstepA : cA; const char* nB = has_next ? (const char*)g.Bt + (size_t)nxt.pn * tstepB : cB;
        for (int t = 0; t < nt; t += 2) {
            if constexpr (HOOK) { if (t == nt / 2) { E.hook(acc, cur, wr, wc, fr, fq); PG8_SCHED; } }
            const bool last = (t == nt - 2);
            const char* a1 = cA + (size_t)(t + 1) * kstep;
            const char* a2 = last ? nA : cA + (size_t)(t + 2) * kstep; const char* b2 = last ? nB : cB + (size_t)(t + 2) * kstep;
            const char* a3 = a2 + kstep; const char* b3 = b2 + kstep;
            PG8_LDB(B0, 0, 0); PG8_LDB(B1, 0, 1); PG8_SCHED; PG8_LDA(At, 0, 0); PG8_STAGE_A1(PG8_SA(1, 1), a1);
            PG8_WAIT_V(8); PG8_WAIT_L(0); PG8_BAR; PG8_MMA(0, 0, At, B0); PG8_MMA(0, 1, At, B1); PG8_BAR; PG8_SCHED;
            PG8_LDA(At, 0, 1); PG8_STAGE(PG8_SB(0, 0), b2, voffB); PG8_STAGE(PG8_SB(0, 1), b2 + hstepB, voffB); PG8_STAGE_A0(PG8_SA(0, 0), a2);
            PG8_WAIT_V(8); PG8_WAIT_L(0); PG8_BAR; PG8_MMA(1, 0, At, B0); PG8_MMA(1, 1, At, B1); PG8_BAR; PG8_SCHED;
            PG8_LDB(B0, 1, 0); PG8_LDB(B1, 1, 1); PG8_SCHED; PG8_LDA(At, 1, 0); PG8_STAGE_A1(PG8_SA(0, 1), a2);
            PG8_WAIT_V(8); PG8_WAIT_L(0); PG8_BAR; PG8_MMA(0, 0, At, B0); PG8_MMA(0, 1, At, B1); PG8_BAR; PG8_SCHED;
            PG8_LDA(At, 1, 1); PG8_STAGE(PG8_SB(1, 0), b3, voffB); PG8_STAGE(PG8_SB(1, 1), b3 + hstepB, voffB); PG8_STAGE_A0(PG8_SA(1, 0), a3);
            PG8_WAIT_V(8); PG8_WAIT_L(0); PG8_BAR; PG8_MMA(1, 0, At, B0); PG8_MMA(1, 1, At, B1); PG8_BAR; PG8_SCHED;
        }
        if (wr == 0) PG8_BAR;
        E(acc, cur, wr, wc, fr, fq);
        if (!has_next) break;
#pragma unroll
        for (int a = 0; a < 2; ++a)
#pragma unroll
            for (int b = 0; b < 2; ++b)
#pragma unroll
                for (int m = 0; m < 4; ++m)
#pragma unroll
                    for (int n = 0; n < 2; ++n) acc[a][b][m][n] = (f32x4){0.f, 0.f, 0.f, 0.f};
        cur = nxt; cA = nA; cB = nB; ++ui;
        if (wr == 1) PG8_BAR;
    }
    PG8_WAIT_V(0);
    PG8_BAR;
#undef PG8_SA
#undef PG8_SB
#undef PG8_STAGE
#undef PG8_STAGE_A0
#undef PG8_STAGE_A1
#undef PG8_LDA
#undef PG8_LDB
#undef PG8_MMA
#undef PG8_WAIT_V
#undef PG8_WAIT_L
#undef PG8_BAR
#undef PG8_SCHED
}

__device__ __forceinline__ u32x4 pack8(f32x4 a, f32x4 b) { u32x4 w; w.x = cvt_pk_bf16(a[0], a[1]); w.y = cvt_pk_bf16(a[2], a[3]); w.z = cvt_pk_bf16(b[0], b[1]); w.w = cvt_pk_bf16(b[2], b[3]); return w; }
__device__ __forceinline__ f32x4 sigmoid4(f32x4 v) { f32x4 r;
#pragma unroll
    for (int i = 0; i < 4; ++i) r[i] = __builtin_amdgcn_rcpf(1.f + __builtin_amdgcn_exp2f(-1.4426950408889634f * v[i])); return r; }

struct EpiInProj {
    bf16_t* QKV; bf16_t* G; const float* rope; float* NP;
    __device__ __forceinline__ void operator()(const Acc& acc, const Unit& u, int wr, int wc, int fr, int fq) const {
        const int row0 = u.pm * BM + wr * 64 + fr;
        if (u.pn < 8) {
            const int g4 = 4 * (4 * wc + fq);
#pragma unroll
            for (int ai = 0; ai < 2; ++ai)
#pragma unroll
                for (int m = 0; m < 4; ++m) { const int r = row0 + ai * HALF + m * 16;
                    const f32x4 cs = *(const f32x4*)(rope + (size_t)r * 128 + g4), sn = *(const f32x4*)(rope + (size_t)r * 128 + 64 + g4);
#pragma unroll
                    for (int bj = 0; bj < 2; ++bj) { const f32x4 t1 = acc[ai][bj][m][0], t2 = acc[ai][bj][m][1];
                        const f32x4 o1 = t1 * cs - t2 * sn, o2 = t1 * sn + t2 * cs;
                        bf16_t* dst = QKV + ((size_t)(2 * u.pn + bj) * S + r) * 128;
                        u32x2 w1, w2; w1.x = cvt_pk_bf16(o1[0], o1[1]); w1.y = cvt_pk_bf16(o1[2], o1[3]); w2.x = cvt_pk_bf16(o2[0], o2[1]); w2.y = cvt_pk_bf16(o2[2], o2[3]);
                        *(u32x2*)(dst + g4) = w1; *(u32x2*)(dst + 64 + g4) = w2; } }
        } else if (u.pn < 24) {
#pragma unroll
            for (int ai = 0; ai < 2; ++ai)
#pragma unroll
                for (int m = 0; m < 4; ++m) { const int r = row0 + ai * HALF + m * 16;
#pragma unroll
                    for (int bj = 0; bj < 2; ++bj) *(u32x4*)(QKV + ((size_t)(2 * u.pn + bj) * S + r) * 128 + wc * 32 + 8 * fq) = pack8(acc[ai][bj][m][0], acc[ai][bj][m][1]); }
            if (u.pn >= 12 && u.pn < 20) {
#pragma unroll
                for (int ai = 0; ai < 2; ++ai)
#pragma unroll
                    for (int bj = 0; bj < 2; ++bj) { float mx = 0.f;
#pragma unroll
                        for (int m = 0; m < 4; ++m) { const f32x4 a = acc[ai][bj][m][0], b = acc[ai][bj][m][1];
                            float ss = (a[0] * a[0] + a[1] * a[1]) + (a[2] * a[2] + a[3] * a[3]) + (b[0] * b[0] + b[1] * b[1]) + (b[2] * b[2] + b[3] * b[3]);
                            ss += __shfl_xor(ss, 16); ss += __shfl_xor(ss, 32); mx = fmaxf(mx, ss); }
                        mx = fmaxf(mx, __shfl_xor(mx, 1)); mx = fmaxf(mx, __shfl_xor(mx, 2)); mx = fmaxf(mx, __shfl_xor(mx, 4)); mx = fmaxf(mx, __shfl_xor(mx, 8));
                        if (fr == 0 && fq == 0) NP[((size_t)(2 * u.pn + bj - 24) * 128 + 4 * u.pm + 2 * ai + wr) * 4 + wc] = mx; }
            }
        } else {
            const int col0 = (u.pn - 24) * BM + wc * 32 + 8 * fq;
#pragma unroll
            for (int ai = 0; ai < 2; ++ai)
#pragma unroll
                for (int m = 0; m < 4; ++m) { const int r = row0 + ai * HALF + m * 16;
#pragma unroll
                    for (int bj = 0; bj < 2; ++bj) *(u32x4*)(G + (size_t)r * 4096 + col0 + bj * HALF) = pack8(sigmoid4(acc[ai][bj][m][0]), sigmoid4(acc[ai][bj][m][1])); }
        }
    }
};
struct EpiGateT {
    float* T; const bf16_t* G;
    __device__ __forceinline__ void operator()(const Acc& acc, const Unit& u, int wr, int wc, int fr, int fq) const {
        const int row0 = u.pm * BM + wr * 64 + fr, col0 = u.pn * BM + wc * 32 + 8 * fq;
#pragma unroll
        for (int ai = 0; ai < 2; ++ai)
#pragma unroll
            for (int m = 0; m < 4; ++m) { const int r = row0 + ai * HALF + m * 16;
#pragma unroll
                for (int bj = 0; bj < 2; ++bj) { const int c = col0 + bj * HALF; const u32x4 gw = *(const u32x4*)(G + (size_t)r * 4096 + c);
                    const f32x4 g0 = {bf_lo(gw.x), bf_hi(gw.x), bf_lo(gw.y), bf_hi(gw.y)}, g1 = {bf_lo(gw.z), bf_hi(gw.z), bf_lo(gw.w), bf_hi(gw.w)};
                    *(f32x4*)(T + (size_t)r * DM + c) = acc[ai][bj][m][0] * g0; *(f32x4*)(T + (size_t)r * DM + c + 4) = acc[ai][bj][m][1] * g1; } }
    }
};
struct EpiGateM {
    const float* T; const bf16_t* G; bf16_t* MB;
    __device__ __forceinline__ void operator()(const Acc& acc, const Unit& u, int wr, int wc, int fr, int fq) const {
        const int row0 = u.pm * BM + wr * 64 + fr, col0 = u.pn * BM + wc * 32 + 8 * fq;
#pragma unroll
        for (int ai = 0; ai < 2; ++ai)
#pragma unroll
            for (int m = 0; m < 4; ++m) { const int r = row0 + ai * HALF + m * 16;
#pragma unroll
                for (int bj = 0; bj < 2; ++bj) { const int c = col0 + bj * HALF; const u32x4 gw = *(const u32x4*)(G + (size_t)r * 4096 + 2048 + c);
                    const f32x4 g0 = {bf_lo(gw.x), bf_hi(gw.x), bf_lo(gw.y), bf_hi(gw.y)}, g1 = {bf_lo(gw.z), bf_hi(gw.z), bf_lo(gw.w), bf_hi(gw.w)};
                    const f32x4 t0 = *(const f32x4*)(T + (size_t)r * DM + c), t1 = *(const f32x4*)(T + (size_t)r * DM + c + 4);
                    *(u32x4*)(MB + (size_t)r * DM + c) = pack8(t0 + acc[ai][bj][m][0] * g0, t1 + acc[ai][bj][m][1] * g1); } }
    }
};
struct EpiGateHook {
    const bf16_t* G; bf16_t* MB;
    __device__ __forceinline__ void hook(Acc& acc, const Unit& u, int wr, int wc, int fr, int fq) const {
        int row0 = u.pm * BM + wr * 64 + fr, col0 = u.pn * BM + wc * 32 + 8 * fq;
        asm volatile("" : "+v"(row0), "+v"(col0));
#pragma unroll
        for (int ai = 0; ai < 2; ++ai)
#pragma unroll
            for (int m = 0; m < 4; ++m) { int r = row0 + ai * HALF + m * 16; asm volatile("" : "+v"(r));
#pragma unroll
                for (int bj = 0; bj < 2; ++bj) { const int c = col0 + bj * HALF; const u32x4 gd = *(const u32x4*)(G + (size_t)r * 4096 + c), gf = *(const u32x4*)(G + (size_t)r * 4096 + 2048 + c);
                    const f32x4 d0 = {bf_lo(gd.x), bf_hi(gd.x), bf_lo(gd.y), bf_hi(gd.y)}, d1 = {bf_lo(gd.z), bf_hi(gd.z), bf_lo(gd.w), bf_hi(gd.w)};
                    f32x4 f0 = {bf_lo(gf.x), bf_hi(gf.x), bf_lo(gf.y), bf_hi(gf.y)}, f1 = {bf_lo(gf.z), bf_hi(gf.z), bf_lo(gf.w), bf_hi(gf.w)};
#pragma unroll
                    for (int i = 0; i < 4; ++i) { f0[i] = __builtin_amdgcn_rcpf(fmaxf(f0[i], 1e-30f)); f1[i] = __builtin_amdgcn_rcpf(fmaxf(f1[i], 1e-30f)); }
                    acc[ai][bj][m][0] = acc[ai][bj][m][0] * (d0 * f0); acc[ai][bj][m][1] = acc[ai][bj][m][1] * (d1 * f1); }
                asm volatile("" ::: "memory"); }
    }
    __device__ __forceinline__ void operator()(const Acc& acc, const Unit& u, int wr, int wc, int fr, int fq) const {
        const int row0 = u.pm * BM + wr * 64 + fr, col0 = u.pn * BM + wc * 32 + 8 * fq;
#pragma unroll
        for (int ai = 0; ai < 2; ++ai)
#pragma unroll
            for (int m = 0; m < 4; ++m) { const int r = row0 + ai * HALF + m * 16;
#pragma unroll
                for (int bj = 0; bj < 2; ++bj) { const int c = col0 + bj * HALF; const u32x4 gw = *(const u32x4*)(G + (size_t)r * 4096 + 2048 + c);
                    const f32x4 g0 = {bf_lo(gw.x), bf_hi(gw.x), bf_lo(gw.y), bf_hi(gw.y)}, g1 = {bf_lo(gw.z), bf_hi(gw.z), bf_lo(gw.w), bf_hi(gw.w)};
                    *(u32x4*)(MB + (size_t)r * DM + c) = pack8(acc[ai][bj][m][0] * g0, acc[ai][bj][m][1] * g1); } }
    }
};
struct EpiZ {
    bf16_t* YO;
    __device__ __forceinline__ void operator()(const Acc& acc, const Unit& u, int wr, int wc, int fr, int fq) const {
        const int row0 = u.pm * BM + wr * 64 + fr, col0 = u.pn * BM + wc * 32 + 8 * fq;
#pragma unroll
        for (int ai = 0; ai < 2; ++ai)
#pragma unroll
            for (int m = 0; m < 4; ++m) { const int r = row0 + ai * HALF + m * 16;
#pragma unroll
                for (int bj = 0; bj < 2; ++bj) *(u32x4*)(YO + (size_t)r * DM + col0 + bj * HALF) = pack8(acc[ai][bj][m][0], acc[ai][bj][m][1]); }
    }
};
struct EpiSwiGLU {
    bf16_t* H;
    __device__ __forceinline__ void operator()(const Acc& acc, const Unit& u, int wr, int wc, int fr, int fq) const {
        const int row0 = u.pm * BM + wr * 64 + fr, col0 = u.pn * HALF + wc * 32 + 8 * fq;
#pragma unroll
        for (int ai = 0; ai < 2; ++ai)
#pragma unroll
            for (int m = 0; m < 4; ++m) { const int r = row0 + ai * HALF + m * 16; f32x4 h[2];
#pragma unroll
                for (int n = 0; n < 2; ++n) { const f32x4 gt = acc[ai][0][m][n], up = acc[ai][1][m][n]; h[n] = gt * sigmoid4(gt) * up; }
                *(u32x4*)(H + (size_t)r * FF + col0) = pack8(h[0], h[1]); }
    }
};
struct EpiY {
    bf16_t* Y;
    __device__ __forceinline__ void operator()(const Acc& acc, const Unit& u, int wr, int wc, int fr, int fq) const {
        const int row0 = u.pm * BM + wr * 64 + fr, col0 = (u.pn & 7) * BM + wc * 32 + 8 * fq;
#pragma unroll
        for (int ai = 0; ai < 2; ++ai)
#pragma unroll
            for (int m = 0; m < 4; ++m) { const int r = row0 + ai * HALF + m * 16;
#pragma unroll
                for (int bj = 0; bj < 2; ++bj) *(u32x4*)(Y + (size_t)r * DM + col0 + bj * HALF) = pack8(acc[ai][bj][m][0], acc[ai][bj][m][1]); }
    }
};
}

namespace att {
using bf16 = __hip_bfloat16;
constexpr int D = 128, NW = 8, QBLK = 32, KVBLK = 64, QB = NW * QBLK;
constexpr int SHM_V = KVBLK * D * 2, SHM_K = KVBLK * D * 2;
constexpr int LDS_WS_OFF = 2 * SHM_V + 2 * SHM_K, LDS_BIAS_OFF = LDS_WS_OFF + NW * 64 * 4, LDS_BYTES = LDS_BIAS_OFF + 512;
constexpr float SCALE = 0.08838834764831845f;
constexpr float THR = 8.f;
#define KSWZ(row, colB) ((row) * 256 + ((colB) ^ (((row) & 7) << 4)))
#define SBAR() __builtin_amdgcn_sched_barrier(0)
__device__ __forceinline__ int v_st(int k, int c) { const int kk = (k & ~0xC) | ((k & 4) << 1) | ((k & 8) >> 1); return ((kk >> 3) * 4 + (c >> 5)) * 512 + ((kk & 7) * 32 + (c & 31)) * 2; }
__device__ __forceinline__ int v_rd_base(int lane) { return ((lane & 3) << 3) | (((lane >> 2) & 3) << 6) | (((lane >> 4) & 1) << 5) | (((lane >> 5) & 1) << 8); }
constexpr int v_rd_off(int d0, int ks, int half) { return d0 * 512 + ks * 4096 + half * 2048; }
__device__ __forceinline__ int crow(int r, int hi) { return (r & 3) + 8 * (r >> 2) + 4 * hi; }
__device__ __forceinline__ unsigned cvtpk(float lo, float hi) { unsigned r; asm volatile("v_cvt_pk_bf16_f32 %0, %1, %2" : "=v"(r) : "v"(lo), "v"(hi)); return r; }
__device__ __forceinline__ bf16x8 load8(const bf16* p) { return *reinterpret_cast<const bf16x8*>(p); }
__device__ __forceinline__ void mask_tile(f32x16& p0, f32x16& p1, int dq) {
    const float NEG = -__builtin_inff();
#pragma unroll
    for (int r = 0; r < 16; ++r) { const int c = (r & 3) + 8 * (r >> 2); if (dq - c < 0) p0[r] = NEG; if (dq - c - 32 < 0) p1[r] = NEG; }
}
__device__ __forceinline__ void partialSM(f32x16& p0, f32x16& p1, float& m_reg, float& mn, float& alpha) {
    float pmax = p0[0];
#pragma unroll
    for (int r = 1; r < 16; ++r) pmax = fmaxf(pmax, p0[r]);
#pragma unroll
    for (int r = 0; r < 16; ++r) pmax = fmaxf(pmax, p1[r]);
    { auto rr = __builtin_amdgcn_permlane32_swap(__float_as_uint(pmax), __float_as_uint(pmax), false, false); pmax = fmaxf(__uint_as_float(rr[0]), __uint_as_float(rr[1])); }
    constexpr float C2 = 1.4426950408889634f * SCALE;
    if (__builtin_expect(__all((pmax - m_reg) * SCALE <= THR), 1)) { mn = m_reg; alpha = 1.f; }
    else { mn = fmaxf(m_reg, pmax); alpha = __builtin_amdgcn_exp2f((m_reg - mn) * C2); m_reg = mn; }
    const float mnL = -mn * C2;
#pragma unroll
    for (int r = 0; r < 16; ++r) p0[r] = fmaf(p0[r], C2, mnL);
#pragma unroll
    for (int r = 0; r < 16; ++r) p1[r] = fmaf(p1[r], C2, mnL);
#pragma unroll
    for (int r = 0; r < 16; ++r) p0[r] = __builtin_amdgcn_exp2f(p0[r]);
}
__device__ __forceinline__ void finishSM(f32x16& p0, f32x16& p1, float alpha, float& l_reg, bf16x8& pa0, bf16x8& pa1, bf16x8& pa2, bf16x8& pa3) {
#pragma unroll
    for (int r = 0; r < 16; ++r) p1[r] = __builtin_amdgcn_exp2f(p1[r]);
    float ps = 0;
#pragma unroll
    for (int r = 0; r < 16; ++r) ps += p0[r];
#pragma unroll
    for (int r = 0; r < 16; ++r) ps += p1[r];
    { auto rr = __builtin_amdgcn_permlane32_swap(__float_as_uint(ps), __float_as_uint(ps), false, false); ps = __uint_as_float(rr[0]) + __uint_as_float(rr[1]); }
    l_reg = l_reg * alpha + ps;
#define PK4(P, B_, OUT) do { unsigned a0 = cvtpk(P[B_+0], P[B_+1]), a1 = cvtpk(P[B_+2], P[B_+3]);                          \
        unsigned b0 = cvtpk(P[B_+4], P[B_+5]), b1 = cvtpk(P[B_+6], P[B_+7]);                                             \
        auto r0 = __builtin_amdgcn_permlane32_swap(a0, b0, false, false); auto r1 = __builtin_amdgcn_permlane32_swap(a1, b1, false, false); \
        u32x4 w = {r0[0], r1[0], r0[1], r1[1]}; OUT = *reinterpret_cast<bf16x8*>(&w); } while (0)
    PK4(p0, 0, pa0); PK4(p0, 8, pa1); PK4(p1, 0, pa2); PK4(p1, 8, pa3);
#undef PK4
}
template <int KB>
__device__ __forceinline__ void qkt(f32x16& p0, f32x16& p1, const char* K_lds, const char* B_lds, int r32, int hi, const bf16x8* qr) {
    const float* bl = (const float*)(B_lds + KB * 256) + 4 * hi;
#pragma unroll
    for (int g = 0; g < 4; ++g) { const f32x4 b0 = *(const f32x4*)(bl + 8 * g), b1 = *(const f32x4*)(bl + 32 + 8 * g);
#pragma unroll
        for (int i = 0; i < 4; ++i) { p0[4 * g + i] = b0[i]; p1[4 * g + i] = b1[i]; } }
    const char* kb[4];
#pragma unroll
    for (int dd = 0; dd < 4; ++dd) kb[dd] = K_lds + KB * SHM_K + KSWZ(r32, (dd * 16 + hi * 8) * 2);
#pragma unroll
    for (int d0 = 0; d0 < 8; ++d0) { const char* a = kb[d0 & 3] + (d0 >> 2) * 128;
        bf16x8 b0 = *reinterpret_cast<const bf16x8*>(a);
        bf16x8 b1 = *reinterpret_cast<const bf16x8*>(a + 32 * 256);
        p0 = __builtin_amdgcn_mfma_f32_32x32x16_bf16(b0, qr[d0], p0, 0, 0, 0);
        p1 = __builtin_amdgcn_mfma_f32_32x32x16_bf16(b1, qr[d0], p1, 0, 0, 0); }
}
template <int VB>
__device__ __forceinline__ void pv_tile(f32x16* o, int vb0, bf16x8 pa0, bf16x8 pa1, bf16x8 pa2, bf16x8 pa3) {
#define TRRD(dst, off) asm volatile("ds_read_b64_tr_b16 %0, %1 offset:%2" : "=&v"(dst) : "v"(vb0), "i"(off) : "memory")
#define PV_D0(d0) do { s16x4 l0, l1, l2, l3, h0, h1, h2, h3; constexpr int b_ = VB * SHM_V + v_rd_off(d0, 0, 0); \
        TRRD(l0, b_); TRRD(h0, b_ + 2048); TRRD(l1, b_ + 4096); TRRD(h1, b_ + 6144); TRRD(l2, b_ + 8192); TRRD(h2, b_ + 10240); TRRD(l3, b_ + 12288); TRRD(h3, b_ + 14336); \
        asm volatile("s_waitcnt lgkmcnt(0)" ::: "memory"); SBAR();   \
        o[d0] = __builtin_amdgcn_mfma_f32_32x32x16_bf16(pa0, (bf16x8){l0[0], l0[1], l0[2], l0[3], h0[0], h0[1], h0[2], h0[3]}, o[d0], 0, 0, 0);   \
        o[d0] = __builtin_amdgcn_mfma_f32_32x32x16_bf16(pa1, (bf16x8){l1[0], l1[1], l1[2], l1[3], h1[0], h1[1], h1[2], h1[3]}, o[d0], 0, 0, 0);   \
        o[d0] = __builtin_amdgcn_mfma_f32_32x32x16_bf16(pa2, (bf16x8){l2[0], l2[1], l2[2], l2[3], h2[0], h2[1], h2[2], h2[3]}, o[d0], 0, 0, 0);   \
        o[d0] = __builtin_amdgcn_mfma_f32_32x32x16_bf16(pa3, (bf16x8){l3[0], l3[1], l3[2], l3[3], h3[0], h3[1], h3[2], h3[3]}, o[d0], 0, 0, 0); } while (0)
    PV_D0(0); PV_D0(1); PV_D0(2); PV_D0(3);
#undef PV_D0
#undef TRRD
}
struct BlockRef { const bf16* Q; const bf16* K; const bf16* V; const float* B; bf16* O; int ostride; int P0; int jlo; };
struct Seam { bf16x8 qr[8]; bf16x8 st_v0, st_v1, st_k0, st_k1; };
#define ROW(p, k0, rr) ((p) + (size_t)((k0) + (rr)) * D + sc)
#define VMW() asm volatile("s_waitcnt vmcnt(0)" ::: "memory")
#define VMWN(n) asm volatile("s_waitcnt vmcnt(%0)" :: "i"(n) : "memory")
#define SLOAD_H(Kp, Vp, k0) do { S.st_v0 = load8(ROW(Vp, k0, sr)); S.st_v1 = load8(ROW(Vp, k0, 32 + sr));              \
                         S.st_k0 = load8(ROW(Kp, k0, sr)); S.st_k1 = load8(ROW(Kp, k0, 32 + sr)); } while (0)
#define BLOAD(Bp, k0, bf) do { if (wid == 0) __builtin_amdgcn_global_load_lds((const unsigned*)((Bp) + (k0) + lane), (LAS unsigned*)(lds3 + LDS_BIAS_OFF + (bf) * 256), 4, 0, 0); } while (0)
#define SWRITE_HK(bf) do { *(bf16x8*)(K_lds + (bf) * SHM_K + kws) = S.st_k0; *(bf16x8*)(K_lds + (bf) * SHM_K + kws + 32 * 256) = S.st_k1; } while (0)
#define SWRITE_HV(bf) do { *(bf16x8*)(V_lds + (bf) * SHM_V + vst0) = S.st_v0; *(bf16x8*)(V_lds + (bf) * SHM_V + vst1) = S.st_v1; } while (0)
#define SWRITE_H(bf) do { SWRITE_HV(bf); SWRITE_HK(bf); } while (0)
__device__ __forceinline__ void attn_prime(const BlockRef& cur, char* lds, LAS unsigned char* lds3, Seam& S) {
    int tid = threadIdx.x; asm volatile("" : "+v"(tid)); const int wid = __builtin_amdgcn_readfirstlane(tid >> 6), lane = tid & 63, r32 = lane & 31, hi = lane >> 5;
    const int sr = tid >> 4, sc = (tid & 15) * 8, kws = KSWZ(sr, sc * 2); char* K_lds = lds + 2 * SHM_V;
#pragma unroll
    for (int d0 = 0; d0 < 8; ++d0) S.qr[d0] = load8(cur.Q + (size_t)(wid * QBLK + r32) * D + d0 * 16 + hi * 8);
    SLOAD_H(cur.K, cur.V, 0); BLOAD(cur.B, 0, 0); VMW(); SWRITE_HK(0);
    __syncthreads();
}
__device__ __forceinline__ void attn_block(const BlockRef& cur, const BlockRef& nxt, char* lds, LAS unsigned char* lds3, Seam& S) {
    int tid = threadIdx.x; asm volatile("" : "+v"(tid)); const int wid = __builtin_amdgcn_readfirstlane(tid >> 6), lane = tid & 63, r32 = lane & 31, hi = lane >> 5;
    const int NT = (cur.P0 + QB) / KVBLK - cur.jlo;
    const int qlo = cur.P0 + wid * QBLK, qm = qlo + r32 - 4 * hi;
    char* V_lds = lds; char* K_lds = lds + 2 * SHM_V; const char* B_lds = lds + LDS_BIAS_OFF;
    float* ws = (float*)(lds + LDS_WS_OFF) + wid * 64; float* li_l = ws, * al_l = ws + 32;
    float m_reg = -1e30f, l_reg = 0; f32x16 o[4] = {};
    const int sr = tid >> 4, sc = (tid & 15) * 8, vst0 = v_st(sr, sc), vst1 = v_st(32 + sr, sc), kws = KSWZ(sr, sc * 2);
    const int vb0 = (int)(uintptr_t)V_lds + v_rd_base(lane);
    const bf16* Kh = cur.K; const bf16* Vh = cur.V; const float* Bh = cur.B;
#define RESC(a) do { if (__any((a) < 1.f)) { if (hi == 0) al_l[r32] = (a); asm volatile("s_waitcnt lgkmcnt(0)" ::: "memory");              \
                     _Pragma("unroll") for (int d_ = 0; d_ < 4; ++d_) _Pragma("unroll") for (int r = 0; r < 16; ++r) o[d_][r] *= al_l[crow(r, hi)]; } } while (0)
#define KBASE(t) ((t) * KVBLK)
#define MASKT(P0_, P1_, t) do { const int kb_ = KBASE((t) + cur.jlo); if (kb_ + KVBLK - 1 > qlo) mask_tile(P0_, P1_, qm - kb_); } while (0)
    f32x16 pA0, pA1, pB0, pB1; float mnA, mnB, alA, alB; bf16x8 pa0, pa1, pa2, pa3;
    SWRITE_HV(0); SBAR();
    SLOAD_H(Kh, Vh, KBASE(1)); BLOAD(Bh, KBASE(1), 1);
    SBAR(); qkt<0>(pA0, pA1, K_lds, B_lds, r32, hi, S.qr);
    MASKT(pA0, pA1, 0); partialSM(pA0, pA1, m_reg, mnA, alA);
    VMW(); SWRITE_H(1);
    __syncthreads();
#define HALF_STEP(PX0, PX1, mnX, alX, PY0, PY1, alY, t, KB, VB, SB) do {                                                      \
        SBAR(); qkt<KB>(PX0, PX1, K_lds, B_lds, r32, hi, S.qr);                                                               \
        finishSM(PY0, PY1, alY, l_reg, pa0, pa1, pa2, pa3); SBAR();                                                           \
        if ((t) + 1 < NT) { SLOAD_H(Kh, Vh, KBASE((t) + 1)); BLOAD(Bh, KBASE((t) + 1), SB); SBAR(); }                        \
        pv_tile<VB>(o, vb0, pa0, pa1, pa2, pa3); MASKT(PX0, PX1, (t)); partialSM(PX0, PX1, m_reg, mnX, alX);                  \
        __syncthreads();                                                                                                      \
        if ((t) + 1 < NT) { VMW(); SWRITE_H(SB); }                                                                            \
        RESC(alX); __syncthreads(); } while (0)
    for (int t = 1; t + 1 < NT; t += 2) {
        HALF_STEP(pB0, pB1, mnB, alB, pA0, pA1, alA, t, 1, 0, 0);
        HALF_STEP(pA0, pA1, mnA, alA, pB0, pB1, alB, t + 1, 0, 1, 1);
    }
    SBAR(); qkt<1>(pB0, pB1, K_lds, B_lds, r32, hi, S.qr); SBAR();
    SLOAD_H(nxt.K, nxt.V, 0); BLOAD(nxt.B, 0, 0); SBAR();
#pragma unroll
    for (int d0 = 0; d0 < 8; ++d0) S.qr[d0] = load8(nxt.Q + (size_t)(wid * QBLK + r32) * D + d0 * 16 + hi * 8);
    SBAR();
    finishSM(pA0, pA1, alA, l_reg, pa0, pa1, pa2, pa3); SBAR();
    pv_tile<0>(o, vb0, pa0, pa1, pa2, pa3);
    MASKT(pB0, pB1, NT - 1); partialSM(pB0, pB1, m_reg, mnB, alB); __syncthreads(); RESC(alB);
    finishSM(pB0, pB1, alB, l_reg, pa0, pa1, pa2, pa3); SBAR(); pv_tile<1>(o, vb0, pa0, pa1, pa2, pa3);
    SBAR(); VMWN(8); SWRITE_HK(0); SBAR();
    if (hi == 0) li_l[r32] = l_reg; asm volatile("s_waitcnt lgkmcnt(0)" ::: "memory");
    float rli[16];
#pragma unroll
    for (int r = 0; r < 16; ++r) rli[r] = __builtin_amdgcn_rcpf(li_l[crow(r, hi)]);
    bf16* Ow = cur.O + (size_t)(wid * QBLK) * cur.ostride;
#pragma unroll
    for (int r = 0; r < 16; ++r) { const int orow = crow(r, hi);
#pragma unroll
        for (int d0 = 0; d0 < 4; ++d0) { const float v = o[d0][r] * rli[r];
            const float vn = __shfl_xor(v, 1);
            if ((r32 & 1) == 0) *(unsigned*)(Ow + (size_t)orow * cur.ostride + d0 * 32 + r32) = cvtpk(v, vn); } }
    __syncthreads();
#undef RESC
#undef KBASE
#undef MASKT
#undef HALF_STEP
}

constexpr int DK_OFF = 49152, DWS_OFF = 81920, DV1_OFF = 83968, DP_OFF = 133120, DATT_LDS_END = DP_OFF + 16384;
struct DRef { const bf16* Q; const bf16* K; const bf16* V0; const bf16* V1; bf16* O0; bf16* O1; int P0; };
template <int KB>
__device__ __forceinline__ void qkt0(f32x16& p0, f32x16& p1, const char* K_lds, int r32, int hi, const bf16x8* qr) {
    p0 = f32x16{}; p1 = f32x16{};
    const char* kb[4];
#pragma unroll
    for (int dd = 0; dd < 4; ++dd) kb[dd] = K_lds + KB * SHM_K + KSWZ(r32, (dd * 16 + hi * 8) * 2);
#pragma unroll
    for (int d0 = 0; d0 < 8; ++d0) { const char* a = kb[d0 & 3] + (d0 >> 2) * 128;
        bf16x8 b0 = *reinterpret_cast<const bf16x8*>(a);
        bf16x8 b1 = *reinterpret_cast<const bf16x8*>(a + 32 * 256);
        p0 = __builtin_amdgcn_mfma_f32_32x32x16_bf16(b0, qr[d0], p0, 0, 0, 0);
        p1 = __builtin_amdgcn_mfma_f32_32x32x16_bf16(b1, qr[d0], p1, 0, 0, 0); }
}
#define D_KLOAD(Kp, k0) do { _Pragma("unroll") for (int j_ = 0; j_ < 4; ++j_) kst[j_] = load8((Kp) + (size_t)((k0) + sr + 16 * j_) * D + sc); } while (0)
#define D_KWRITE(bf) do { _Pragma("unroll") for (int j_ = 0; j_ < 4; ++j_) *(bf16x8*)(K_lds + (bf) * SHM_K + kws + j_ * 4096) = kst[j_]; } while (0)
#define D_VLOAD(V0p, V1p, k0) do { unsigned vo_ = (unsigned)(sr * D + sc) * 2u; asm volatile("" : "+v"(vo_));   \
        _Pragma("unroll") for (int j_ = 0; j_ < 4; ++j_) { vs[j_] = load8((const bf16*)((const char*)((V0p) + (size_t)((k0) + 16 * j_) * D) + vo_)); vs[4 + j_] = load8((const bf16*)((const char*)((V1p) + (size_t)((k0) + 16 * j_) * D) + vo_)); } } while (0)
#define D_VWRITE(sl_) do { int sr_ = sr; asm volatile("" : "+v"(sr_)); _Pragma("unroll") for (int j_ = 0; j_ < 4; ++j_) { const int vs_ = v_st(sr_ + 16 * j_, sc); *(bf16x8*)(V_lds + (sl_) * SHM_V + vs_) = vs[j_]; *(bf16x8*)(V1_lds + (sl_) * SHM_V + vs_) = vs[4 + j_]; } } while (0)
#define D_PEXPORT() do { bf16x8* pp_ = (bf16x8*)P_lds + lane; pp_[0] = pa0; pp_[64] = pa1; pp_[128] = pa2; pp_[192] = pa3; } while (0)
#define D_PIMPORT() do { const bf16x8* pp_ = (const bf16x8*)P_lds + lane; pa0 = pp_[0]; pa1 = pp_[64]; pa2 = pp_[128]; pa3 = pp_[192]; } while (0)
#define D_AEXPORT(par, a) do { if (hi == 0) al_l[(par) * 32 + r32] = (a); } while (0)
#define D_RESC(par) do { const float* ap_ = al_l + (par) * 32; const float a_ = ap_[r32]; if (__any(a_ < 1.f)) { _Pragma("unroll") for (int d_ = 0; d_ < 4; ++d_) _Pragma("unroll") for (int r = 0; r < 16; ++r) { const float f_ = ap_[crow(r, hi)]; o0[d_][r] *= f_; o1[d_][r] *= f_; } } } while (0)
#define D_OSTORE(Op, oo) do { int rq_ = r32, hq_ = hi; asm volatile("" : "+v"(rq_), "+v"(hq_));   bf16* Ow = (Op) + (size_t)((wid & 3) * QBLK) * D + rq_; \
        _Pragma("unroll") for (int r = 0; r < 16; ++r) { const int orow = crow(r, hq_); \
            const float rl_ = __builtin_amdgcn_rcpf(li_l[orow]); \
            _Pragma("unroll") for (int d0 = 0; d0 < 4; ++d0) { const float v = oo[d0][r] * rl_; const float vn = __shfl_xor(v, 1); \
                if ((r32 & 1) == 0) *(unsigned*)(Ow + (size_t)orow * D + d0 * 32) = cvtpk(v, vn); } } } while (0)
__device__ __forceinline__ void pv_both(f32x16* o0, f32x16* o1, int vb0s, int vb1s, bf16x8 pa0, bf16x8 pa1, bf16x8 pa2, bf16x8 pa3) {
#define TRRD(dst, base, off) asm volatile("ds_read_b64_tr_b16 %0, %1 offset:%2" : "=&v"(dst) : "v"(base), "i"(off) : "memory")
#define TR8(P, base, d0) do { constexpr int b_ = v_rd_off(d0, 0, 0); TRRD(P##l0, base, b_); TRRD(P##h0, base, b_ + 2048); TRRD(P##l1, base, b_ + 4096); TRRD(P##h1, base, b_ + 6144); \
        TRRD(P##l2, base, b_ + 8192); TRRD(P##h2, base, b_ + 10240); TRRD(P##l3, base, b_ + 12288); TRRD(P##h3, base, b_ + 14336); } while (0)
#define MM4(P, acc) do { \
        acc = __builtin_amdgcn_mfma_f32_32x32x16_bf16(pa0, (bf16x8){P##l0[0], P##l0[1], P##l0[2], P##l0[3], P##h0[0], P##h0[1], P##h0[2], P##h0[3]}, acc, 0, 0, 0); \
        acc = __builtin_amdgcn_mfma_f32_32x32x16_bf16(pa1, (bf16x8){P##l1[0], P##l1[1], P##l1[2], P##l1[3], P##h1[0], P##h1[1], P##h1[2], P##h1[3]}, acc, 0, 0, 0); \
        acc = __builtin_amdgcn_mfma_f32_32x32x16_bf16(pa2, (bf16x8){P##l2[0], P##l2[1], P##l2[2], P##l2[3], P##h2[0], P##h2[1], P##h2[2], P##h2[3]}, acc, 0, 0, 0); \
        acc = __builtin_amdgcn_mfma_f32_32x32x16_bf16(pa3, (bf16x8){P##l3[0], P##l3[1], P##l3[2], P##l3[3], P##h3[0], P##h3[1], P##h3[2], P##h3[3]}, acc, 0, 0, 0); } while (0)
#define WAIT8() do { asm volatile("s_waitcnt lgkmcnt(8)" ::: "memory"); SBAR(); } while (0)
#define WAIT0() do { asm volatile("s_waitcnt lgkmcnt(0)" ::: "memory"); SBAR(); } while (0)
    s16x4 Al0, Al1, Al2, Al3, Ah0, Ah1, Ah2, Ah3, Bl0, Bl1, Bl2, Bl3, Bh0, Bh1, Bh2, Bh3;
    TR8(A, vb0s, 0);
    TR8(B, vb1s, 0); WAIT8(); MM4(A, o0[0]);
    TR8(A, vb0s, 1); WAIT8(); MM4(B, o1[0]);
    TR8(B, vb1s, 1); WAIT8(); MM4(A, o0[1]);
    TR8(A, vb0s, 2); WAIT8(); MM4(B, o1[1]);
    TR8(B, vb1s, 2); WAIT8(); MM4(A, o0[2]);
    TR8(A, vb0s, 3); WAIT8(); MM4(B, o1[2]);
    TR8(B, vb1s, 3); WAIT8(); MM4(A, o0[3]);
    WAIT0(); MM4(B, o1[3]);
#undef TRRD
#undef TR8
#undef MM4
#undef WAIT8
#undef WAIT0
}
__device__ __forceinline__ void pv_one(f32x16* o, int vbs, bf16x8 pa0, bf16x8 pa1, bf16x8 pa2, bf16x8 pa3) {
#define TRRD(dst, base, off) asm volatile("ds_read_b64_tr_b16 %0, %1 offset:%2" : "=&v"(dst) : "v"(base), "i"(off) : "memory")
#define TR8(P, base, d0) do { constexpr int b_ = v_rd_off(d0, 0, 0); TRRD(P##l0, base, b_); TRRD(P##h0, base, b_ + 2048); TRRD(P##l1, base, b_ + 4096); TRRD(P##h1, base, b_ + 6144); \
        TRRD(P##l2, base, b_ + 8192); TRRD(P##h2, base, b_ + 10240); TRRD(P##l3, base, b_ + 12288); TRRD(P##h3, base, b_ + 14336); } while (0)
#define MM4(P, acc) do { \
        acc = __builtin_amdgcn_mfma_f32_32x32x16_bf16(pa0, (bf16x8){P##l0[0], P##l0[1], P##l0[2], P##l0[3], P##h0[0], P##h0[1], P##h0[2], P##h0[3]}, acc, 0, 0, 0); \
        acc = __builtin_amdgcn_mfma_f32_32x32x16_bf16(pa1, (bf16x8){P##l1[0], P##l1[1], P##l1[2], P##l1[3], P##h1[0], P##h1[1], P##h1[2], P##h1[3]}, acc, 0, 0, 0); \
        acc = __builtin_amdgcn_mfma_f32_32x32x16_bf16(pa2, (bf16x8){P##l2[0], P##l2[1], P##l2[2], P##l2[3], P##h2[0], P##h2[1], P##h2[2], P##h2[3]}, acc, 0, 0, 0); \
        acc = __builtin_amdgcn_mfma_f32_32x32x16_bf16(pa3, (bf16x8){P##l3[0], P##l3[1], P##l3[2], P##l3[3], P##h3[0], P##h3[1], P##h3[2], P##h3[3]}, acc, 0, 0, 0); } while (0)
    s16x4 Al0, Al1, Al2, Al3, Ah0, Ah1, Ah2, Ah3, Bl0, Bl1, Bl2, Bl3, Bh0, Bh1, Bh2, Bh3;
    TR8(A, vbs, 0);
    TR8(B, vbs, 1); asm volatile("s_waitcnt lgkmcnt(8)" ::: "memory"); SBAR(); MM4(A, o[0]);
    TR8(A, vbs, 2); asm volatile("s_waitcnt lgkmcnt(8)" ::: "memory"); SBAR(); MM4(B, o[1]);
    TR8(B, vbs, 3); asm volatile("s_waitcnt lgkmcnt(8)" ::: "memory"); SBAR(); MM4(A, o[2]);
    asm volatile("s_waitcnt lgkmcnt(0)" ::: "memory"); SBAR(); MM4(B, o[3]);
#undef TRRD
#undef TR8
#undef MM4
}
struct DQueue { unsigned* ctr; volatile LAS unsigned* slot; const bf16* QKV; bf16* OD; };
constexpr int DS_ = 8192, DNITEM = 512;
__device__ __forceinline__ int dfetch(const DQueue& q, int& par, int tid) {
    if (tid == 0) q.slot[par] = __hip_atomic_fetch_add(q.ctr, 1u, __ATOMIC_RELAXED, __HIP_MEMORY_SCOPE_AGENT);
    __syncthreads(); const int v = __builtin_amdgcn_readfirstlane((int)q.slot[par]); par ^= 1; return v;
}
__device__ __forceinline__ DRef dref_of(const DQueue& q, int item) {
    DRef r; const int m = item & 7, qb = 63 - (item >> 3);
    r.Q = q.QKV + ((size_t)m * DS_ + qb * 128) * 128; r.K = q.QKV + (size_t)(8 + m) * DS_ * 128;
    r.V0 = q.QKV + (size_t)(16 + (m >> 1) * 2) * DS_ * 128; r.V1 = r.V0 + (size_t)DS_ * 128;
    r.O0 = q.OD + ((size_t)(2 * m) * DS_ + qb * 128) * 128; r.O1 = q.OD + ((size_t)(2 * m + 1) * DS_ + qb * 128) * 128; r.P0 = qb * 128; return r;
}
#define KBASE(t) ((t) * KVBLK)
__device__ __forceinline__ void dattn_S(char* lds, const DQueue& Q_) {
    int tid = threadIdx.x; asm volatile("" : "+v"(tid)); const int wid = __builtin_amdgcn_readfirstlane(tid >> 6), lane = tid & 63, r32 = lane & 31, hi = lane >> 5;
    const int t8 = tid & 255, sr = t8 >> 4, sc = (t8 & 15) * 8, kws = KSWZ(sr, sc * 2);
    char* K_lds = lds + DK_OFF; char* P_lds = lds + DP_OFF + (wid & 3) * 4096;
    float* ws = (float*)(lds + DWS_OFF) + (wid & 3) * 128; float* li_l = ws, * al_l = ws + 32;
    int par = 0; int item = dfetch(Q_, par, tid); if (item >= DNITEM) return;
    DRef cur = dref_of(Q_, item);
    bf16x8 qr[8], kst[4], pa0, pa1, pa2, pa3;
#pragma unroll
    for (int d0 = 0; d0 < 8; ++d0) qr[d0] = load8(cur.Q + (size_t)(wid * QBLK + r32) * D + d0 * 16 + hi * 8);
    D_KLOAD(cur.K, 0); VMW(); D_KWRITE(0);
    __syncthreads();
    for (;;) {
        const int nitem = dfetch(Q_, par, tid); const bool more = nitem < DNITEM; const DRef nxt = more ? dref_of(Q_, nitem) : cur;
        const int NT = (cur.P0 + 128) / KVBLK;
        const int qlo = cur.P0 + wid * QBLK, qm = qlo + r32 - 4 * hi;
        float m_reg = -1e30f, l_reg = 0; const bf16* Kh = cur.K;
        f32x16 pA0, pA1, pB0, pB1; float mnA, mnB, alA = 1.f, alB = 1.f;
#define MASKT(P0_, P1_, t) do { const int kb_ = KBASE(t); if (kb_ + KVBLK - 1 > qlo) mask_tile(P0_, P1_, qm - kb_); } while (0)
#define SSTEP(PX0, PX1, mnX, alX, PY0, PY1, alY, t, KB, FS) do {                                                              \
        SBAR(); qkt0<KB>(PX0, PX1, K_lds, r32, hi, qr);                                                                       \
        if (FS) { finishSM(PY0, PY1, alY, l_reg, pa0, pa1, pa2, pa3); D_PEXPORT(); } SBAR();                                  \
        if ((t) + 1 < NT) { D_KLOAD(Kh, KBASE((t) + 1)); }                                                                    \
        else { D_KLOAD(nxt.K, 0); SBAR();                                                                                     \
               _Pragma("unroll") for (int d0 = 0; d0 < 8; ++d0) qr[d0] = load8(nxt.Q + (size_t)(wid * QBLK + r32) * D + d0 * 16 + hi * 8); }   \
        SBAR(); __syncthreads();                                                                                     \
        MASKT(PX0, PX1, (t)); partialSM(PX0, PX1, m_reg, mnX, alX); D_AEXPORT(KB, alX);                                       \
        if ((t) + 1 < NT) { VMW(); } else { VMWN(8); }                                                                        \
        D_KWRITE((KB) ^ 1); SBAR();                                                                                           \
        __syncthreads();                                                                                             \
        } while (0)
        SSTEP(pA0, pA1, mnA, alA, pB0, pB1, alB, 0, 0, false);
        for (int t = 1; t < NT; t += 2) {
            SSTEP(pB0, pB1, mnB, alB, pA0, pA1, alA, t, 1, true);
            if (t + 1 < NT) SSTEP(pA0, pA1, mnA, alA, pB0, pB1, alB, t + 1, 0, true);
        }
        finishSM(pB0, pB1, alB, l_reg, pa0, pa1, pa2, pa3); D_PEXPORT(); if (hi == 0) li_l[r32] = l_reg;
        __syncthreads();
        __syncthreads();
#undef MASKT
#undef SSTEP
        if (!more) break;
        cur = nxt;
    }
}
__device__ __forceinline__ void dattn_V(char* lds, const DQueue& Q_) {
    int tid = threadIdx.x; asm volatile("" : "+v"(tid)); const int wid = __builtin_amdgcn_readfirstlane(tid >> 6), lane = tid & 63, r32 = lane & 31, hi = lane >> 5;
    const int t8 = tid & 255, sr = t8 >> 4, sc = (t8 & 15) * 8;
    char* V_lds = lds; char* V1_lds = lds + DV1_OFF; char* P_lds = lds + DP_OFF + (wid & 3) * 4096;
    float* ws = (float*)(lds + DWS_OFF) + (wid & 3) * 128; float* li_l = ws, * al_l = ws + 32;
    const int vb0 = (int)(uintptr_t)V_lds + v_rd_base(lane), vb1 = (int)(uintptr_t)V1_lds + v_rd_base(lane);
    int par = 0; int item = dfetch(Q_, par, tid); if (item >= DNITEM) return;
    DRef cur = dref_of(Q_, item);
    bf16x8 vs[8], pa0, pa1, pa2, pa3;
    D_VLOAD(cur.V0, cur.V1, 0); VMW(); D_VWRITE(0);
    __syncthreads();
    int s_prev = 2, s_next = 1;
    for (;;) {
        const int nitem = dfetch(Q_, par, tid); const bool more = nitem < DNITEM; const DRef nxt = more ? dref_of(Q_, nitem) : cur;
        const int NT = (cur.P0 + 128) / KVBLK;
        f32x16 o0[4] = {}, o1[4] = {};
        int t = 0;
        int s_pp = (s_prev == 0) ? 2 : s_prev - 1;
        do {
            if (t + 1 < NT) D_VLOAD(cur.V0, cur.V1, KBASE(t + 1)); else D_VLOAD(nxt.V0, nxt.V1, 0);
            if (t >= 2) pv_one(o1, vb1 + s_pp * SHM_V, pa0, pa1, pa2, pa3);
            __syncthreads();
            VMW(); D_VWRITE(s_next);
            if (t >= 1) { D_RESC((t - 1) & 1); D_PIMPORT(); asm volatile("s_waitcnt lgkmcnt(0)" ::: "memory");
                pv_one(o0, vb0 + s_prev * SHM_V, pa0, pa1, pa2, pa3); }
            __syncthreads();
            s_pp = s_prev; s_prev = (s_prev == 2) ? 0 : s_prev + 1; s_next = (s_next == 2) ? 0 : s_next + 1;
        } while (++t < NT);
        pv_one(o1, vb1 + s_pp * SHM_V, pa0, pa1, pa2, pa3);
        __syncthreads();
        D_RESC((NT - 1) & 1); D_PIMPORT(); asm volatile("s_waitcnt lgkmcnt(0)" ::: "memory");
        pv_both(o0, o1, vb0 + s_prev * SHM_V, vb1 + s_prev * SHM_V, pa0, pa1, pa2, pa3);
        D_OSTORE(cur.O0, o0); D_OSTORE(cur.O1, o1);
        __syncthreads();
        if (!more) break;
        cur = nxt;
    }
}
#undef KBASE
#undef D_KLOAD
#undef D_KWRITE
#undef D_VLOAD
#undef D_VWRITE
#undef D_PEXPORT
#undef D_PIMPORT
#undef D_AEXPORT
#undef D_RESC
#undef D_OSTORE
#undef ROW
#undef VMW
#undef VMWN
#undef SLOAD_H
#undef BLOAD
#undef SWRITE_HK
#undef SWRITE_HV
#undef SWRITE_H
#undef KSWZ
#undef SBAR
}

constexpr size_t MiB = 1u << 20, KiB = 1u << 10;
constexpr size_t WS_CTL = 0, CTL_ZERO_BYTES = 1 * MiB;
constexpr size_t WS_FLOG = 1 * MiB, WS_FBIAS = WS_FLOG + 256 * KiB, WS_ZEROB = WS_FBIAS + 256 * KiB, WS_WRT = WS_ZEROB + 64 * KiB;
constexpr size_t WS_NP = 1920 * KiB;
constexpr size_t WS_TOKINFO = 2 * MiB, WS_LIST = 3 * MiB;
constexpr size_t WS_ROPE = 4 * MiB;
constexpr size_t WS_WPC = 8 * MiB, WS_WOUT = 16 * MiB, WS_WIN = 24 * MiB, WS_WGU = 64 * MiB, WS_WD = 192 * MiB;
constexpr size_t WS_QKV = 256 * MiB, WS_G = 352 * MiB, WS_XB = 416 * MiB, WS_OD = 416 * MiB, WS_ACAT = 448 * MiB;
constexpr size_t WS_MB = 256 * MiB, WS_Z = 288 * MiB, WS_X1B = 352 * MiB, WS_H = 384 * MiB, WS_Y = 408 * MiB, WS_END = 504 * MiB;
constexpr int CW_TMO = 0, CW_BAR = 4096, CW_ATTQ = 8192, CW_ECNT = 12288, CW_QN = 16384, CW_KN = 17408, CW_DQ = 18560;
constexpr int HROWS = 24576;

constexpr int RING_OFF = 0, RING_BYTES = 131072;
constexpr int SM_OFF = 135168;
constexpr int LDSCTL_OFF = 155648, MISC_OFF = LDSCTL_OFF + 320;
constexpr int LDS_BYTES = 163840;
static_assert(att::DATT_LDS_END <= LDSCTL_OFF, "attention LDS map");

#define RLX_AGENT __ATOMIC_RELAXED, __HIP_MEMORY_SCOPE_AGENT
#define LDS_WAIT() asm volatile("s_waitcnt lgkmcnt(0)" ::: "memory")
#define VM_WAIT() asm volatile("s_waitcnt vmcnt(0)" ::: "memory")

#define XB_TMO      128
#define XB_XCNT(j)  (256  + 64 * (j))
#define XB_XSUB(j)  (1280 + 64 * (j))
#define XB_XGEN(j)  (2304 + 64 * (j))
#define XB_TOP      3328
#define XB_TOPGEN   3392
#define XCD_BAR_WORDS 3456
#define XB_SPIN_CAP (1u << 18)
__device__ __forceinline__ unsigned xb_ld(unsigned* p)              { return __hip_atomic_load(p, __ATOMIC_RELAXED, __HIP_MEMORY_SCOPE_AGENT); }
__device__ __forceinline__ unsigned xb_add(unsigned* p, unsigned v) { return __hip_atomic_fetch_add(p, v, __ATOMIC_RELAXED, __HIP_MEMORY_SCOPE_AGENT); }
__device__ __forceinline__ unsigned xb_xcc_id() { return (unsigned)__builtin_amdgcn_s_getreg((3 << 11) | 20) & 0xFu; }
#define XB_SPIN(cond, bar) do { unsigned _sp = 0; while (cond) { __builtin_amdgcn_s_sleep(1); \
    if ((++_sp & 255u) == 0u) { if (xb_ld(&(bar)[XB_TMO])) break; if (_sp > XB_SPIN_CAP) { atomicAdd(&(bar)[XB_TMO], 1u); break; } } } } while (0)
struct XcdBarrier { unsigned* bar; unsigned x; volatile LAS unsigned* st; };
__device__ __forceinline__ XcdBarrier xcd_barrier_post(unsigned* bar, volatile LAS unsigned* st) {
    XcdBarrier b; b.bar = bar; b.x = xb_xcc_id(); b.st = st;
    if (threadIdx.x == 0) (void)xb_add(&bar[XB_XCNT(b.x)], 1u);
    return b;
}
__device__ __forceinline__ void xcd_barrier_complete(unsigned* bar, unsigned x, unsigned& nloc, unsigned& nx) {
    const unsigned G = gridDim.x * gridDim.y * gridDim.z;
    unsigned sum, cnt, mine, sp = 0u;
    for (;;) {
        sum = 0u; cnt = 0u; mine = 0u;
#pragma unroll
        for (unsigned j = 0; j < 16; ++j) { const unsigned c = xb_ld(&bar[XB_XCNT(j)]); sum += c; cnt += (c > 0u) ? 1u : 0u; mine = (j == x) ? c : mine; }
        if (sum == G) break;
        __builtin_amdgcn_s_sleep(1);
        if ((++sp & 255u) == 0u) { if (xb_ld(&bar[XB_TMO])) break; if (sp > XB_SPIN_CAP) { atomicAdd(&bar[XB_TMO], 1u); break; } }
    }
    nloc = mine > 0u ? mine : 1u; nx = cnt > 0u ? cnt : 1u;
}
__device__ __forceinline__ void xcd_barrier(const XcdBarrier& b) {
    asm volatile("s_waitcnt vmcnt(0)" ::: "memory");
    __syncthreads();
    if (threadIdx.x == 0) {
        unsigned* bar = b.bar;
        __builtin_amdgcn_s_waitcnt(0);
        unsigned nloc = b.st[0], nx = b.st[1];
        if (nloc == 0u) { xcd_barrier_complete(bar, b.x, nloc, nx); b.st[0] = nloc; b.st[1] = nx; }
        const unsigned old = xb_add(&bar[XB_XSUB(b.x)], 1u);
        const unsigned gen = old / nloc;
        if (old + 1u == (gen + 1u) * nloc) {
            __builtin_amdgcn_fence(__ATOMIC_RELEASE, "agent");
            asm volatile("s_waitcnt vmcnt(0)" ::: "memory");
            const unsigned og = xb_add(&bar[XB_TOP], 1u);
            const unsigned tg = og / nx;
            if (og + 1u == (tg + 1u) * nx) xb_add(&bar[XB_TOPGEN], 1u);
            else XB_SPIN(xb_ld(&bar[XB_TOPGEN]) == tg, bar);
            __builtin_amdgcn_fence(__ATOMIC_ACQUIRE, "agent");
            xb_add(&bar[XB_XGEN(b.x)], 1u);
            asm volatile("s_waitcnt vmcnt(0)" ::: "memory");
        } else {
            XB_SPIN(xb_ld(&bar[XB_XGEN(b.x)]) == gen, bar);
            __builtin_amdgcn_fence(__ATOMIC_ACQUIRE, "agent");
            asm volatile("s_waitcnt vmcnt(0)" ::: "memory");
        }
    }
    __syncthreads();
}

constexpr int NWAVES = 8, NPHASE = 11;
struct Args { const float* in[22]; float* out; unsigned char* ws; int ph_lo, ph_hi; };
struct Frame {
    LAS unsigned char* lds; volatile LAS unsigned* MISC; unsigned* ctl;
    int tid, lane, wave, vcu, G;
};

template <class RM>
__device__ __forceinline__ void tr_item(const float* W, int N, int k0, int nsrc0, bf16_t* WT, int ldw, int kdst, const RM& rowmap, LAS float* scr, int lane) {
    const int lr = lane >> 4, lc = (lane & 15) * 4;
#pragma unroll 4
    for (int i = 0; i < 16; ++i) { const int kk = 4 * i + lr; const f32x4 v = *(const f32x4*)(W + (size_t)(k0 + kk) * N + nsrc0 + lc);
        scr[kk * 65 + lc] = v[0]; scr[kk * 65 + lc + 1] = v[1]; scr[kk * 65 + lc + 2] = v[2]; scr[kk * 65 + lc + 3] = v[3]; }
    LDS_WAIT(); asm volatile("" ::: "memory");
    const int c = lane & 7;
#pragma unroll
    for (int j = 0; j < 8; ++j) { const int n = (lane >> 3) + 8 * j; const LAS float* s = scr + (8 * c) * 65 + n;
        u32x4 o; o.x = cvt_pk_bf16(s[0 * 65], s[1 * 65]); o.y = cvt_pk_bf16(s[2 * 65], s[3 * 65]); o.z = cvt_pk_bf16(s[4 * 65], s[5 * 65]); o.w = cvt_pk_bf16(s[6 * 65], s[7 * 65]);
        *(u32x4*)(WT + (size_t)rowmap(nsrc0 + n) * ldw + kdst + k0 + 8 * c) = o; }
    LDS_WAIT(); asm volatile("" ::: "memory");
}
struct RmId { __device__ __forceinline__ int operator()(int c) const { return c; } };
struct RmIn { __device__ __forceinline__ int operator()(int c) const {
        if (c < 2048) { const int jj = c & 127, j6 = jj & 63; return (c & ~127) + 8 * (j6 >> 2) + (jj >= 64 ? 4 : 0) + (j6 & 3); }
        return c < 6144 ? c : c - 8; } };
struct RmGate { int up; __device__ __forceinline__ int operator()(int c) const { return 256 * (c >> 7) + 128 * up + (c & 127); } };

__device__ __forceinline__ att::BlockRef mk_ref(int item, int jlo, const bf16_t* QKV, bf16_t* OD, bf16_t* ACAT, const float* FBIAS, const float* ZEROB) {
    att::BlockRef r; const int qb = 31 - item / 24, u = item % 24; int hq, hk, hv;
    if (u < 16) { const int m = u >> 1, c = u & 1; hq = m; hk = 8 + m; hv = 16 + (m >> 1) * 2 + c; r.B = ZEROB; r.O = (att::bf16*)OD + ((size_t)u * S + qb * 256) * 128; r.ostride = 128; }
    else { const int h = u - 16; hq = 24 + h; hk = 32 + h; hv = 40 + h; r.B = FBIAS + (size_t)h * S; r.O = (att::bf16*)ACAT + (size_t)(qb * 256) * DM + 1024 + h * 128; r.ostride = DM; }
    r.Q = (const att::bf16*)QKV + ((size_t)hq * S + qb * 256) * 128; r.K = (const att::bf16*)QKV + ((size_t)hk * S + jlo * 64) * 128; r.V = (const att::bf16*)QKV + ((size_t)hv * S + jlo * 64) * 128; r.B += jlo * 64; r.P0 = qb * 256; r.jlo = jlo; return r;
}
__global__ void __launch_bounds__(NWAVES * 64, 2) mk_fwd(Args args) {
    extern __shared__ __attribute__((aligned(16))) unsigned char lds[];
    Frame F;
    F.lds = (LAS unsigned char*)lds;
    F.MISC = (volatile LAS unsigned*)(F.lds + MISC_OFF);
    F.tid = threadIdx.x; F.lane = F.tid & 63; F.wave = __builtin_amdgcn_readfirstlane(F.tid >> 6);
    F.G = gridDim.x; { const int bx = blockIdx.x; F.vcu = (F.G % 8 == 0) ? (bx % 8) * (F.G / 8) + bx / 8 : bx; }
    unsigned char* ws = args.ws;
    F.ctl = (unsigned*)(ws + WS_CTL);
    const float* x = args.in[0]; const float* w_in = args.in[1]; const float* b_forget = args.in[2];
    const float* lq1 = args.in[3]; const float* lk1 = args.in[4]; const float* lq2 = args.in[5]; const float* lk2 = args.in[6];
    const float* dng = args.in[7]; const float* wpd = args.in[8]; const float* wpf = args.in[9]; const float* wout = args.in[10];
    const float* ln1g = args.in[11]; const float* ln1b = args.in[12]; const float* wrg = args.in[13]; const float* brg = args.in[14];
    const float* wre = args.in[15]; const float* bre = args.in[16]; const float* wgate = args.in[17]; const float* wup = args.in[18];
    const float* wdown = args.in[19]; const float* ln2g = args.in[20]; const float* ln2b = args.in[21];
    float* FLOG = (float*)(ws + WS_FLOG); float* FBIAS = (float*)(ws + WS_FBIAS); float* ZEROB = (float*)(ws + WS_ZEROB); float* WRT = (float*)(ws + WS_WRT);
    float* NPB = (float*)(ws + WS_NP);
    int* TOKINFO = (int*)(ws + WS_TOKINFO); int* LIST = (int*)(ws + WS_LIST); float* ROPE = (float*)(ws + WS_ROPE);
    bf16_t* WPC = (bf16_t*)(ws + WS_WPC); bf16_t* WOUT = (bf16_t*)(ws + WS_WOUT); bf16_t* WIN = (bf16_t*)(ws + WS_WIN); bf16_t* WGU = (bf16_t*)(ws + WS_WGU); bf16_t* WD = (bf16_t*)(ws + WS_WD);
    bf16_t* QKV = (bf16_t*)(ws + WS_QKV); bf16_t* GB = (bf16_t*)(ws + WS_G); bf16_t* XB = (bf16_t*)(ws + WS_XB); bf16_t* OD = (bf16_t*)(ws + WS_OD); bf16_t* ACAT = (bf16_t*)(ws + WS_ACAT);
    bf16_t* MB = (bf16_t*)(ws + WS_MB); float* Z = (float*)(ws + WS_Z); bf16_t* X1B = (bf16_t*)(ws + WS_X1B); bf16_t* HB = (bf16_t*)(ws + WS_H); bf16_t* YB = (bf16_t*)(ws + WS_Y);

    for (int u = F.tid; u < (LDS_BYTES - LDSCTL_OFF) / 4; u += NWAVES * 64) ((LAS unsigned*)(F.lds + LDSCTL_OFF))[u] = 0u;
    __syncthreads();
    XcdBarrier bar; bar.bar = F.ctl + CW_BAR; bar.x = 0; bar.st = nullptr;
    if (MK_N_LAUNCHES == 1) bar = xcd_barrier_post(F.ctl + CW_BAR, F.MISC + 8);
    const int lo = args.ph_lo, hi = args.ph_hi; constexpr int rep = 0;
#define FRESH() do { int t_ = threadIdx.x; asm volatile("" : "+v"(t_)); F.tid = t_; F.lane = t_ & 63; F.wave = __builtin_amdgcn_readfirstlane(t_ >> 6); } while (0)
#define IN(k) ((((PH_MASK) >> (k)) & 1) && lo <= (k) && (k) < hi)
#define SEAM(k) do { if (IN(k) && IN((k) + 1)) xcd_barrier(bar); } while (0)
#define gw (F.vcu * NWAVES + F.wave)
    const int NGW = F.G * NWAVES;
    LAS int* sm_rowidx = (LAS int*)(F.lds + SM_OFF); LAS int* sm_pre = sm_rowidx + 256; LAS int* sm_cnt = sm_pre + 40;

    if (IN(0)) {
        FRESH();
        LAS float* scr = (LAS float*)(F.lds + F.wave * 16640);
        constexpr int I_IN = 32 * 160, I_P = 16 * 32, I_O = 32 * 32, I_E = 32 * 256, NITEMS = I_IN + 2 * I_P + I_O + 2 * I_E;
        for (int it = gw; it < NITEMS; it += NGW) {
            int r = it;
            if (r < I_IN) { const int kb = r / 160, nb = r % 160; tr_item(w_in, INC, 64 * kb, 64 * nb + (nb >= 96 ? 8 : 0), WIN, DM, 0, RmIn{}, scr, F.lane); continue; } r -= I_IN;
            if (r < I_P) { tr_item(wpd, DM, 64 * (r / 32), 64 * (r % 32), WPC, DM, 0, RmId{}, scr, F.lane); continue; } r -= I_P;
            if (r < I_P) { tr_item(wpf, DM, 64 * (r / 32), 64 * (r % 32), WPC, DM, 1024, RmId{}, scr, F.lane); continue; } r -= I_P;
            if (r < I_O) { tr_item(wout, DM, 64 * (r / 32), 64 * (r % 32), WOUT, DM, 0, RmId{}, scr, F.lane); continue; } r -= I_O;
            if (r < I_E) { const int e = r >> 8, q = r & 255; tr_item(wgate + (size_t)e * DM * FF, FF, 64 * (q >> 3), 64 * (q & 7), WGU + (size_t)e * 1024 * DM, DM, 0, RmGate{0}, scr, F.lane); continue; } r -= I_E;
            { const int e = r >> 8, q = r & 255; tr_item(wup + (size_t)e * DM * FF, FF, 64 * (q >> 3), 64 * (q & 7), WGU + (size_t)e * 1024 * DM, DM, 0, RmGate{1}, scr, F.lane); }
        }
        const int gt = F.vcu * (NWAVES * 64) + F.tid, NGT = F.G * NWAVES * 64;
        for (int i = gt; i < S * 64; i += NGT) { const int pos = i >> 6, j = i & 63; const double ang = (double)pos * pow(10000.0, -(double)j / 64.0);
            ROPE[(size_t)pos * 128 + j] = (float)cos(ang); ROPE[(size_t)pos * 128 + 64 + j] = (float)sin(ang); }
        for (int i = gt; i < 36 * DM; i += NGT) { const int c = i / DM, k = i % DM; WRT[i] = c < 4 ? wrg[k * 4 + c] : wre[((size_t)((c - 4) >> 3) * DM + k) * 8 + ((c - 4) & 7)]; }
        for (int i = gt; i < S; i += NGT) ZEROB[i] = 0.f;
        __syncthreads();
        { LAS float* Wf = (LAS float*)F.lds;
          for (int i = F.tid; i < DM * 2; i += NWAVES * 64) { const int k = i >> 1, h4 = (i & 1) * 4; const f32x4 v = *(const f32x4*)(w_in + (size_t)k * INC + 6144 + h4);
              Wf[(h4 + 0) * DM + k] = v[0]; Wf[(h4 + 1) * DM + k] = v[1]; Wf[(h4 + 2) * DM + k] = v[2]; Wf[(h4 + 3) * DM + k] = v[3]; }
          __syncthreads();
          for (int m = gw; m < S; m += NGW) {
              const f32x4* xr = (const f32x4*)(x + (size_t)m * DM) + F.lane; f32x4 v[8];
#pragma unroll
              for (int j = 0; j < 8; ++j) v[j] = xr[64 * j];
              u32x2* o8 = (u32x2*)(XB + (size_t)m * DM) + F.lane;
#pragma unroll
              for (int j = 0; j < 8; ++j) { u32x2 w; w.x = cvt_pk_bf16(v[j][0], v[j][1]); w.y = cvt_pk_bf16(v[j][2], v[j][3]); o8[64 * j] = w; }
              float fl[8];
#pragma unroll
              for (int c = 0; c < 8; ++c) { float a = 0.f;
#pragma unroll
                  for (int j = 0; j < 8; ++j) { const f32x4 w = *(const LAS f32x4*)(Wf + c * DM + 256 * j + 4 * F.lane); a = fmaf(v[j][0], w[0], fmaf(v[j][1], w[1], fmaf(v[j][2], w[2], fmaf(v[j][3], w[3], a)))); }
                  asm volatile("" ::: "memory");
                  fl[c] = wave_sum(a); asm volatile("" : "+v"(fl[c])); }
              if (F.lane == 0) { *(f32x4*)(FLOG + (size_t)m * 8) = (f32x4){fl[0], fl[1], fl[2], fl[3]}; *(f32x4*)(FLOG + (size_t)m * 8 + 4) = (f32x4){fl[4], fl[5], fl[6], fl[7]}; }
          }
          __syncthreads();
        }
    }
    SEAM(0);

    if (IN(1)) {
        FRESH();
        if (F.vcu < 8) {
            const int h = F.vcu; LAS double* part = (LAS double*)F.lds; const double b = (double)b_forget[h];
            double ls[16]; double run = 0.0;
#pragma unroll
            for (int i = 0; i < 16; ++i) { const double z = (double)FLOG[(size_t)(F.tid * 16 + i) * 8 + h] + b; run += (z < 0.0 ? z : 0.0) - log1p(exp(-fabs(z))); ls[i] = run; }
            part[F.tid] = run; __syncthreads();
            if (F.tid == 0) { double a = 0.0; for (int i = 0; i < NWAVES * 64; ++i) { const double t = part[i]; part[i] = a; a += t; } }
            __syncthreads();
            const double off = part[F.tid];
#pragma unroll
            for (int i = 0; i < 16; ++i) FBIAS[(size_t)h * S + F.tid * 16 + i] = (float)(-(off + ls[i]) * (double)INV_SCALE);
            __syncthreads();
        }
        pg8::Gemm g{XB, WIN, DM, DM, DM, nullptr}; pg8::StaticOrder So; So.init(S, NIN, F.G, (int)blockIdx.x);
        pg8::EpiInProj E{QKV, GB, ROPE, NPB};
        pg8::gemm_phase<pg8::EpiInProj, pg8::StaticOrder, false>(F.lds + RING_OFF, g, So, E);
    }
    SEAM(1);

    if (IN(2)) {
        FRESH();
        constexpr int NITEM = 24 * 32;
        { att::DQueue dq{F.ctl + CW_ATTQ + 64 * 8, F.MISC + 22, (const att::bf16*)QKV, (att::bf16*)OD};
          if (F.wave < 4) att::dattn_S((char*)lds, dq); else att::dattn_V((char*)lds, dq);
          VM_WAIT(); __syncthreads();
        }
        #define ref(item, jl) mk_ref((item), (jl), QKV, OD, ACAT, FBIAS, ZEROB)
        int slot = 0;
#define FETCH(dst, dstj) do { if (F.wave == 0) { unsigned v_ = 0; if (F.lane == 0) { const unsigned i_ = __hip_atomic_fetch_add(F.ctl + CW_ATTQ + 64 * rep, 1u, RLX_AGENT); v_ = i_ < 256u ? (i_ >> 3) * 24u + 16u + (i_ & 7u) : (unsigned)NITEM; } const int it_ = (int)__builtin_amdgcn_readfirstlane(v_); int jl_ = 0; \
        if (it_ < NITEM && (it_ % 24) >= 16) { const int h_ = it_ % 24 - 16, qb_ = 31 - it_ / 24, nt_ = 4 * qb_ + 4; const float* Bh_ = FBIAS + (size_t)h_ * S; \
            float qn_ = 0.f, kd_ = 0.f; \
            for (int d_ = 0; d_ < 4; ++d_) { const f32x4 a_ = *(const f32x4*)(NPB + ((size_t)h_ * 128 + 4 * qb_ + d_) * 4), b_ = *(const f32x4*)(NPB + ((size_t)(8 + h_) * 128 + 4 * qb_ + d_) * 4); \
                qn_ = fmaxf(qn_, (a_[0] + a_[1]) + (a_[2] + a_[3])); kd_ = fmaxf(kd_, (b_[0] + b_[1]) + (b_[2] + b_[3])); } \
            qn_ = sqrtf(qn_) * 1.005f; kd_ = sqrtf(kd_) * 1.005f; \
            const float lowm_ = -qn_ * kd_ * 1.0001f + Bh_[qb_ * 256]; int first_ = nt_; \
            for (int c_ = 0; c_ < 2; ++c_) { const int t_ = c_ * 64 + F.lane; bool keep_ = true; \
                if (t_ < nt_) { const f32x4 b_ = *(const f32x4*)(NPB + ((size_t)(8 + h_) * 128 + t_) * 4); const float kn_ = sqrtf((b_[0] + b_[1]) + (b_[2] + b_[3])) * 1.005f; keep_ = !(qn_ * kn_ * 1.0001f + Bh_[64 * t_ + 63] - lowm_ < -FOX_THR_RAW); } else keep_ = (t_ == nt_); \
                const unsigned long long bm_ = __ballot(keep_ && t_ <= nt_); if (bm_ && first_ == nt_) first_ = c_ * 64 + (int)__builtin_ctzll(bm_); } \
            jl_ = first_ & ~1; if (jl_ > nt_ - 4) jl_ = nt_ - 4; if (jl_ < 0) jl_ = 0; } \
        if (F.lane == 0) { F.MISC[16 + slot] = (unsigned)it_; F.MISC[18 + slot] = (unsigned)jl_; } } \
        __syncthreads(); dst = __builtin_amdgcn_readfirstlane((int)F.MISC[16 + slot]); dstj = __builtin_amdgcn_readfirstlane((int)F.MISC[18 + slot]); slot ^= 1; } while (0)
        int item, jl; FETCH(item, jl);
        if (item < NITEM) {
            att::BlockRef cur = ref(item, jl); att::Seam Sm;
            att::attn_prime(cur, (char*)lds, F.lds, Sm);
            for (;;) {
                int nitem, njl; FETCH(nitem, njl);
                const bool more = nitem < NITEM;
                const att::BlockRef nxt = more ? ref(nitem, njl) : cur;
                att::attn_block(cur, nxt, (char*)lds, F.lds, Sm);
                if (!more) break;
                cur = nxt;
            }
        }
        VM_WAIT(); __syncthreads();
#undef FETCH
#undef ref
    }
    SEAM(2);

    if (IN(3)) {
        FRESH();
        float a = lq1[F.lane] * lk1[F.lane] + lq1[F.lane + 64] * lk1[F.lane + 64], b = lq2[F.lane] * lk2[F.lane] + lq2[F.lane + 64] * lk2[F.lane + 64];
        const float lam = __expf(wave_sum(a)) - __expf(wave_sum(b)) + LAM_INIT;
        const int c = F.lane >> 5, dd = (F.lane & 31) * 4;
        for (int p = gw; p < S * 4; p += NGW) { const int s = p >> 2, h = p & 3;
            const u32x2 w1 = *(const u32x2*)(OD + ((size_t)(4 * h + c) * S + s) * 128 + dd), w2 = *(const u32x2*)(OD + ((size_t)(4 * h + 2 + c) * S + s) * 128 + dd);
            const f32x4 o1 = {bf_lo(w1.x), bf_hi(w1.x), bf_lo(w1.y), bf_hi(w1.y)}, o2 = {bf_lo(w2.x), bf_hi(w2.x), bf_lo(w2.y), bf_hi(w2.y)};
            const f32x4 v = o1 - o2 * lam;
            const float ss = wave_sum(v[0] * v[0] + v[1] * v[1] + v[2] * v[2] + v[3] * v[3]);
            const float r = rsqrtf(ss * (1.f / 256.f) + LN_EPS) * (1.f - LAM_INIT);
            const f32x4 gg = *(const f32x4*)(dng + h * 256 + 4 * F.lane);
            u32x2 w; w.x = cvt_pk_bf16(v[0] * r * gg[0], v[1] * r * gg[1]); w.y = cvt_pk_bf16(v[2] * r * gg[2], v[3] * r * gg[3]);
            *(u32x2*)(ACAT + (size_t)s * DM + h * 256 + 4 * F.lane) = w; }
    }
    SEAM(3);

    if (IN(4)) {
        pg8::Gemm g{ACAT, WPC, DM, DM, DM, nullptr}; pg8::StaticOrder So; So.init(S, DM, F.G, (int)blockIdx.x);
        pg8::EpiGateHook E{GB, MB};
        pg8::gemm_phase<pg8::EpiGateHook, pg8::StaticOrder, false, true>(F.lds + RING_OFF, g, So, E);
    }
    if (IN(4) && IN(6)) xcd_barrier(bar);

    if (IN(6)) {
        pg8::Gemm g{MB, WOUT, DM, DM, DM, nullptr};
        pg8::StaticOrder So; So.init(S, DM, F.G, (int)blockIdx.x);
        pg8::EpiZ E{X1B};
        pg8::gemm_phase<pg8::EpiZ, pg8::StaticOrder, false>(F.lds + RING_OFF, g, So, E);
    }
    SEAM(6);

    if (IN(7)) {
        FRESH();
        unsigned* ecnt = F.ctl + CW_ECNT + rep * 2048; int* LISTr = rep ? (int*)(ws + WS_H) : LIST; int* TOKr = rep ? (int*)(ws + WS_H + 2 * MiB) : TOKINFO; float* Zw = rep ? (float*)(ws + WS_Y) : Z; bf16_t* X1Bw = rep ? (bf16_t*)(ws + WS_Y + 64 * MiB) : X1B;
        LAS float* Wl = (LAS float*)F.lds;
        LAS float* Lw = (LAS float*)(F.lds + 81920) + F.wave * 128;
#pragma unroll 1
        for (int pr = 0; pr < 2; ++pr) {
            const int rowA = gw * 4 + 2 * pr;
            f32x4 xa[8], xb[8];
            {
                const f32x4* za = (const f32x4*)(x + (size_t)rowA * DM) + F.lane; const f32x4* zb = za + DM / 4;
                const u32x2* ya = (const u32x2*)(X1B + (size_t)rowA * DM) + F.lane; const u32x2* yb = ya + DM / 4;
                float sa = 0.f, sb = 0.f;
#pragma unroll
                for (int j = 0; j < 8; ++j) { const u32x2 wa_ = ya[64 * j], wb_ = yb[64 * j];
                    xa[j] = za[64 * j] * ALPHA + (f32x4){bf_lo(wa_.x), bf_hi(wa_.x), bf_lo(wa_.y), bf_hi(wa_.y)}; xb[j] = zb[64 * j] * ALPHA + (f32x4){bf_lo(wb_.x), bf_hi(wb_.x), bf_lo(wb_.y), bf_hi(wb_.y)}; sa += (xa[j][0] + xa[j][1]) + (xa[j][2] + xa[j][3]); sb += (xb[j][0] + xb[j][1]) + (xb[j][2] + xb[j][3]); }
                const float ma = wave_sum(sa) * (1.f / DM), mb = wave_sum(sb) * (1.f / DM); float qa = 0.f, qb = 0.f;
#pragma unroll
                for (int j = 0; j < 8; ++j) { xa[j] = xa[j] - ma; xb[j] = xb[j] - mb; qa += (xa[j][0] * xa[j][0] + xa[j][1] * xa[j][1]) + (xa[j][2] * xa[j][2] + xa[j][3] * xa[j][3]);
                    qb += (xb[j][0] * xb[j][0] + xb[j][1] * xb[j][1]) + (xb[j][2] * xb[j][2] + xb[j][3] * xb[j][3]); }
                const float ra = rsqrtf(wave_sum(qa) * (1.f / DM) + LN_EPS), rb = rsqrtf(wave_sum(qb) * (1.f / DM) + LN_EPS);
                f32x4* oa = (f32x4*)(Zw + (size_t)rowA * DM) + F.lane; f32x4* ob = oa + DM / 4;
                u32x2* ha = (u32x2*)(X1Bw + (size_t)rowA * DM) + F.lane; u32x2* hb = ha + DM / 4;
#pragma unroll
                for (int j = 0; j < 8; ++j) { const f32x4 gg = *((const f32x4*)ln1g + F.lane + 64 * j), bb = *((const f32x4*)ln1b + F.lane + 64 * j);
                    xa[j] = xa[j] * ra * gg + bb; xb[j] = xb[j] * rb * gg + bb; oa[64 * j] = xa[j]; ob[64 * j] = xb[j];
                    u32x2 w; w.x = cvt_pk_bf16(xa[j][0], xa[j][1]); w.y = cvt_pk_bf16(xa[j][2], xa[j][3]); ha[64 * j] = w;
                    w.x = cvt_pk_bf16(xb[j][0], xb[j][1]); w.y = cvt_pk_bf16(xb[j][2], xb[j][3]); hb[64 * j] = w; }
            }
            float la[36], lb[36];
#pragma unroll
            for (int c = 0; c < 36; ++c) { la[c] = 0.f; lb[c] = 0.f; }
#define P7_STAGE(j, b) do { unsigned lo_ = (unsigned)F.lane * 16u; asm volatile("" : "+v"(lo_)); _Pragma("unroll") for (int n_ = 0; n_ < 5; ++n_) { const int c_ = F.wave + 8 * n_; if (c_ < 36) { \
        const char* ub_ = (const char*)(WRT + (size_t)c_ * DM + 256 * (j)); __builtin_amdgcn_global_load_lds((const unsigned*)(ub_ + lo_), (LAS unsigned*)(Wl + (b) * 9216 + c_ * 256), 16, 0, 0); } } } while (0)
#define P7_COMMIT(b) do { VM_WAIT(); } while (0)
            __syncthreads();
            P7_STAGE(0, 0); P7_COMMIT(0); __syncthreads();
#pragma unroll
            for (int j = 0; j < 8; ++j) {
                if (j + 1 < 8) P7_STAGE(j + 1, (j + 1) & 1);
                const LAS float* Wb = Wl + (j & 1) * 9216;
#pragma unroll
                for (int cg = 0; cg < 9; ++cg) { f32x4 w[4];
#pragma unroll
                    for (int q = 0; q < 4; ++q) w[q] = *(const LAS f32x4*)(Wb + (4 * cg + q) * 256 + 4 * F.lane);
                    asm volatile("" ::: "memory");
#pragma unroll
                    for (int q = 0; q < 4; ++q) { const int c = 4 * cg + q;
                        la[c] = fmaf(xa[j][0], w[q][0], fmaf(xa[j][1], w[q][1], fmaf(xa[j][2], w[q][2], fmaf(xa[j][3], w[q][3], la[c]))));
                        lb[c] = fmaf(xb[j][0], w[q][0], fmaf(xb[j][1], w[q][1], fmaf(xb[j][2], w[q][2], fmaf(xb[j][3], w[q][3], lb[c]))));
                        asm volatile("" : "+v"(la[c]), "+v"(lb[c])); }
                    asm volatile("" ::: "memory"); __builtin_amdgcn_sched_barrier(0); }
                if (j + 1 < 8) { P7_COMMIT((j + 1) & 1); __syncthreads(); }
                __builtin_amdgcn_sched_barrier(0);
            }
#undef P7_STAGE
#undef P7_COMMIT
#pragma unroll
            for (int c = 0; c < 36; ++c) { la[c] = wave_sum(la[c]); lb[c] = wave_sum(lb[c]); asm volatile("" : "+v"(la[c]), "+v"(lb[c])); }
            if (F.lane == 0) {
#pragma unroll
                for (int c = 0; c < 36; ++c) { Lw[c] = la[c]; Lw[64 + c] = lb[c]; } }
            LDS_WAIT(); asm volatile("" ::: "memory");
            if (F.lane < 2) {
                const LAS float* L = Lw + 64 * F.lane; const int tok = rowA + F.lane;
                int g = 0; float gm = L[0] + brg[0];
                for (int c = 1; c < 4; ++c) { const float v = L[c] + brg[c]; if (v > gm) { gm = v; g = c; } }
                float den = 0.f;
                for (int c = 0; c < 4; ++c) den += expf(L[c] + brg[c] - gm);
                const float top_gp = 1.f / den;
                int e1 = 0; float l1 = L[4 + g * 8] + bre[g * 8];
                for (int e = 1; e < 8; ++e) { const float v = L[4 + g * 8 + e] + bre[g * 8 + e]; if (v > l1) { l1 = v; e1 = e; } }
                int e2 = 0; float l2 = -INFINITY;
                for (int e = 0; e < 8; ++e) { const float v = L[4 + g * 8 + e] + bre[g * 8 + e]; if (e != e1 && v > l2) { l2 = v; e2 = e; } }
                const float w1 = 1.f / (1.f + expf(l2 - l1));
                const int ea = g * 8 + e1, eb = g * 8 + e2;
                const int pa = (int)__hip_atomic_fetch_add(ecnt + 64 * ea, 1u, RLX_AGENT), pb = (int)__hip_atomic_fetch_add(ecnt + 64 * eb, 1u, RLX_AGENT);
                LISTr[(size_t)ea * S + pa] = tok; LISTr[(size_t)eb * S + pb] = tok;
                int* ti = TOKr + (size_t)tok * 8; ti[0] = ea; ti[1] = pa; ti[2] = __float_as_int(top_gp * w1); ti[3] = eb; ti[4] = pb; ti[5] = __float_as_int(top_gp * (1.f - w1));
            }
            asm volatile("" ::: "memory");
        }
    }
    SEAM(7);

    if (IN(8) || IN(9) || IN(10)) {
        FRESH();
        if (F.tid < 32) { const int c = (int)__hip_atomic_load(F.ctl + CW_ECNT + 64 * F.tid, RLX_AGENT); sm_cnt[F.tid] = c; }
        __syncthreads();
        if (F.tid == 0) { int a = 0; for (int e = 0; e < NEXP; ++e) { sm_pre[e] = a; a += (sm_cnt[e] + 255) >> 8; } sm_pre[32] = a; }
        __syncthreads();
    }
    if (IN(8)) {
        FRESH();
        const int nunits = sm_pre[32] * 4;
        for (int u = F.vcu; u < nunits; u += F.G) {
            const int mtile = u >> 2, nt4 = u & 3; int e = 0;
            for (int q = 1; q < NEXP; ++q) if (sm_pre[q] <= mtile) e = q;
            const int mt = mtile - sm_pre[e], cnt = sm_cnt[e];
            if (F.tid < 256) { int r = mt * 256 + F.tid; r = r < cnt ? r : cnt - 1; sm_rowidx[F.tid] = LIST[(size_t)e * S + r]; }
            __syncthreads();
            pg8::Gemm g{X1B, WGU + (size_t)e * 1024 * DM, DM, DM, DM, sm_rowidx}; pg8::SingleUnit Su{{mtile, nt4}};
            pg8::EpiSwiGLU E{HB};
            pg8::gemm_phase<pg8::EpiSwiGLU, pg8::SingleUnit, true>(F.lds + RING_OFF, g, Su, E);
        }
        if (rep == 0) { LAS float* scr = (LAS float*)(F.lds + F.wave * 16640); int sl = 0;
            for (;;) { if (F.tid == 0) F.MISC[20 + sl] = __hip_atomic_fetch_add(F.ctl + CW_DQ, 1u, RLX_AGENT); __syncthreads(); const int batch = (int)F.MISC[20 + sl]; sl ^= 1;
                if (batch >= 1024) break;
                const int r = batch * 8 + F.wave, e = r >> 8, q = r & 255;
                tr_item(wdown + (size_t)e * FF * DM, DM, 64 * (q >> 5), 64 * (q & 31), WD + (size_t)e * DM * FF, FF, 0, RmId{}, scr, F.lane); }
            __syncthreads(); }
    }
    SEAM(8);
    if (IN(9)) {
        FRESH();
        const int nunits = sm_pre[32] * 8;
        for (int u = F.vcu; u < nunits; u += F.G) {
            const int mtile = u >> 3; int e = 0;
            for (int q = 1; q < NEXP; ++q) if (sm_pre[q] <= mtile) e = q;
            pg8::Gemm g{HB, WD, FF, FF, FF, nullptr}; pg8::SingleUnit Su{{mtile, e * 8 + (u & 7)}}; pg8::EpiY E{YB};
            pg8::gemm_phase<pg8::EpiY, pg8::SingleUnit, false>(F.lds + RING_OFF, g, Su, E);
        }
    }
    SEAM(9);
    if (IN(10)) {
        FRESH();
        float* out = args.out;
        for (int m = gw; m < S; m += NGW) {
            const int* ti = TOKINFO + (size_t)m * 8;
            const int ea = ti[0], pa = ti[1], eb = ti[3], pb = ti[4]; float wa = __int_as_float(ti[2]), wb = __int_as_float(ti[5]);
            const size_t ra = (size_t)sm_pre[ea] * 256 + pa, rb = (size_t)sm_pre[eb] * 256 + pb;
            const f32x4* xr = (const f32x4*)(Z + (size_t)m * DM) + F.lane; const u32x2* ya = (const u32x2*)(YB + ra * DM) + F.lane; const u32x2* yb = (const u32x2*)(YB + rb * DM) + F.lane;
            f32x4 v[8]; float s = 0.f;
#pragma unroll
            for (int j = 0; j < 8; ++j) { const f32x4 xv = xr[64 * j]; const u32x2 a = ya[64 * j], b = yb[64 * j];
                const f32x4 fa = {bf_lo(a.x), bf_hi(a.x), bf_lo(a.y), bf_hi(a.y)}, fb = {bf_lo(b.x), bf_hi(b.x), bf_lo(b.y), bf_hi(b.y)};
                v[j] = xv * ALPHA + fa * wa + fb * wb; s += (v[j][0] + v[j][1]) + (v[j][2] + v[j][3]); }
            const float mean = wave_sum(s) * (1.f / DM); float q = 0.f;
#pragma unroll
            for (int j = 0; j < 8; ++j) { v[j] = v[j] - mean; q += (v[j][0] * v[j][0] + v[j][1] * v[j][1]) + (v[j][2] * v[j][2] + v[j][3] * v[j][3]); }
            const float rstd = rsqrtf(wave_sum(q) * (1.f / DM) + LN_EPS);
            f32x4* o = (f32x4*)(out + (size_t)m * DM) + F.lane;
#pragma unroll
            for (int j = 0; j < 8; ++j) { const f32x4 gg = *((const f32x4*)ln2g + F.lane + 64 * j), bb = *((const f32x4*)ln2b + F.lane + 64 * j); o[64 * j] = v[j] * rstd * gg + bb; }
        }
    }
#undef IN
#undef SEAM
#undef gw
#undef FRESH
}

extern "C" void kernel_launch(void* const* d_in, const int* in_sizes, int n_in, void* d_out, int out_size, void* d_ws, size_t ws_size, hipStream_t stream) {
    static int grid = 0;
    if (grid == 0) {
        if (n_in != 22 || in_sizes[0] != S * DM || in_sizes[1] != DM * INC || out_size != S * DM || ws_size < WS_END) {
            fprintf(stderr, "kernel_launch: unexpected shapes (n_in %d, in0 %d, out %d, ws %zu); nothing launched\n", n_in, n_in > 0 ? in_sizes[0] : -1, out_size, ws_size); grid = -1; return; }
        int dev = 0, cus = 0, per_cu = 0;
        if (hipGetDevice(&dev) != hipSuccess || hipDeviceGetAttribute(&cus, hipDeviceAttributeMultiprocessorCount, dev) != hipSuccess) { fprintf(stderr, "kernel_launch: device query failed\n"); grid = -1; return; }
        if (hipFuncSetAttribute((const void*)mk_fwd, hipFuncAttributeMaxDynamicSharedMemorySize, LDS_BYTES) != hipSuccess) { fprintf(stderr, "kernel_launch: hipFuncSetAttribute failed\n"); grid = -1; return; }
        if (hipOccupancyMaxActiveBlocksPerMultiprocessor(&per_cu, (const void*)mk_fwd, NWAVES * 64, LDS_BYTES) != hipSuccess || per_cu < 1) fprintf(stderr, "kernel_launch: occupancy query reports %d\n", per_cu);
        (void)hipGetLastError();
        grid = cus;
        if (grid != 256) fprintf(stderr, "kernel_launch: %d CUs; this build assumes 256\n", grid);
    }
    if (grid < 0) return;
    (void)hipMemsetAsync((char*)d_ws + WS_CTL, 0, CTL_ZERO_BYTES, stream);
    Args a{};
    for (int i = 0; i < 22; ++i) a.in[i] = (const float*)d_in[i];
    a.out = (float*)d_out; a.ws = (unsigned char*)d_ws;
    if (MK_N_LAUNCHES == 1) { a.ph_lo = 0; a.ph_hi = NPHASE; hipLaunchKernelGGL(mk_fwd, dim3(grid), dim3(NWAVES * 64), LDS_BYTES, stream, a); }
    else { for (int p = 0; p < NPHASE; ++p) { a.ph_lo = p; a.ph_hi = p + 1; hipLaunchKernelGGL(mk_fwd, dim3(grid), dim3(NWAVES * 64), LDS_BYTES, stream, a); } }
}
```

```cpp
#include <hip/hip_runtime.h>
#ifndef PROBE_SEL
#define PROBE_SEL -1
#endif
#ifndef PROBE_AMP
#define PROBE_AMP 1
#endif
#include <hip/hip_bf16.h>
#include <cstdio>
#include <cstdint>
#include <cmath>

#ifndef PH_MASK
#define PH_MASK 0x7ff
#endif
#ifndef MK_N_LAUNCHES
#define MK_N_LAUNCHES 1
#endif

constexpr int S = 8192, DM = 2048, INC = 10248, NIN = 10240, NEXP = 32, FF = 512;
constexpr size_t QUS = (size_t)S * 128 + 40960;
constexpr float ALPHA = 1.189207115002721f;
constexpr float LN_EPS = 1e-5f;
constexpr float LAM_INIT = 0.2f;
constexpr float INV_SCALE = 11.313708498984761f;
constexpr float FOX_THR_RAW = 36.f * 11.313708498984761f;

#define LAS __attribute__((address_space(3)))
#define GAS __attribute__((address_space(1)))
typedef unsigned short bf16_t;
typedef short bf16x8 __attribute__((ext_vector_type(8)));
typedef short s16x4 __attribute__((ext_vector_type(4)));
typedef float f32x4 __attribute__((ext_vector_type(4)));
typedef float f32x2 __attribute__((ext_vector_type(2)));
typedef float f32x16 __attribute__((ext_vector_type(16)));
typedef unsigned u32x4 __attribute__((ext_vector_type(4)));
typedef unsigned u32x2 __attribute__((ext_vector_type(2)));
typedef GAS unsigned gu32;

typedef __bf16 bf16x2_t __attribute__((ext_vector_type(2)));
__device__ __forceinline__ unsigned cvt_pk_bf16(float lo, float hi) { f32x2 v = {lo, hi}; bf16x2_t b = __builtin_convertvector(v, bf16x2_t); return __builtin_bit_cast(unsigned, b); }
__device__ __forceinline__ float bf_lo(unsigned w) { return __uint_as_float(w << 16); }
__device__ __forceinline__ float bf_hi(unsigned w) { return __uint_as_float(w & 0xffff0000u); }
__device__ __forceinline__ float wave_sum(float v) {
#pragma unroll
    for (int o = 1; o < 64; o <<= 1) v += __shfl_xor(v, o);
    return v;
}

namespace pg8 {
constexpr int BM = 256, BK = 64, HALF = 128, HTB = HALF * BK * 2, STAGE_BYTES = 8 * HTB, NXCD = 8, WGM = 8;
__host__ __device__ __forceinline__ int lds_byte(int r, int c) { const int st = (r >> 4) * 2 + (c >> 5), rr = r & 15, cc = c & 31, ob = rr * 64 + cc * 2; return st * 1024 + (ob ^ (((ob >> 9) & 1) << 5)); }
__host__ __device__ __forceinline__ void stage_rc(int b, int& R, int& C) { const int st = b / 1024, sb = b % 1024, swz = sb ^ (((sb >> 9) & 1) << 5); R = (st >> 1) * 16 + swz / 64; C = (st & 1) * 32 + (swz % 64) / 2; }
__host__ __device__ __forceinline__ int perm32(int rho) { const int n = rho >> 4, i = rho & 15; return 8 * (i >> 2) + 4 * n + (i & 3); }

struct Unit { int pm, pn; };
struct Gemm { const bf16_t* A; const bf16_t* Bt; int K, lda, ldb; const LAS int* rowidx; };

struct StaticOrder {
    int nM, nN, nwg, G, c;
    __device__ void init(int M, int N, int G_, int c_) { nM = M / BM; nN = N / BM; nwg = nM * nN; G = G_; c = c_; }
    __device__ bool next(int i, Unit& u) const {
        const long L = (long)i * G + c; if (L >= nwg) return false;
        int wgid = (int)L; { const int q = nwg / NXCD, r = nwg % NXCD, xcd = wgid % NXCD, off = wgid / NXCD; wgid = (xcd < r ? xcd * (q + 1) : r * (q + 1) + (xcd - r) * q) + off; }
        const int nig = WGM * nN, gid = wgid / nig, fm = gid * WGM, gsz = (nM - fm) < WGM ? (nM - fm) : WGM;
        u.pm = fm + ((wgid % nig) % gsz); u.pn = (wgid % nig) / gsz; return true;
    }
};
struct SingleUnit { Unit u; __device__ bool next(int i, Unit& o) const { if (i) return false; o = u; return true; } };
struct UnitRun { Unit u; int n; __device__ bool next(int i, Unit& o) const { if (i >= n) return false; o.pm = u.pm; o.pn = u.pn + i; return true; } };

typedef f32x4 Acc[2][2][4][2];

template <class Epi, class Sched, bool GATHER, bool HOOK = false>
__device__ __forceinline__ void gemm_phase(LAS unsigned char* lds, const Gemm g, const Sched& S, const Epi& E) {
    int tid = threadIdx.x; asm volatile("" : "+v"(tid));
    const int wid = __builtin_amdgcn_readfirstlane(tid >> 6), lane = tid & 63, wr = wid >> 2, wc = wid & 3, fr = lane & 15, fq = lane >> 4;
    const int K = g.K, nt = K / BK;
    unsigned voffA[2], voffA1[2], voffB[2];
#pragma unroll
    for (int i = 0; i < 2; ++i) { int R, C; stage_rc(tid * 16 + i * 8192, R, C); const int Rb = (R & ~31) + perm32(R & 31);
        if constexpr (GATHER) { voffA[i] = (unsigned)(g.rowidx[R] * g.lda + C) * 2u; voffA1[i] = (unsigned)(g.rowidx[HALF + R] * g.lda + C) * 2u; }
        else { voffA[i] = (unsigned)(R * g.lda + C) * 2u; voffA1[i] = 0u; }
        voffB[i] = (unsigned)(Rb * g.ldb + C) * 2u; }
    const size_t kstep = (size_t)(BK * 2);
    const size_t hstepA = GATHER ? 0 : (size_t)HALF * g.lda * 2, hstepB = (size_t)HALF * g.ldb * 2;
    const size_t tstepA = GATHER ? 0 : 2 * hstepA, tstepB = 2 * hstepB;
    const unsigned ldsw = (unsigned)wid * 1024u;
    const int aoff = lds_byte(wr * 64 + fr, fq * 8), boff = lds_byte(wc * 32 + fr, fq * 8);
#define PG8_SA(b, h) (((b) * 2 + (h)) * HTB)
#define PG8_SB(b, h) ((4 + (b) * 2 + (h)) * HTB)
#define PG8_STAGE(bufoff, gbase, voff) do { _Pragma("unroll") for (int _i = 0; _i < 2; ++_i) \
        __builtin_amdgcn_global_load_lds((const unsigned*)((const char*)(gbase) + (voff)[_i]), (LAS unsigned*)(lds + (bufoff) + ldsw + _i * 8192), 16, 0, 0); } while (0)
#define PG8_STAGE_A0(bufoff, gbase) PG8_STAGE(bufoff, gbase, voffA)
#define PG8_STAGE_A1(bufoff, gbase) do { if constexpr (GATHER) { PG8_STAGE(bufoff, gbase, voffA1); } else { PG8_STAGE(bufoff, (gbase) + hstepA, voffA); } } while (0)
#define PG8_LDA(dst, b, h) do { _Pragma("unroll") for (int m = 0; m < 4; ++m) _Pragma("unroll") for (int k = 0; k < 2; ++k) dst[m][k] = *(const LAS bf16x8*)(lds + PG8_SA(b, h) + aoff + m * 2048 + k * 1024); } while (0)
#define PG8_LDB(dst, b, h) do { _Pragma("unroll") for (int n = 0; n < 2; ++n) _Pragma("unroll") for (int k = 0; k < 2; ++k) dst[n][k] = *(const LAS bf16x8*)(lds + PG8_SB(b, h) + boff + n * 2048 + k * 1024); } while (0)
#define PG8_MMA(ai, bj, At, Bt) do { __builtin_amdgcn_s_setprio(1); _Pragma("unroll") for (int m = 0; m < 4; ++m) _Pragma("unroll") for (int n = 0; n < 2; ++n) _Pragma("unroll") for (int k = 0; k < 2; ++k) \
        acc[ai][bj][m][n] = __builtin_amdgcn_mfma_f32_16x16x32_bf16(Bt[n][k], At[m][k], acc[ai][bj][m][n], 0, 0, 0); __builtin_amdgcn_s_setprio(0); } while (0)
#define PG8_WAIT_V(n) asm volatile("s_waitcnt vmcnt(" #n ")" ::: "memory")
#define PG8_WAIT_L(n) asm volatile("s_waitcnt lgkmcnt(" #n ")" ::: "memory")
#define PG8_BAR __builtin_amdgcn_s_barrier()
#define PG8_SCHED __builtin_amdgcn_sched_barrier(0)
    Unit cur, nxt; int ui = 0;
    if (!S.next(0, cur)) return;
    Acc acc;
#pragma unroll
    for (int a = 0; a < 2; ++a)
#pragma unroll
        for (int b = 0; b < 2; ++b)
#pragma unroll
            for (int m = 0; m < 4; ++m)
#pragma unroll
                for (int n = 0; n < 2; ++n) acc[a][b][m][n] = (f32x4){0.f, 0.f, 0.f, 0.f};
    bf16x8 At[4][2], B0[2][2], B1[2][2];
    const char* cA = (const char*)g.A + (size_t)cur.pm * tstepA; const char* cB = (const char*)g.Bt + (size_t)cur.pn * tstepB;
    PG8_STAGE(PG8_SB(0, 0), cB, voffB); PG8_STAGE(PG8_SB(0, 1), cB + hstepB, voffB); PG8_STAGE_A0(PG8_SA(0, 0), cA); PG8_STAGE_A1(PG8_SA(0, 1), cA);
    if (wr == 1) PG8_BAR;
    PG8_WAIT_V(2); PG8_BAR;
    PG8_STAGE(PG8_SB(1, 0), cB + kstep, voffB); PG8_STAGE_A0(PG8_SA(1, 0), cA + kstep); PG8_STAGE(PG8_SB(1, 1), cB + hstepB + kstep, voffB);
    PG8_WAIT_V(6); PG8_BAR;
    for (;;) {
        const bool has_next = S.next(ui + 1, nxt);
        const char* nA = has_next ? (const char*)g.A + (size_t)nxt.pm * tstepA : cA; const char* nB = has_next ? (const char*)g.Bt + (size_t)nxt.pn * tstepB : cB;
        for (int t = 0; t < nt; t += 2) {
            if constexpr (HOOK) { if (t == nt / 2) { E.hook(acc, cur, wr, wc, fr, fq); PG8_SCHED; } }
            const bool last = (t == nt - 2);
            const char* a1 = cA + (size_t)(t + 1) * kstep;
            const char* a2 = last ? nA : cA + (size_t)(t + 2) * kstep; const char* b2 = last ? nB : cB + (size_t)(t + 2) * kstep;
            const char* a3 = a2 + kstep; const char* b3 = b2 + kstep;
            PG8_LDB(B0, 0, 0); PG8_LDB(B1, 0, 1); PG8_SCHED; PG8_LDA(At, 0, 0); PG8_STAGE_A1(PG8_SA(1, 1), a1);
            PG8_WAIT_V(8); PG8_WAIT_L(0); PG8_BAR; PG8_MMA(0, 0, At, B0); PG8_MMA(0, 1, At, B1); PG8_BAR; PG8_SCHED;
            PG8_LDA(At, 0, 1); PG8_STAGE(PG8_SB(0, 0), b2, voffB); PG8_STAGE(PG8_SB(0, 1), b2 + hstepB, voffB); PG8_STAGE_A0(PG8_SA(0, 0), a2);
            PG8_WAIT_V(8); PG8_WAIT_L(0); PG8_BAR; PG8_MMA(1, 0, At, B0); PG8_MMA(1, 1, At, B1); PG8_BAR; PG8_SCHED;
            PG8_LDB(B0, 1, 0); PG8_LDB(B1, 1, 1); PG8_SCHED; PG8_LDA(At, 1, 0); PG8_STAGE_A1(PG8_SA(0, 1), a2);
            PG8_WAIT_V(8); PG8_WAIT_L(0); PG8_BAR; PG8_MMA(0, 0, At, B0); PG8_MMA(0, 1, At, B1); PG8_BAR; PG8_SCHED;
            PG8_LDA(At, 1, 1); PG8_STAGE(PG8_SB(1, 0), b3, voffB); PG8_STAGE(PG8_SB(1, 1), b3 + hstepB, voffB); PG8_STAGE_A0(PG8_SA(1, 0), a3);
            PG8_WAIT_V(8); PG8_WAIT_L(0); PG8_BAR; PG8_MMA(1, 0, At, B0); PG8_MMA(1, 1, At, B1); PG8_BAR; PG8_SCHED;
        }
        if (wr == 0) PG8_BAR;
        E(acc, cur, wr, wc, fr, fq);
        if (!has_next) break;
#pragma unroll
        for (int a = 0; a < 2; ++a)
#pragma unroll
            for (int b = 0; b < 2; ++b)
#pragma unroll
                for (int m = 0; m < 4; ++m)
#pragma unroll
                    for (int n = 0; n < 2; ++n) acc[a][b][m][n] = (f32x4){0.f, 0.f, 0.f, 0.f};
        cur = nxt; cA = nA; cB = nB; ++ui;
        if (wr == 1) PG8_BAR;
    }
    PG8_WAIT_V(0);
    PG8_BAR;
#undef PG8_SA
#undef PG8_SB
#undef PG8_STAGE
#undef PG8_STAGE_A0
#undef PG8_STAGE_A1
#undef PG8_LDA
#undef PG8_LDB
#undef PG8_MMA
#undef PG8_WAIT_V
#undef PG8_WAIT_L
#undef PG8_BAR
#undef PG8_SCHED
}

__device__ __forceinline__ void store16_wt(void* p, u32x4 v) { asm volatile("global_store_dwordx4 %0, %1, off sc1\n\ts_nop 1" :: "v"(p), "v"(v) : "memory"); }
__device__ __forceinline__ u32x4 pack8(f32x4 a, f32x4 b) { u32x4 w; w.x = cvt_pk_bf16(a[0], a[1]); w.y = cvt_pk_bf16(a[2], a[3]); w.z = cvt_pk_bf16(b[0], b[1]); w.w = cvt_pk_bf16(b[2], b[3]); return w; }
__device__ __forceinline__ f32x4 sigmoid4(f32x4 v) { f32x4 r;
#pragma unroll
    for (int i = 0; i < 4; ++i) r[i] = __builtin_amdgcn_rcpf(1.f + __builtin_amdgcn_exp2f(-1.4426950408889634f * v[i])); return r; }

struct EpiInProj {
    bf16_t* QKV; bf16_t* G; const float* rope; float* NP;
    __device__ __forceinline__ void operator()(const Acc& acc, const Unit& u, int wr, int wc, int fr, int fq) const {
        const int row0 = u.pm * BM + wr * 64 + fr;
        if (u.pn < 8) {
            const int g4 = 4 * (4 * wc + fq);
#pragma unroll
            for (int ai = 0; ai < 2; ++ai)
#pragma unroll
                for (int m = 0; m < 4; ++m) { const int r = row0 + ai * HALF + m * 16;
                    const f32x4 cs = *(const f32x4*)(rope + (size_t)r * 128 + g4), sn = *(const f32x4*)(rope + (size_t)r * 128 + 64 + g4);
#pragma unroll
                    for (int bj = 0; bj < 2; ++bj) { const f32x4 t1 = acc[ai][bj][m][0], t2 = acc[ai][bj][m][1];
                        const f32x4 o1 = t1 * cs - t2 * sn, o2 = t1 * sn + t2 * cs;
                        bf16_t* dst = QKV + (size_t)(2 * u.pn + bj) * QUS + (size_t)r * 128;
                        u32x2 w1, w2; w1.x = cvt_pk_bf16(o1[0], o1[1]); w1.y = cvt_pk_bf16(o1[2], o1[3]); w2.x = cvt_pk_bf16(o2[0], o2[1]); w2.y = cvt_pk_bf16(o2[2], o2[3]);
                        *(u32x2*)(dst + g4) = w1; *(u32x2*)(dst + 64 + g4) = w2; } }
        } else if (u.pn < 24) {
#pragma unroll
            for (int ai = 0; ai < 2; ++ai)
#pragma unroll
                for (int m = 0; m < 4; ++m) { const int r = row0 + ai * HALF + m * 16;
#pragma unroll
                    for (int bj = 0; bj < 2; ++bj) *(u32x4*)(QKV + (size_t)(2 * u.pn + bj) * QUS + (size_t)r * 128 + wc * 32 + 8 * fq) = pack8(acc[ai][bj][m][0], acc[ai][bj][m][1]); }
            if (u.pn >= 12 && u.pn < 20) {
#pragma unroll
                for (int ai = 0; ai < 2; ++ai)
#pragma unroll
                    for (int bj = 0; bj < 2; ++bj) { float mx = 0.f;
#pragma unroll
                        for (int m = 0; m < 4; ++m) { const f32x4 a = acc[ai][bj][m][0], b = acc[ai][bj][m][1];
                            float ss = (a[0] * a[0] + a[1] * a[1]) + (a[2] * a[2] + a[3] * a[3]) + (b[0] * b[0] + b[1] * b[1]) + (b[2] * b[2] + b[3] * b[3]);
                            ss += __shfl_xor(ss, 16); ss += __shfl_xor(ss, 32); mx = fmaxf(mx, ss); }
                        mx = fmaxf(mx, __shfl_xor(mx, 1)); mx = fmaxf(mx, __shfl_xor(mx, 2)); mx = fmaxf(mx, __shfl_xor(mx, 4)); mx = fmaxf(mx, __shfl_xor(mx, 8));
                        if (fr == 0 && fq == 0) NP[((size_t)(2 * u.pn + bj - 24) * 128 + 4 * u.pm + 2 * ai + wr) * 4 + wc] = mx; }
            }
        } else {
            const int col0 = (u.pn - 24) * BM + wc * 32 + 8 * fq;
#pragma unroll
            for (int ai = 0; ai < 2; ++ai)
#pragma unroll
                for (int m = 0; m < 4; ++m) { const int r = row0 + ai * HALF + m * 16;
#pragma unroll
                    for (int bj = 0; bj < 2; ++bj) *(u32x4*)(G + (size_t)r * 4096 + col0 + bj * HALF) = pack8(sigmoid4(acc[ai][bj][m][0]), sigmoid4(acc[ai][bj][m][1])); }
        }
    }
};
struct EpiGateT {
    float* T; const bf16_t* G;
    __device__ __forceinline__ void operator()(const Acc& acc, const Unit& u, int wr, int wc, int fr, int fq) const {
        const int row0 = u.pm * BM + wr * 64 + fr, col0 = u.pn * BM + wc * 32 + 8 * fq;
#pragma unroll
        for (int ai = 0; ai < 2; ++ai)
#pragma unroll
            for (int m = 0; m < 4; ++m) { const int r = row0 + ai * HALF + m * 16;
#pragma unroll
                for (int bj = 0; bj < 2; ++bj) { const int c = col0 + bj * HALF; const u32x4 gw = *(const u32x4*)(G + (size_t)r * 4096 + c);
                    const f32x4 g0 = {bf_lo(gw.x), bf_hi(gw.x), bf_lo(gw.y), bf_hi(gw.y)}, g1 = {bf_lo(gw.z), bf_hi(gw.z), bf_lo(gw.w), bf_hi(gw.w)};
                    *(f32x4*)(T + (size_t)r * DM + c) = acc[ai][bj][m][0] * g0; *(f32x4*)(T + (size_t)r * DM + c + 4) = acc[ai][bj][m][1] * g1; } }
    }
};
struct EpiGateM {
    const float* T; const bf16_t* G; bf16_t* MB;
    __device__ __forceinline__ void operator()(const Acc& acc, const Unit& u, int wr, int wc, int fr, int fq) const {
        const int row0 = u.pm * BM + wr * 64 + fr, col0 = u.pn * BM + wc * 32 + 8 * fq;
#pragma unroll
        for (int ai = 0; ai < 2; ++ai)
#pragma unroll
            for (int m = 0; m < 4; ++m) { const int r = row0 + ai * HALF + m * 16;
#pragma unroll
                for (int bj = 0; bj < 2; ++bj) { const int c = col0 + bj * HALF; const u32x4 gw = *(const u32x4*)(G + (size_t)r * 4096 + 2048 + c);
                    const f32x4 g0 = {bf_lo(gw.x), bf_hi(gw.x), bf_lo(gw.y), bf_hi(gw.y)}, g1 = {bf_lo(gw.z), bf_hi(gw.z), bf_lo(gw.w), bf_hi(gw.w)};
                    const f32x4 t0 = *(const f32x4*)(T + (size_t)r * DM + c), t1 = *(const f32x4*)(T + (size_t)r * DM + c + 4);
                    *(u32x4*)(MB + (size_t)r * DM + c) = pack8(t0 + acc[ai][bj][m][0] * g0, t1 + acc[ai][bj][m][1] * g1); } }
    }
};
struct EpiGateHook {
    const bf16_t* G; bf16_t* MB;
    __device__ __forceinline__ void hook(Acc& acc, const Unit& u, int wr, int wc, int fr, int fq) const {
        int row0 = u.pm * BM + wr * 64 + fr, col0 = u.pn * BM + wc * 32 + 8 * fq;
        asm volatile("" : "+v"(row0), "+v"(col0));
#pragma unroll
        for (int ai = 0; ai < 2; ++ai)
#pragma unroll
            for (int m = 0; m < 4; ++m) { int r = row0 + ai * HALF + m * 16; asm volatile("" : "+v"(r));
#pragma unroll
                for (int bj = 0; bj < 2; ++bj) { const int c = col0 + bj * HALF; const u32x4 gd = *(const u32x4*)(G + (size_t)r * 4096 + c), gf = *(const u32x4*)(G + (size_t)r * 4096 + 2048 + c);
                    const f32x4 d0 = {bf_lo(gd.x), bf_hi(gd.x), bf_lo(gd.y), bf_hi(gd.y)}, d1 = {bf_lo(gd.z), bf_hi(gd.z), bf_lo(gd.w), bf_hi(gd.w)};
                    f32x4 f0 = {bf_lo(gf.x), bf_hi(gf.x), bf_lo(gf.y), bf_hi(gf.y)}, f1 = {bf_lo(gf.z), bf_hi(gf.z), bf_lo(gf.w), bf_hi(gf.w)};
#pragma unroll
                    for (int i = 0; i < 4; ++i) { f0[i] = __builtin_amdgcn_rcpf(fmaxf(f0[i], 1e-30f)); f1[i] = __builtin_amdgcn_rcpf(fmaxf(f1[i], 1e-30f)); }
                    acc[ai][bj][m][0] = acc[ai][bj][m][0] * (d0 * f0); acc[ai][bj][m][1] = acc[ai][bj][m][1] * (d1 * f1); }
                asm volatile("" ::: "memory"); }
    }
    __device__ __forceinline__ void operator()(const Acc& acc, const Unit& u, int wr, int wc, int fr, int fq) const {
        const int row0 = u.pm * BM + wr * 64 + fr, col0 = u.pn * BM + wc * 32 + 8 * fq;
#pragma unroll
        for (int ai = 0; ai < 2; ++ai)
#pragma unroll
            for (int m = 0; m < 4; ++m) { const int r = row0 + ai * HALF + m * 16;
#pragma unroll
                for (int bj = 0; bj < 2; ++bj) { const int c = col0 + bj * HALF; const u32x4 gw = *(const u32x4*)(G + (size_t)r * 4096 + 2048 + c);
                    const f32x4 g0 = {bf_lo(gw.x), bf_hi(gw.x), bf_lo(gw.y), bf_hi(gw.y)}, g1 = {bf_lo(gw.z), bf_hi(gw.z), bf_lo(gw.w), bf_hi(gw.w)};
                    *(u32x4*)(MB + (size_t)r * DM + c) = pack8(acc[ai][bj][m][0] * g0, acc[ai][bj][m][1] * g1); } }
    }
};
struct EpiZ {
    bf16_t* YO;
    __device__ __forceinline__ void operator()(const Acc& acc, const Unit& u, int wr, int wc, int fr, int fq) const {
        const int row0 = u.pm * BM + wr * 64 + fr, col0 = u.pn * BM + wc * 32 + 8 * fq;
#pragma unroll
        for (int ai = 0; ai < 2; ++ai)
#pragma unroll
            for (int m = 0; m < 4; ++m) { const int r = row0 + ai * HALF + m * 16;
#pragma unroll
                for (int bj = 0; bj < 2; ++bj) *(u32x4*)(YO + (size_t)r * DM + col0 + bj * HALF) = pack8(acc[ai][bj][m][0], acc[ai][bj][m][1]); }
    }
};
struct EpiSwiGLU {
    bf16_t* H;
    __device__ __forceinline__ void operator()(const Acc& acc, const Unit& u, int wr, int wc, int fr, int fq) const {
        const int row0 = u.pm * BM + wr * 64 + fr, col0 = u.pn * HALF + wc * 32 + 8 * fq;
#pragma unroll
        for (int ai = 0; ai < 2; ++ai)
#pragma unroll
            for (int m = 0; m < 4; ++m) { const int r = row0 + ai * HALF + m * 16; f32x4 h[2];
#pragma unroll
                for (int n = 0; n < 2; ++n) { const f32x4 gt = acc[ai][0][m][n], up = acc[ai][1][m][n]; h[n] = gt * sigmoid4(gt) * up; }
                store16_wt(H + (size_t)r * FF + col0, pack8(h[0], h[1])); }
    }
};
struct EpiY {
    bf16_t* Y;
    __device__ __forceinline__ void operator()(const Acc& acc, const Unit& u, int wr, int wc, int fr, int fq) const {
        const int row0 = u.pm * BM + wr * 64 + fr, col0 = (u.pn & 7) * BM + wc * 32 + 8 * fq;
#pragma unroll
        for (int ai = 0; ai < 2; ++ai)
#pragma unroll
            for (int m = 0; m < 4; ++m) { unsigned bo = (unsigned)((row0 + ai * HALF + m * 16) * DM + col0) * 2u; asm volatile("" : "+v"(bo));
#pragma unroll
                for (int bj = 0; bj < 2; ++bj) *(u32x4*)((char*)Y + bo + bj * HALF * 2) = pack8(acc[ai][bj][m][0], acc[ai][bj][m][1]); }
    }
};
}

namespace att {
using bf16 = __hip_bfloat16;
constexpr int D = 128, NW = 8, QBLK = 32, KVBLK = 64, QB = NW * QBLK;
constexpr int SHM_V = KVBLK * D * 2, SHM_K = KVBLK * D * 2;
constexpr int LDS_WS_OFF = 2 * SHM_V + 2 * SHM_K, LDS_BIAS_OFF = LDS_WS_OFF + NW * 64 * 4, LDS_BYTES = LDS_BIAS_OFF + 512;
constexpr float SCALE = 0.08838834764831845f;
constexpr float THR = 8.f;
#define KSWZ(row, colB) ((row) * 256 + ((colB) ^ (((row) & 7) << 4)))
#define SBAR() __builtin_amdgcn_sched_barrier(0)
__device__ __forceinline__ int v_st(int k, int c) { const int kk = (k & ~0xC) | ((k & 4) << 1) | ((k & 8) >> 1); return ((kk >> 3) * 4 + (c >> 5)) * 512 + ((kk & 7) * 32 + (c & 31)) * 2; }
__device__ __forceinline__ int v_rd_base(int lane) { return ((lane & 3) << 3) | (((lane >> 2) & 3) << 6) | (((lane >> 4) & 1) << 5) | (((lane >> 5) & 1) << 8); }
constexpr int v_rd_off(int d0, int ks, int half) { return d0 * 512 + ks * 4096 + half * 2048; }
__device__ __forceinline__ int crow(int r, int hi) { return (r & 3) + 8 * (r >> 2) + 4 * hi; }
__device__ __forceinline__ unsigned cvtpk(float lo, float hi) { unsigned r; asm volatile("v_cvt_pk_bf16_f32 %0, %1, %2" : "=v"(r) : "v"(lo), "v"(hi)); return r; }
__device__ __forceinline__ bf16x8 load8(const bf16* p) { return *reinterpret_cast<const bf16x8*>(p); }
__device__ __forceinline__ void mask_tile(f32x16& p0, f32x16& p1, int dq) {
    const float NEG = -__builtin_inff();
#pragma unroll
    for (int r = 0; r < 16; ++r) { const int c = (r & 3) + 8 * (r >> 2); if (dq - c < 0) p0[r] = NEG; if (dq - c - 32 < 0) p1[r] = NEG; }
}
__device__ __forceinline__ void partialSM(f32x16& p0, f32x16& p1, float& m_reg, float& mn, float& alpha) {
    float pmax = p0[0];
#pragma unroll
    for (int r = 1; r < 16; ++r) pmax = fmaxf(pmax, p0[r]);
#pragma unroll
    for (int r = 0; r < 16; ++r) pmax = fmaxf(pmax, p1[r]);
    { auto rr = __builtin_amdgcn_permlane32_swap(__float_as_uint(pmax), __float_as_uint(pmax), false, false); pmax = fmaxf(__uint_as_float(rr[0]), __uint_as_float(rr[1])); }
    constexpr float C2 = 1.4426950408889634f * SCALE;
    if (__builtin_expect(__all((pmax - m_reg) * SCALE <= THR), 1)) { mn = m_reg; alpha = 1.f; }
    else { mn = fmaxf(m_reg, pmax); alpha = __builtin_amdgcn_exp2f((m_reg - mn) * C2); m_reg = mn; }
    const float mnL = -mn * C2;
#pragma unroll
    for (int r = 0; r < 16; ++r) p0[r] = fmaf(p0[r], C2, mnL);
#pragma unroll
    for (int r = 0; r < 16; ++r) p1[r] = fmaf(p1[r], C2, mnL);
#pragma unroll
    for (int r = 0; r < 16; ++r) p0[r] = __builtin_amdgcn_exp2f(p0[r]);
}
__device__ __forceinline__ void finishSM(f32x16& p0, f32x16& p1, float alpha, float& l_reg, bf16x8& pa0, bf16x8& pa1, bf16x8& pa2, bf16x8& pa3) {
#pragma unroll
    for (int r = 0; r < 16; ++r) p1[r] = __builtin_amdgcn_exp2f(p1[r]);
    float ps = 0;
#pragma unroll
    for (int r = 0; r < 16; ++r) ps += p0[r];
#pragma unroll
    for (int r = 0; r < 16; ++r) ps += p1[r];
    { auto rr = __builtin_amdgcn_permlane32_swap(__float_as_uint(ps), __float_as_uint(ps), false, false); ps = __uint_as_float(rr[0]) + __uint_as_float(rr[1]); }
    l_reg = l_reg * alpha + ps;
#define PK4(P, B_, OUT) do { unsigned a0 = cvtpk(P[B_+0], P[B_+1]), a1 = cvtpk(P[B_+2], P[B_+3]);                          \
        unsigned b0 = cvtpk(P[B_+4], P[B_+5]), b1 = cvtpk(P[B_+6], P[B_+7]);                                             \
        auto r0 = __builtin_amdgcn_permlane32_swap(a0, b0, false, false); auto r1 = __builtin_amdgcn_permlane32_swap(a1, b1, false, false); \
        u32x4 w = {r0[0], r1[0], r0[1], r1[1]}; OUT = *reinterpret_cast<bf16x8*>(&w); } while (0)
    PK4(p0, 0, pa0); PK4(p0, 8, pa1); PK4(p1, 0, pa2); PK4(p1, 8, pa3);
#undef PK4
}
template <int KB>
__device__ __forceinline__ void qkt(f32x16& p0, f32x16& p1, const char* K_lds, const char* B_lds, int r32, int hi, const bf16x8* qr) {
    const float* bl = (const float*)(B_lds + KB * 256) + 4 * hi;
#pragma unroll
    for (int g = 0; g < 4; ++g) { const f32x4 b0 = *(const f32x4*)(bl + 8 * g), b1 = *(const f32x4*)(bl + 32 + 8 * g);
#pragma unroll
        for (int i = 0; i < 4; ++i) { p0[4 * g + i] = b0[i]; p1[4 * g + i] = b1[i]; } }
    const char* kb[4];
#pragma unroll
    for (int dd = 0; dd < 4; ++dd) kb[dd] = K_lds + KB * SHM_K + KSWZ(r32, (dd * 16 + hi * 8) * 2);
#pragma unroll
    for (int d0 = 0; d0 < 8; ++d0) { const char* a = kb[d0 & 3] + (d0 >> 2) * 128;
        bf16x8 b0 = *reinterpret_cast<const bf16x8*>(a);
        bf16x8 b1 = *reinterpret_cast<const bf16x8*>(a + 32 * 256);
        p0 = __builtin_amdgcn_mfma_f32_32x32x16_bf16(b0, qr[d0], p0, 0, 0, 0);
        p1 = __builtin_amdgcn_mfma_f32_32x32x16_bf16(b1, qr[d0], p1, 0, 0, 0); }
}
template <int VB>
__device__ __forceinline__ void pv_tile(f32x16* o, int vb0, bf16x8 pa0, bf16x8 pa1, bf16x8 pa2, bf16x8 pa3) {
#define TRRD(dst, off) asm volatile("ds_read_b64_tr_b16 %0, %1 offset:%2" : "=&v"(dst) : "v"(vb0), "i"(off) : "memory")
#define PV_D0(d0) do { s16x4 l0, l1, l2, l3, h0, h1, h2, h3; constexpr int b_ = VB * SHM_V + v_rd_off(d0, 0, 0); \
        TRRD(l0, b_); TRRD(h0, b_ + 2048); TRRD(l1, b_ + 4096); TRRD(h1, b_ + 6144); TRRD(l2, b_ + 8192); TRRD(h2, b_ + 10240); TRRD(l3, b_ + 12288); TRRD(h3, b_ + 14336); \
        asm volatile("s_waitcnt lgkmcnt(0)" ::: "memory"); SBAR();   \
        o[d0] = __builtin_amdgcn_mfma_f32_32x32x16_bf16(pa0, (bf16x8){l0[0], l0[1], l0[2], l0[3], h0[0], h0[1], h0[2], h0[3]}, o[d0], 0, 0, 0);   \
        o[d0] = __builtin_amdgcn_mfma_f32_32x32x16_bf16(pa1, (bf16x8){l1[0], l1[1], l1[2], l1[3], h1[0], h1[1], h1[2], h1[3]}, o[d0], 0, 0, 0);   \
        o[d0] = __builtin_amdgcn_mfma_f32_32x32x16_bf16(pa2, (bf16x8){l2[0], l2[1], l2[2], l2[3], h2[0], h2[1], h2[2], h2[3]}, o[d0], 0, 0, 0);   \
        o[d0] = __builtin_amdgcn_mfma_f32_32x32x16_bf16(pa3, (bf16x8){l3[0], l3[1], l3[2], l3[3], h3[0], h3[1], h3[2], h3[3]}, o[d0], 0, 0, 0); } while (0)
    PV_D0(0); PV_D0(1); PV_D0(2); PV_D0(3);
#undef PV_D0
#undef TRRD
}
struct BlockRef { const bf16* Q; const bf16* K; const bf16* V; const float* B; bf16* O; int ostride; int P0; int jlo; };
struct Seam { bf16x8 qr[8]; bf16x8 st_v0, st_v1, st_k0, st_k1; };
#define ROW(p, k0, rr) ((p) + (size_t)((k0) + (rr)) * D + sc)
#define VMW() asm volatile("s_waitcnt vmcnt(0)" ::: "memory")
#define VMWN(n) asm volatile("s_waitcnt vmcnt(%0)" :: "i"(n) : "memory")
#define SLOAD_H(Kp, Vp, k0) do { S.st_v0 = load8(ROW(Vp, k0, sr)); S.st_v1 = load8(ROW(Vp, k0, 32 + sr));              \
                         S.st_k0 = load8(ROW(Kp, k0, sr)); S.st_k1 = load8(ROW(Kp, k0, 32 + sr)); } while (0)
#define BLOAD(Bp, k0, bf) do { if (wid == 0) __builtin_amdgcn_global_load_lds((const unsigned*)((Bp) + (k0) + lane), (LAS unsigned*)(lds3 + LDS_BIAS_OFF + (bf) * 256), 4, 0, 0); } while (0)
#define SWRITE_HK(bf) do { *(bf16x8*)(K_lds + (bf) * SHM_K + kws) = S.st_k0; *(bf16x8*)(K_lds + (bf) * SHM_K + kws + 32 * 256) = S.st_k1; } while (0)
#define SWRITE_HV(bf) do { *(bf16x8*)(V_lds + (bf) * SHM_V + vst0) = S.st_v0; *(bf16x8*)(V_lds + (bf) * SHM_V + vst1) = S.st_v1; } while (0)
#define SWRITE_H(bf) do { SWRITE_HV(bf); SWRITE_HK(bf); } while (0)
__device__ __forceinline__ void attn_prime(const BlockRef& cur, char* lds, LAS unsigned char* lds3, Seam& S) {
    int tid = threadIdx.x; asm volatile("" : "+v"(tid)); const int wid = __builtin_amdgcn_readfirstlane(tid >> 6), lane = tid & 63, r32 = lane & 31, hi = lane >> 5;
    const int sr = tid >> 4, sc = (tid & 15) * 8, kws = KSWZ(sr, sc * 2); char* K_lds = lds + 2 * SHM_V;
#pragma unroll
    for (int d0 = 0; d0 < 8; ++d0) S.qr[d0] = load8(cur.Q + (size_t)(wid * QBLK + r32) * D + d0 * 16 + hi * 8);
    SLOAD_H(cur.K, cur.V, 0); BLOAD(cur.B, 0, 0); VMW(); SWRITE_HK(0);
    __syncthreads();
}
__device__ __forceinline__ void attn_block(const BlockRef& cur, const BlockRef& nxt, char* lds, LAS unsigned char* lds3, Seam& S) {
    int tid = threadIdx.x; asm volatile("" : "+v"(tid)); const int wid = __builtin_amdgcn_readfirstlane(tid >> 6), lane = tid & 63, r32 = lane & 31, hi = lane >> 5;
    const int NT = (cur.P0 + QB) / KVBLK - cur.jlo;
    const int qlo = cur.P0 + wid * QBLK, qm = qlo + r32 - 4 * hi;
    char* V_lds = lds; char* K_lds = lds + 2 * SHM_V; const char* B_lds = lds + LDS_BIAS_OFF;
    float* ws = (float*)(lds + LDS_WS_OFF) + wid * 64; float* li_l = ws, * al_l = ws + 32;
    float m_reg = -1e30f, l_reg = 0; f32x16 o[4] = {};
    const int sr = tid >> 4, sc = (tid & 15) * 8, vst0 = v_st(sr, sc), vst1 = v_st(32 + sr, sc), kws = KSWZ(sr, sc * 2);
    const int vb0 = (int)(uintptr_t)V_lds + v_rd_base(lane);
    const bf16* Kh = cur.K; const bf16* Vh = cur.V; const float* Bh = cur.B;
#define RESC(a) do { if (__any((a) < 1.f)) { if (hi == 0) al_l[r32] = (a); asm volatile("s_waitcnt lgkmcnt(0)" ::: "memory");              \
                     _Pragma("unroll") for (int d_ = 0; d_ < 4; ++d_) _Pragma("unroll") for (int r = 0; r < 16; ++r) o[d_][r] *= al_l[crow(r, hi)]; } } while (0)
#define KBASE(t) ((t) * KVBLK)
#define MASKT(P0_, P1_, t) do { const int kb_ = KBASE((t) + cur.jlo); if (kb_ + KVBLK - 1 > qlo) mask_tile(P0_, P1_, qm - kb_); } while (0)
    f32x16 pA0, pA1, pB0, pB1; float mnA, mnB, alA, alB; bf16x8 pa0, pa1, pa2, pa3;
    SWRITE_HV(0); SBAR();
    SLOAD_H(Kh, Vh, KBASE(1)); BLOAD(Bh, KBASE(1), 1);
    SBAR(); qkt<0>(pA0, pA1, K_lds, B_lds, r32, hi, S.qr);
    MASKT(pA0, pA1, 0); partialSM(pA0, pA1, m_reg, mnA, alA);
    VMW(); SWRITE_H(1);
    __syncthreads();
#define HALF_STEP(PX0, PX1, mnX, alX, PY0, PY1, alY, t, KB, VB, SB) do {                                                      \
        SBAR(); qkt<KB>(PX0, PX1, K_lds, B_lds, r32, hi, S.qr);                                                               \
        finishSM(PY0, PY1, alY, l_reg, pa0, pa1, pa2, pa3); SBAR();                                                           \
        if ((t) + 1 < NT) { SLOAD_H(Kh, Vh, KBASE((t) + 1)); BLOAD(Bh, KBASE((t) + 1), SB); SBAR(); }                        \
        pv_tile<VB>(o, vb0, pa0, pa1, pa2, pa3); MASKT(PX0, PX1, (t)); partialSM(PX0, PX1, m_reg, mnX, alX);                  \
        __syncthreads();                                                                                                      \
        if ((t) + 1 < NT) { VMW(); SWRITE_H(SB); }                                                                            \
        RESC(alX); __syncthreads(); } while (0)
    for (int t = 1; t + 1 < NT; t += 2) {
        HALF_STEP(pB0, pB1, mnB, alB, pA0, pA1, alA, t, 1, 0, 0);
        HALF_STEP(pA0, pA1, mnA, alA, pB0, pB1, alB, t + 1, 0, 1, 1);
    }
    SBAR(); qkt<1>(pB0, pB1, K_lds, B_lds, r32, hi, S.qr); SBAR();
    SLOAD_H(nxt.K, nxt.V, 0); BLOAD(nxt.B, 0, 0); SBAR();
#pragma unroll
    for (int d0 = 0; d0 < 8; ++d0) S.qr[d0] = load8(nxt.Q + (size_t)(wid * QBLK + r32) * D + d0 * 16 + hi * 8);
    SBAR();
    finishSM(pA0, pA1, alA, l_reg, pa0, pa1, pa2, pa3); SBAR();
    pv_tile<0>(o, vb0, pa0, pa1, pa2, pa3);
    MASKT(pB0, pB1, NT - 1); partialSM(pB0, pB1, m_reg, mnB, alB); __syncthreads(); RESC(alB);
    finishSM(pB0, pB1, alB, l_reg, pa0, pa1, pa2, pa3); SBAR(); pv_tile<1>(o, vb0, pa0, pa1, pa2, pa3);
    SBAR(); VMWN(8); SWRITE_HK(0); SBAR();
    if (hi == 0) li_l[r32] = l_reg; asm volatile("s_waitcnt lgkmcnt(0)" ::: "memory");
    float rli[16];
#pragma unroll
    for (int r = 0; r < 16; ++r) rli[r] = __builtin_amdgcn_rcpf(li_l[crow(r, hi)]);
    bf16* Ow = cur.O + (size_t)(wid * QBLK) * cur.ostride;
#pragma unroll
    for (int r = 0; r < 16; ++r) { const int orow = crow(r, hi);
#pragma unroll
        for (int d0 = 0; d0 < 4; ++d0) { const float v = o[d0][r] * rli[r];
            const float vn = __shfl_xor(v, 1);
            if ((r32 & 1) == 0) *(unsigned*)(Ow + (size_t)orow * cur.ostride + d0 * 32 + r32) = cvtpk(v, vn); } }
    __syncthreads();
#undef RESC
#undef KBASE
#undef MASKT
#undef HALF_STEP
}

constexpr int DV1_OFF = 32768, DK_OFF = 65536, DP_OFF = 98304, DWS_OFF = 131072, DATT_LDS_END = DWS_OFF + 2048;
struct DRef { const bf16* Q; const bf16* K; const bf16* V0; const bf16* V1; bf16* O0; bf16* O1; int P0; };
template <int KB>
__device__ __forceinline__ void qkt0(f32x16& p0, f32x16& p1, const char* K_lds, int r32, int hi, const bf16x8* qr) {
    p0 = f32x16{}; p1 = f32x16{};
    const char* kb[4];
#pragma unroll
    for (int dd = 0; dd < 4; ++dd) kb[dd] = K_lds + KB * SHM_K + KSWZ(r32, (dd * 16 + hi * 8) * 2);
#pragma unroll
    for (int d0 = 0; d0 < 8; ++d0) { const char* a = kb[d0 & 3] + (d0 >> 2) * 128;
        bf16x8 b0 = *reinterpret_cast<const bf16x8*>(a);
        bf16x8 b1 = *reinterpret_cast<const bf16x8*>(a + 32 * 256);
        p0 = __builtin_amdgcn_mfma_f32_32x32x16_bf16(b0, qr[d0], p0, 0, 0, 0);
        p1 = __builtin_amdgcn_mfma_f32_32x32x16_bf16(b1, qr[d0], p1, 0, 0, 0); }
}
#define D_KLOAD(Kp, k0) do { _Pragma("unroll") for (int j_ = 0; j_ < 4; ++j_) kst[j_] = load8((Kp) + (size_t)((k0) + sr + 16 * j_) * D + sc); } while (0)
#define D_KWRITE(bf) do { _Pragma("unroll") for (int j_ = 0; j_ < 4; ++j_) *(bf16x8*)(K_lds + (bf) * SHM_K + kws + j_ * 4096) = kst[j_]; } while (0)
#define D_VLOAD(V0p, V1p, k0) do { unsigned vo_ = (unsigned)(sr * D + sc) * 2u; asm volatile("" : "+v"(vo_));   \
        _Pragma("unroll") for (int j_ = 0; j_ < 4; ++j_) { vs[j_] = load8((const bf16*)((const char*)((V0p) + (size_t)((k0) + 16 * j_) * D) + vo_)); vs[4 + j_] = load8((const bf16*)((const char*)((V1p) + (size_t)((k0) + 16 * j_) * D) + vo_)); } } while (0)
#define D_VWRITE(sl_) do { int sr_ = sr; asm volatile("" : "+v"(sr_)); _Pragma("unroll") for (int j_ = 0; j_ < 4; ++j_) { const int vs_ = v_st(sr_ + 16 * j_, sc); *(bf16x8*)(V_lds + (sl_) * SHM_V + vs_) = vs[j_]; *(bf16x8*)(V1_lds + (sl_) * SHM_V + vs_) = vs[4 + j_]; } } while (0)
#define D_PEXPORT(pb_) do { bf16x8* pp_ = (bf16x8*)(P_lds + (pb_) * 16384) + lane; pp_[0] = pa0; pp_[64] = pa1; pp_[128] = pa2; pp_[192] = pa3; } while (0)
#define D_PIMPORT(pb_) do { const bf16x8* pp_ = (const bf16x8*)(P_lds + (pb_) * 16384) + lane; pa0 = pp_[0]; pa1 = pp_[64]; pa2 = pp_[128]; pa3 = pp_[192]; } while (0)
#define D_AEXPORT(par, a) do { if (hi == 0) al_l[(par) * 32 + r32] = (a); } while (0)
#define D_RESC(par) do { const float* ap_ = al_l + (par) * 32; const float a_ = ap_[r32]; if (__any(a_ < 1.f)) { _Pragma("unroll") for (int d_ = 0; d_ < 4; ++d_) _Pragma("unroll") for (int r = 0; r < 16; ++r) { const float f_ = ap_[crow(r, hi)]; o0[d_][r] *= f_; o1[d_][r] *= f_; } } } while (0)
#define D_OSTORE(Op, oo) do { int rq_ = r32, hq_ = hi; asm volatile("" : "+v"(rq_), "+v"(hq_));   bf16* Ow = (Op) + (size_t)((wid & 3) * QBLK) * D + rq_; \
        _Pragma("unroll") for (int r = 0; r < 16; ++r) { const int orow = crow(r, hq_); \
            const float rl_ = __builtin_amdgcn_rcpf(li_l[orow]); \
            _Pragma("unroll") for (int d0 = 0; d0 < 4; ++d0) { const float v = oo[d0][r] * rl_; const float vn = __shfl_xor(v, 1); \
                if ((r32 & 1) == 0) *(unsigned*)(Ow + (size_t)orow * D + d0 * 32) = cvtpk(v, vn); } } } while (0)
__device__ __forceinline__ void pv_both(f32x16* o0, f32x16* o1, int vb0s, int vb1s, bf16x8 pa0, bf16x8 pa1, bf16x8 pa2, bf16x8 pa3) {
#define TRRD(dst, base, off) asm volatile("ds_read_b64_tr_b16 %0, %1 offset:%2" : "=&v"(dst) : "v"(base), "i"(off) : "memory")
#define TR8(P, base, d0) do { constexpr int b_ = v_rd_off(d0, 0, 0); TRRD(P##l0, base, b_); TRRD(P##h0, base, b_ + 2048); TRRD(P##l1, base, b_ + 4096); TRRD(P##h1, base, b_ + 6144); \
        TRRD(P##l2, base, b_ + 8192); TRRD(P##h2, base, b_ + 10240); TRRD(P##l3, base, b_ + 12288); TRRD(P##h3, base, b_ + 14336); } while (0)
#define MM4(P, acc) do { \
        acc = __builtin_amdgcn_mfma_f32_32x32x16_bf16(pa0, (bf16x8){P##l0[0], P##l0[1], P##l0[2], P##l0[3], P##h0[0], P##h0[1], P##h0[2], P##h0[3]}, acc, 0, 0, 0); \
        acc = __builtin_amdgcn_mfma_f32_32x32x16_bf16(pa1, (bf16x8){P##l1[0], P##l1[1], P##l1[2], P##l1[3], P##h1[0], P##h1[1], P##h1[2], P##h1[3]}, acc, 0, 0, 0); \
        acc = __builtin_amdgcn_mfma_f32_32x32x16_bf16(pa2, (bf16x8){P##l2[0], P##l2[1], P##l2[2], P##l2[3], P##h2[0], P##h2[1], P##h2[2], P##h2[3]}, acc, 0, 0, 0); \
        acc = __builtin_amdgcn_mfma_f32_32x32x16_bf16(pa3, (bf16x8){P##l3[0], P##l3[1], P##l3[2], P##l3[3], P##h3[0], P##h3[1], P##h3[2], P##h3[3]}, acc, 0, 0, 0); } while (0)
#define WAIT8() do { asm volatile("s_waitcnt lgkmcnt(8)" ::: "memory"); SBAR(); } while (0)
#define WAIT0() do { asm volatile("s_waitcnt lgkmcnt(0)" ::: "memory"); SBAR(); } while (0)
    s16x4 Al0, Al1, Al2, Al3, Ah0, Ah1, Ah2, Ah3, Bl0, Bl1, Bl2, Bl3, Bh0, Bh1, Bh2, Bh3;
    TR8(A, vb0s, 0);
    TR8(B, vb1s, 0); WAIT8(); MM4(A, o0[0]);
    TR8(A, vb0s, 1); WAIT8(); MM4(B, o1[0]);
    TR8(B, vb1s, 1); WAIT8(); MM4(A, o0[1]);
    TR8(A, vb0s, 2); WAIT8(); MM4(B, o1[1]);
    TR8(B, vb1s, 2); WAIT8(); MM4(A, o0[2]);
    TR8(A, vb0s, 3); WAIT8(); MM4(B, o1[2]);
    TR8(B, vb1s, 3); WAIT8(); MM4(A, o0[3]);
    WAIT0(); MM4(B, o1[3]);
#undef TRRD
#undef TR8
#undef MM4
#undef WAIT8
#undef WAIT0
}
__device__ __forceinline__ void pv_one(f32x16* o, int vbs, bf16x8 pa0, bf16x8 pa1, bf16x8 pa2, bf16x8 pa3) {
#define TRRD(dst, base, off) asm volatile("ds_read_b64_tr_b16 %0, %1 offset:%2" : "=&v"(dst) : "v"(base), "i"(off) : "memory")
#define TR8(P, base, d0) do { constexpr int b_ = v_rd_off(d0, 0, 0); TRRD(P##l0, base, b_); TRRD(P##h0, base, b_ + 2048); TRRD(P##l1, base, b_ + 4096); TRRD(P##h1, base, b_ + 6144); \
        TRRD(P##l2, base, b_ + 8192); TRRD(P##h2, base, b_ + 10240); TRRD(P##l3, base, b_ + 12288); TRRD(P##h3, base, b_ + 14336); } while (0)
#define MM4(P, acc) do { \
        acc = __builtin_amdgcn_mfma_f32_32x32x16_bf16(pa0, (bf16x8){P##l0[0], P##l0[1], P##l0[2], P##l0[3], P##h0[0], P##h0[1], P##h0[2], P##h0[3]}, acc, 0, 0, 0); \
        acc = __builtin_amdgcn_mfma_f32_32x32x16_bf16(pa1, (bf16x8){P##l1[0], P##l1[1], P##l1[2], P##l1[3], P##h1[0], P##h1[1], P##h1[2], P##h1[3]}, acc, 0, 0, 0); \
        acc = __builtin_amdgcn_mfma_f32_32x32x16_bf16(pa2, (bf16x8){P##l2[0], P##l2[1], P##l2[2], P##l2[3], P##h2[0], P##h2[1], P##h2[2], P##h2[3]}, acc, 0, 0, 0); \
        acc = __builtin_amdgcn_mfma_f32_32x32x16_bf16(pa3, (bf16x8){P##l3[0], P##l3[1], P##l3[2], P##l3[3], P##h3[0], P##h3[1], P##h3[2], P##h3[3]}, acc, 0, 0, 0); } while (0)
    s16x4 Al0, Al1, Al2, Al3, Ah0, Ah1, Ah2, Ah3, Bl0, Bl1, Bl2, Bl3, Bh0, Bh1, Bh2, Bh3;
    TR8(A, vbs, 0);
    TR8(B, vbs, 1); asm volatile("s_waitcnt lgkmcnt(8)" ::: "memory"); SBAR(); MM4(A, o[0]);
    TR8(A, vbs, 2); asm volatile("s_waitcnt lgkmcnt(8)" ::: "memory"); SBAR(); MM4(B, o[1]);
    TR8(B, vbs, 3); asm volatile("s_waitcnt lgkmcnt(8)" ::: "memory"); SBAR(); MM4(A, o[2]);
    asm volatile("s_waitcnt lgkmcnt(0)" ::: "memory"); SBAR(); MM4(B, o[3]);
#undef TRRD
#undef TR8
#undef MM4
}
struct DQueue { unsigned* ctr; volatile LAS unsigned* slot; const bf16* QKV; bf16* OD; int xcd; unsigned long long* stp; int half; };
constexpr int DS_ = 8192, DNITEM = 512;
__device__ __forceinline__ int dfetch(const DQueue& q, int& par, int tid) {
    if (tid == 0) { unsigned it_ = (unsigned)DNITEM;
        for (int k_ = 0; k_ < 8; ++k_) { const unsigned x_ = (unsigned)(q.xcd + k_) & 7u; const unsigned v_ = __hip_atomic_fetch_add(q.ctr + 64 * x_, 1u, __ATOMIC_RELAXED, __HIP_MEMORY_SCOPE_AGENT); if (v_ < 32u) { it_ = ((unsigned)q.half * 32u + v_) * 8u + x_; break; } }
        q.slot[par] = it_; }
    __syncthreads(); const int v = __builtin_amdgcn_readfirstlane((int)q.slot[par]); par ^= 1; return v;
}
__device__ __forceinline__ DRef dref_of(const DQueue& q, int item) {
    DRef r; const int m = item & 7, qb = 63 - (item >> 3);
    r.Q = q.QKV + (size_t)m * QUS + (size_t)(qb * 128) * 128; r.K = q.QKV + (size_t)(8 + m) * QUS;
    r.V0 = q.QKV + (size_t)(16 + (m >> 1) * 2) * QUS; r.V1 = r.V0 + QUS;
    r.O0 = q.OD + ((size_t)(2 * m) * DS_ + qb * 128) * 128; r.O1 = q.OD + ((size_t)(2 * m + 1) * DS_ + qb * 128) * 128; r.P0 = qb * 128; return r;
}
#define KBASE(t) ((t) * KVBLK)
__device__ __forceinline__ void dattn_S(char* lds, const DQueue& Q_) {
    int tid = threadIdx.x; asm volatile("" : "+v"(tid)); const int wid = __builtin_amdgcn_readfirstlane(tid >> 6), lane = tid & 63, r32 = lane & 31, hi = lane >> 5;
    const int t8 = tid & 255, sr = t8 >> 4, sc = (t8 & 15) * 8, kws = KSWZ(sr, sc * 2);
    char* K_lds = lds + DK_OFF; char* P_lds = lds + DP_OFF + (wid & 3) * 4096;
    float* ws = (float*)(lds + DWS_OFF) + (wid & 3) * 128; float* li_l = ws, * al_l = ws + 32;
    int par = 0; int item = dfetch(Q_, par, tid); if (item >= DNITEM) return;
    DRef cur = dref_of(Q_, item);
    bf16x8 qr[8], kst[4], pa0, pa1, pa2, pa3;
#pragma unroll
    for (int d0 = 0; d0 < 8; ++d0) qr[d0] = load8(cur.Q + (size_t)(wid * QBLK + r32) * D + d0 * 16 + hi * 8);
    D_KLOAD(cur.K, 0); VMW(); D_KWRITE(0); D_KLOAD(cur.K, KBASE(1));
    __syncthreads();
    for (;;) {
        bool more = false; DRef nxt = cur;
#define LATE_FETCH() do { const int nitem_ = dfetch(Q_, par, tid); more = nitem_ < DNITEM; if (more) nxt = dref_of(Q_, nitem_); } while (0)
        const int NT = (cur.P0 + 128) / KVBLK;
        const int qlo = cur.P0 + wid * QBLK, qm = qlo + r32 - 4 * hi;
        float m_reg = -1e30f, l_reg = 0; const bf16* Kh = cur.K;
        f32x16 pA0, pA1, pB0, pB1; float mnA, mnB, alA = 1.f, alB = 1.f;
#define MASKT(P0_, P1_, t) do { const int kb_ = KBASE(t); if (kb_ + KVBLK - 1 > qlo) mask_tile(P0_, P1_, qm - kb_); } while (0)
#define SSTEP(PX0, PX1, mnX, alX, PY0, PY1, mnY, alY, t, KB, FS) do {                                                              \
        VMW(); D_KWRITE((KB) ^ 1); SBAR();                                       \
        if ((t) + 2 < NT) { D_KLOAD(Kh, KBASE((t) + 2)); } else if ((t) + 2 == NT) { D_KLOAD(nxt.K, 0); }                     \
        SBAR(); qkt0<KB>(PX0, PX1, K_lds, r32, hi, qr);                                                                       \
        if (FS) { MASKT(PY0, PY1, (t) - 1); partialSM(PY0, PY1, m_reg, mnY, alY);          \
                  finishSM(PY0, PY1, alY, l_reg, pa0, pa1, pa2, pa3); D_PEXPORT((KB) ^ 1); D_AEXPORT((KB) ^ 1, alY); } SBAR(); \
        __syncthreads();                                                                                             \
        } while (0)
        if (NT == 2) LATE_FETCH();
        SSTEP(pA0, pA1, mnA, alA, pB0, pB1, mnB, alB, 0, 0, false);
        for (int t = 1; t < NT; t += 2) {
            SSTEP(pB0, pB1, mnB, alB, pA0, pA1, mnA, alA, t, 1, true);
            if (t + 1 < NT) { if (t + 1 == NT - 2) LATE_FETCH(); SSTEP(pA0, pA1, mnA, alA, pB0, pB1, mnB, alB, t + 1, 0, true); }
        }
        MASKT(pB0, pB1, NT - 1); partialSM(pB0, pB1, m_reg, mnB, alB);
        finishSM(pB0, pB1, alB, l_reg, pa0, pa1, pa2, pa3); D_PEXPORT(1); D_AEXPORT(1, alB); if (hi == 0) li_l[r32] = l_reg;
#pragma unroll
        for (int d0 = 0; d0 < 8; ++d0) qr[d0] = load8(nxt.Q + (size_t)(wid * QBLK + r32) * D + d0 * 16 + hi * 8);
        __syncthreads();
        D_KLOAD(nxt.K, KBASE(1));
        __syncthreads();
#undef MASKT
#undef SSTEP
#undef LATE_FETCH
        if (PROBE_SEL >= 0 && tid == 0) { if (Q_.stp[24] == 0ull) { Q_.stp[24] = __builtin_amdgcn_s_memrealtime(); Q_.stp[25] = (unsigned long long)(NT + 2); } else if (Q_.stp[26] == 0ull) { Q_.stp[26] = __builtin_amdgcn_s_memrealtime(); Q_.stp[27] = (unsigned long long)(NT + 2); } }
        if (!more) break;
        cur = nxt;
    }
    VMW();
}
__device__ __forceinline__ void dattn_V(char* lds, const DQueue& Q_) {
    int tid = threadIdx.x; asm volatile("" : "+v"(tid)); const int wid = __builtin_amdgcn_readfirstlane(tid >> 6), lane = tid & 63, r32 = lane & 31, hi = lane >> 5;
    const int t8 = tid & 255, sr = t8 >> 4, sc = (t8 & 15) * 8;
    char* V_lds = lds; char* V1_lds = lds + DV1_OFF; char* P_lds = lds + DP_OFF + (wid & 3) * 4096;
    float* ws = (float*)(lds + DWS_OFF) + (wid & 3) * 128; float* li_l = ws, * al_l = ws + 32;
    const int vb0 = (int)(uintptr_t)V_lds + v_rd_base(lane), vb1 = (int)(uintptr_t)V1_lds + v_rd_base(lane);
    int par = 0; int item = dfetch(Q_, par, tid); if (item >= DNITEM) return;
    DRef cur = dref_of(Q_, item);
    bf16x8 vs[8], pa0, pa1, pa2, pa3;
    __syncthreads();
    for (;;) {
        bool more = false; DRef nxt = cur;
        const int NT = (cur.P0 + 128) / KVBLK;
        f32x16 o0[4] = {}, o1[4] = {};
        int t = 0;
        do {
            if (t == NT - 2) { const int nitem_ = dfetch(Q_, par, tid); more = nitem_ < DNITEM; if (more) nxt = dref_of(Q_, nitem_); }
            if (t >= 1 && t <= NT) { VMW(); D_VWRITE((t - 1) & 1); }
            if (t < NT) D_VLOAD(cur.V0, cur.V1, KBASE(t));
            if (t >= 2) { const int pb = t & 1; D_RESC(pb); D_PIMPORT(pb); asm volatile("s_waitcnt lgkmcnt(0)" ::: "memory");
                pv_both(o0, o1, vb0 + pb * SHM_V, vb1 + pb * SHM_V, pa0, pa1, pa2, pa3); }
            if (t == NT + 1) { D_OSTORE(cur.O0, o0); D_OSTORE(cur.O1, o1); }
            __syncthreads();
        } while (++t < NT + 2);
        if (!more) break;
        cur = nxt;
    }
}
#undef KBASE
#undef D_KLOAD
#undef D_KWRITE
#undef D_VLOAD
#undef D_VWRITE
#undef D_PEXPORT
#undef D_PIMPORT
#undef D_AEXPORT
#undef D_RESC
#undef D_OSTORE
#undef ROW
#undef VMW
#undef VMWN
#undef SLOAD_H
#undef BLOAD
#undef SWRITE_HK
#undef SWRITE_HV
#undef SWRITE_H
#undef KSWZ
#undef SBAR
}

constexpr size_t MiB = 1u << 20, KiB = 1u << 10;
constexpr size_t WS_CTL = 0, CTL_ZERO_BYTES = 1 * MiB;
constexpr size_t WS_FLOG = 1 * MiB, WS_FBIAS = WS_FLOG + 256 * KiB, WS_ZEROB = WS_FBIAS + 256 * KiB, WS_WRT = WS_ZEROB + 64 * KiB;
constexpr size_t WS_NP = 1920 * KiB;
constexpr size_t WS_TOKINFO = 2 * MiB, WS_LIST = 3 * MiB;
constexpr size_t WS_ROPE = 4 * MiB;
constexpr size_t WS_WPC = 8 * MiB, WS_WOUT = 16 * MiB, WS_WIN = 24 * MiB, WS_WGU = 64 * MiB, WS_WD = 192 * MiB;
constexpr size_t WS_QKV = 256 * MiB, WS_G = 356 * MiB, WS_XB = 420 * MiB, WS_OD = 24 * MiB, WS_ACAT = 452 * MiB;
constexpr size_t WS_MB = 256 * MiB, WS_Z = 288 * MiB, WS_X1B = 352 * MiB, WS_H = 384 * MiB, WS_Y = 408 * MiB, WS_END = 504 * MiB;
constexpr int CW_TMO = 0, CW_BAR = 4096, CW_ATTQ = 8192, CW_ECNT = 12288, CW_QN = 16384, CW_KN = 17408, CW_DQ = 18560, CW_TD = 20480, CW_CD = 20736, CW_BG = 21504, CW_GD = 21632, CW_AD = 21760, CW_MQ8 = 22528, CW_MQ9 = 23552;
constexpr int HROWS = 24576;

constexpr int RING_OFF = 0, RING_BYTES = 131072;
constexpr int SM_OFF = 135168;
constexpr int LDSCTL_OFF = 155648, MISC_OFF = LDSCTL_OFF + 320;
constexpr int LDS_BYTES = 163840;
static_assert(att::DATT_LDS_END <= LDSCTL_OFF, "attention LDS map");

#define RLX_AGENT __ATOMIC_RELAXED, __HIP_MEMORY_SCOPE_AGENT
#define LDS_WAIT() asm volatile("s_waitcnt lgkmcnt(0)" ::: "memory")
#define VM_WAIT() asm volatile("s_waitcnt vmcnt(0)" ::: "memory")

#define XB_TMO      128
#define XB_XCNT(j)  (256  + 64 * (j))
#define XB_XSUB(j)  (1280 + 64 * (j))
#define XB_XGEN(j)  (2304 + 64 * (j))
#define XB_TOP      3328
#define XB_TOPGEN   3392
#define XCD_BAR_WORDS 3456
#define XB_SPIN_CAP (1u << 18)
__device__ __forceinline__ unsigned xb_ld(unsigned* p)              { return __hip_atomic_load(p, __ATOMIC_RELAXED, __HIP_MEMORY_SCOPE_AGENT); }
__device__ __forceinline__ unsigned xb_add(unsigned* p, unsigned v) { return __hip_atomic_fetch_add(p, v, __ATOMIC_RELAXED, __HIP_MEMORY_SCOPE_AGENT); }
__device__ __forceinline__ unsigned xb_xcc_id() { return (unsigned)__builtin_amdgcn_s_getreg((3 << 11) | 20) & 0xFu; }
#define XB_SPIN(cond, bar) do { unsigned _sp = 0; while (cond) { __builtin_amdgcn_s_sleep(1); \
    if ((++_sp & 255u) == 0u) { if (xb_ld(&(bar)[XB_TMO])) break; if (_sp > XB_SPIN_CAP) { atomicAdd(&(bar)[XB_TMO], 1u); break; } } } } while (0)
struct XcdBarrier { unsigned* bar; unsigned x; volatile LAS unsigned* st; };
__device__ __forceinline__ XcdBarrier xcd_barrier_post(unsigned* bar, volatile LAS unsigned* st) {
    XcdBarrier b; b.bar = bar; b.x = xb_xcc_id(); b.st = st;
    if (threadIdx.x == 0) (void)xb_add(&bar[XB_XCNT(b.x)], 1u);
    return b;
}
__device__ __forceinline__ void xcd_barrier_complete(unsigned* bar, unsigned x, unsigned& nloc, unsigned& nx) {
    const unsigned G = gridDim.x * gridDim.y * gridDim.z;
    unsigned sum, cnt, mine, sp = 0u;
    for (;;) {
        sum = 0u; cnt = 0u; mine = 0u;
#pragma unroll
        for (unsigned j = 0; j < 16; ++j) { const unsigned c = xb_ld(&bar[XB_XCNT(j)]); sum += c; cnt += (c > 0u) ? 1u : 0u; mine = (j == x) ? c : mine; }
        if (sum == G) break;
        __builtin_amdgcn_s_sleep(1);
        if ((++sp & 255u) == 0u) { if (xb_ld(&bar[XB_TMO])) break; if (sp > XB_SPIN_CAP) { atomicAdd(&bar[XB_TMO], 1u); break; } }
    }
    nloc = mine > 0u ? mine : 1u; nx = cnt > 0u ? cnt : 1u;
}
__device__ __forceinline__ void xcd_barrier(const XcdBarrier& b) {
    asm volatile("s_waitcnt vmcnt(0)" ::: "memory");
    __syncthreads();
    if (threadIdx.x == 0) {
        unsigned* bar = b.bar;
        __builtin_amdgcn_s_waitcnt(0);
        unsigned nloc = b.st[0], nx = b.st[1];
        if (nloc == 0u) { xcd_barrier_complete(bar, b.x, nloc, nx); b.st[0] = nloc; b.st[1] = nx; }
        const unsigned old = xb_add(&bar[XB_XSUB(b.x)], 1u);
        const unsigned gen = old / nloc;
        if (old + 1u == (gen + 1u) * nloc) {
            __builtin_amdgcn_fence(__ATOMIC_RELEASE, "agent");
            asm volatile("s_waitcnt vmcnt(0)" ::: "memory");
            const unsigned og = xb_add(&bar[XB_TOP], 1u);
            const unsigned tg = og / nx;
            if (og + 1u == (tg + 1u) * nx) xb_add(&bar[XB_TOPGEN], 1u);
            else XB_SPIN(xb_ld(&bar[XB_TOPGEN]) == tg, bar);
            __builtin_amdgcn_fence(__ATOMIC_ACQUIRE, "agent");
            xb_add(&bar[XB_XGEN(b.x)], 1u);
            asm volatile("s_waitcnt vmcnt(0)" ::: "memory");
        } else {
            XB_SPIN(xb_ld(&bar[XB_XGEN(b.x)]) == gen, bar);
            __builtin_amdgcn_fence(__ATOMIC_ACQUIRE, "agent");
            asm volatile("s_waitcnt vmcnt(0)" ::: "memory");
        }
    }
    __syncthreads();
}

constexpr int NWAVES = 8, NPHASE = 11;
struct Args { const float* in[22]; float* out; unsigned char* ws; int ph_lo, ph_hi; };
struct Frame {
    LAS unsigned char* lds; volatile LAS unsigned* MISC; unsigned* ctl;
    int tid, lane, wave, vcu, G;
};

template <class RM, bool WTHROUGH = false>
__device__ __forceinline__ void tr_item(const float* W, int N, int k0, int nsrc0, bf16_t* WT, int ldw, int kdst, const RM& rowmap, LAS float* scr, int lane) {
    const int lr = lane >> 4, lc = (lane & 15) * 4;
#pragma unroll 4
    for (int i = 0; i < 16; ++i) { const int kk = 4 * i + lr; const f32x4 v = *(const f32x4*)(W + (size_t)(k0 + kk) * N + nsrc0 + lc);
        scr[kk * 65 + lc] = v[0]; scr[kk * 65 + lc + 1] = v[1]; scr[kk * 65 + lc + 2] = v[2]; scr[kk * 65 + lc + 3] = v[3]; }
    LDS_WAIT(); asm volatile("" ::: "memory");
    const int c = lane & 7;
#pragma unroll
    for (int j = 0; j < 8; ++j) { const int n = (lane >> 3) + 8 * j; const LAS float* s = scr + (8 * c) * 65 + n;
        u32x4 o; o.x = cvt_pk_bf16(s[0 * 65], s[1 * 65]); o.y = cvt_pk_bf16(s[2 * 65], s[3 * 65]); o.z = cvt_pk_bf16(s[4 * 65], s[5 * 65]); o.w = cvt_pk_bf16(s[6 * 65], s[7 * 65]);
        if (WTHROUGH) pg8::store16_wt(WT + (size_t)rowmap(nsrc0 + n) * ldw + kdst + k0 + 8 * c, o); else *(u32x4*)(WT + (size_t)rowmap(nsrc0 + n) * ldw + kdst + k0 + 8 * c) = o; }
    LDS_WAIT(); asm volatile("" ::: "memory");
}
struct RmId { __device__ __forceinline__ int operator()(int c) const { return c; } };
struct RmIn { __device__ __forceinline__ int operator()(int c) const {
        if (c < 2048) { const int jj = c & 127, j6 = jj & 63; return (c & ~127) + 8 * (j6 >> 2) + (jj >= 64 ? 4 : 0) + (j6 & 3); }
        return c < 6144 ? c : c - 8; } };
struct RmGate { int up; __device__ __forceinline__ int operator()(int c) const { return 256 * (c >> 7) + 128 * up + (c & 127); } };

__device__ __forceinline__ att::BlockRef mk_ref(int item, int jlo, const bf16_t* QKV, bf16_t* OD, bf16_t* ACAT, const float* FBIAS, const float* ZEROB) {
    att::BlockRef r; const int qb = 31 - item / 24, u = item % 24; int hq, hk, hv;
    if (u < 16) { const int m = u >> 1, c = u & 1; hq = m; hk = 8 + m; hv = 16 + (m >> 1) * 2 + c; r.B = ZEROB; r.O = (att::bf16*)OD + ((size_t)u * S + qb * 256) * 128; r.ostride = 128; }
    else { const int h = u - 16; hq = 24 + h; hk = 32 + h; hv = 40 + h; r.B = FBIAS + (size_t)h * S; r.O = (att::bf16*)ACAT + (size_t)(qb * 256) * DM + 1024 + h * 128; r.ostride = DM; }
    r.Q = (const att::bf16*)QKV + (size_t)hq * QUS + (size_t)(qb * 256) * 128; r.K = (const att::bf16*)QKV + (size_t)hk * QUS + (size_t)(jlo * 64) * 128; r.V = (const att::bf16*)QKV + (size_t)hv * QUS + (size_t)(jlo * 64) * 128; r.B += jlo * 64; r.P0 = qb * 256; r.jlo = jlo; return r;
}
__global__ void __launch_bounds__(NWAVES * 64, 2) mk_fwd(Args args) {
    extern __shared__ __attribute__((aligned(16))) unsigned char lds[];
    Frame F;
    F.lds = (LAS unsigned char*)lds;
    F.MISC = (volatile LAS unsigned*)(F.lds + MISC_OFF);
    F.tid = threadIdx.x; F.lane = F.tid & 63; F.wave = __builtin_amdgcn_readfirstlane(F.tid >> 6);
    F.G = gridDim.x; { const int bx = blockIdx.x; F.vcu = (F.G % 8 == 0) ? (bx % 8) * (F.G / 8) + bx / 8 : bx; }
    unsigned char* ws = args.ws;
    F.ctl = (unsigned*)(ws + WS_CTL);
    const float* x = args.in[0]; const float* w_in = args.in[1]; const float* b_forget = args.in[2];
    const float* lq1 = args.in[3]; const float* lk1 = args.in[4]; const float* lq2 = args.in[5]; const float* lk2 = args.in[6];
    const float* dng = args.in[7]; const float* wpd = args.in[8]; const float* wpf = args.in[9]; const float* wout = args.in[10];
    const float* ln1g = args.in[11]; const float* ln1b = args.in[12]; const float* wrg = args.in[13]; const float* brg = args.in[14];
    const float* wre = args.in[15]; const float* bre = args.in[16]; const float* wgate = args.in[17]; const float* wup = args.in[18];
    const float* wdown = args.in[19]; const float* ln2g = args.in[20]; const float* ln2b = args.in[21];
    float* FLOG = (float*)(ws + WS_FLOG); float* FBIAS = (float*)(ws + WS_FBIAS); float* ZEROB = (float*)(ws + WS_ZEROB); float* WRT = (float*)(ws + WS_WRT);
    float* NPB = (float*)(ws + WS_NP);
    int* TOKINFO = (int*)(ws + WS_TOKINFO); int* LIST = (int*)(ws + WS_LIST); float* ROPE = (float*)(ws + WS_ROPE);
    bf16_t* WPC = (bf16_t*)(ws + WS_WPC); bf16_t* WOUT = (bf16_t*)(ws + WS_WOUT); bf16_t* WIN = (bf16_t*)(ws + WS_WIN); bf16_t* WGU = (bf16_t*)(ws + WS_WGU); bf16_t* WD = (bf16_t*)(ws + WS_WD);
    bf16_t* QKV = (bf16_t*)(ws + WS_QKV); bf16_t* GB = (bf16_t*)(ws + WS_G); bf16_t* XB = (bf16_t*)(ws + WS_XB); bf16_t* OD = (bf16_t*)(ws + WS_OD); bf16_t* ACAT = (bf16_t*)(ws + WS_ACAT);
    bf16_t* MB = (bf16_t*)(ws + WS_MB); float* Z = (float*)(ws + WS_Z); bf16_t* X1B = (bf16_t*)(ws + WS_X1B); bf16_t* HB = (bf16_t*)(ws + WS_H); bf16_t* YB = (bf16_t*)(ws + WS_Y);

    for (int u = F.tid; u < (LDS_BYTES - LDSCTL_OFF) / 4; u += NWAVES * 64) ((LAS unsigned*)(F.lds + LDSCTL_OFF))[u] = 0u;
    __syncthreads();
    XcdBarrier bar; bar.bar = F.ctl + CW_BAR; bar.x = 0; bar.st = nullptr;
    if (MK_N_LAUNCHES == 1) bar = xcd_barrier_post(F.ctl + CW_BAR, F.MISC + 8);
    const int lo = args.ph_lo, hi = args.ph_hi; constexpr int rep = 0;
#define FRESH() do { int t_ = threadIdx.x; asm volatile("" : "+v"(t_)); F.tid = t_; F.lane = t_ & 63; F.wave = __builtin_amdgcn_readfirstlane(t_ >> 6); } while (0)
#define IN(k) ((((PH_MASK) >> (k)) & 1) && lo <= (k) && (k) < hi)
#if PROBE_SEL >= 0
    unsigned long long* stamps = (unsigned long long*)(ws + WS_CTL + 512 * KiB) + (size_t)blockIdx.x * 32;
#define STAMP(i) do { if (threadIdx.x == 0) stamps[i] = __builtin_amdgcn_s_memrealtime(); } while (0)
#else
#define STAMP(i) do { } while (0)
#endif
#define SEAM(k) do { STAMP(2 * (k) + 1); if (IN(k) && IN((k) + 1)) xcd_barrier(bar); STAMP(2 * (k) + 2); } while (0)
#define gw (F.vcu * NWAVES + F.wave)
#define BG_BATCH(b_) do { const int r_ = (int)(b_) * 8 + F.wave, e_ = r_ >> 9, up_ = (r_ >> 8) & 1, q_ = r_ & 255;                                               \
        tr_item<RmGate, true>((up_ ? wup : wgate) + (size_t)e_ * DM * FF, FF, 64 * (q_ >> 3), 64 * (q_ & 7), WGU + (size_t)e_ * 1024 * DM, DM, 0, RmGate{up_}, (LAS float*)(F.lds + F.wave * 16640), F.lane); \
        VM_WAIT(); __syncthreads();                                                                                                                                  \
        if (F.tid == 0) (void)__hip_atomic_fetch_add(F.ctl + CW_GD + e_, 1u, RLX_AGENT); } while (0)
    const int NGW = F.G * NWAVES;
    LAS int* sm_rowidx = (LAS int*)(F.lds + SM_OFF); LAS int* sm_pre = sm_rowidx + 256; LAS int* sm_cnt = sm_pre + 40;

    STAMP(0);
    if (IN(0)) {
        FRESH();
        LAS float* scr = (LAS float*)(F.lds + F.wave * 16640);
        constexpr int I_IN = 32 * 160, I_P = 16 * 32, I_O = 32 * 32, I_E = 32 * 256, NITEMS = I_IN + 2 * I_P + I_O;
        for (int it = gw; it < NITEMS; it += NGW) {
            int r = it;
            if (r < I_IN) { const int kb = r / 160, nb = r % 160; tr_item(w_in, INC, 64 * kb, 64 * nb + (nb >= 96 ? 8 : 0), WIN, DM, 0, RmIn{}, scr, F.lane); continue; } r -= I_IN;
            if (r < I_P) { tr_item(wpd, DM, 64 * (r / 32), 64 * (r % 32), WPC, DM, 0, RmId{}, scr, F.lane); continue; } r -= I_P;
            if (r < I_P) { tr_item(wpf, DM, 64 * (r / 32), 64 * (r % 32), WPC, DM, 1024, RmId{}, scr, F.lane); continue; } r -= I_P;
            if (r < I_O) { tr_item(wout, DM, 64 * (r / 32), 64 * (r % 32), WOUT, DM, 0, RmId{}, scr, F.lane); continue; } r -= I_O;
        }
        const int gt = F.vcu * (NWAVES * 64) + F.tid, NGT = F.G * NWAVES * 64;
        for (int i = gt; i < S * 64; i += NGT) { const int pos = i >> 6, j = i & 63; const double ang = (double)pos * pow(10000.0, -(double)j / 64.0);
            ROPE[(size_t)pos * 128 + j] = (float)cos(ang); ROPE[(size_t)pos * 128 + 64 + j] = (float)sin(ang); }
        for (int i = gt; i < 36 * DM; i += NGT) { const int c = i / DM, k = i % DM; WRT[i] = c < 4 ? wrg[k * 4 + c] : wre[((size_t)((c - 4) >> 3) * DM + k) * 8 + ((c - 4) & 7)]; }
        for (int i = gt; i < S; i += NGT) ZEROB[i] = 0.f;
        __syncthreads();
        { LAS float* Wf = (LAS float*)F.lds;
          for (int i = F.tid; i < DM * 2; i += NWAVES * 64) { const int k = i >> 1, h4 = (i & 1) * 4; const f32x4 v = *(const f32x4*)(w_in + (size_t)k * INC + 6144 + h4);
              Wf[(h4 + 0) * DM + k] = v[0]; Wf[(h4 + 1) * DM + k] = v[1]; Wf[(h4 + 2) * DM + k] = v[2]; Wf[(h4 + 3) * DM + k] = v[3]; }
          __syncthreads();
          for (int m = gw; m < S; m += NGW) {
              const f32x4* xr = (const f32x4*)(x + (size_t)m * DM) + F.lane; f32x4 v[8];
#pragma unroll
              for (int j = 0; j < 8; ++j) v[j] = xr[64 * j];
              u32x2* o8 = (u32x2*)(XB + (size_t)m * DM) + F.lane;
#pragma unroll
              for (int j = 0; j < 8; ++j) { u32x2 w; w.x = cvt_pk_bf16(v[j][0], v[j][1]); w.y = cvt_pk_bf16(v[j][2], v[j][3]); o8[64 * j] = w; }
              float fl[8];
#pragma unroll
              for (int c = 0; c < 8; ++c) { float a = 0.f;
#pragma unroll
                  for (int j = 0; j < 8; ++j) { const f32x4 w = *(const LAS f32x4*)(Wf + c * DM + 256 * j + 4 * F.lane); a = fmaf(v[j][0], w[0], fmaf(v[j][1], w[1], fmaf(v[j][2], w[2], fmaf(v[j][3], w[3], a)))); }
                  asm volatile("" ::: "memory");
                  fl[c] = wave_sum(a); asm volatile("" : "+v"(fl[c])); }
              if (F.lane == 0) { *(f32x4*)(FLOG + (size_t)m * 8) = (f32x4){fl[0], fl[1], fl[2], fl[3]}; *(f32x4*)(FLOG + (size_t)m * 8 + 4) = (f32x4){fl[4], fl[5], fl[6], fl[7]}; }
          }
          __syncthreads();
        }
    }
    SEAM(0);

    if (IN(1)) {
        FRESH();
        if (F.vcu < 8) {
            const int h = F.vcu; LAS double* part = (LAS double*)F.lds; const double b = (double)b_forget[h];
            double ls[16]; double run = 0.0;
#pragma unroll
            for (int i = 0; i < 16; ++i) { const double z = (double)FLOG[(size_t)(F.tid * 16 + i) * 8 + h] + b; run += (z < 0.0 ? z : 0.0) - log1p(exp(-fabs(z))); ls[i] = run; }
            part[F.tid] = run; __syncthreads();
            if (F.tid == 0) { double a = 0.0; for (int i = 0; i < NWAVES * 64; ++i) { const double t = part[i]; part[i] = a; a += t; } }
            __syncthreads();
            const double off = part[F.tid];
#pragma unroll
            for (int i = 0; i < 16; ++i) FBIAS[(size_t)h * S + F.tid * 16 + i] = (float)(-(off + ls[i]) * (double)INV_SCALE);
            __syncthreads();
        }
        pg8::Gemm g{XB, WIN, DM, DM, DM, nullptr}; pg8::StaticOrder So; So.init(S, NIN, F.G, (int)blockIdx.x);
        pg8::EpiInProj E{QKV, GB, ROPE, NPB};
        pg8::gemm_phase<pg8::EpiInProj, pg8::StaticOrder, false>(F.lds + RING_OFF, g, So, E);
    }
    SEAM(1);

    if (IN(2)) {
        FRESH();
        constexpr int NITEM = 24 * 32;
#pragma nounroll
        for (int pass = 0; pass < 2; ++pass) {
        { att::DQueue dq{F.ctl + CW_ATTQ + 64 * (8 + 8 * pass), F.MISC + 22, (const att::bf16*)QKV, (att::bf16*)OD, (int)bar.x, PROBE_SEL >= 0 ? (unsigned long long*)(ws + WS_CTL + 512 * KiB) + (size_t)blockIdx.x * 32 : nullptr, pass};
          if (F.wave < 4) att::dattn_S((char*)lds, dq); else att::dattn_V((char*)lds, dq);
          VM_WAIT(); __syncthreads();
        }
        if (pass == 0) {
        STAMP(22);
        #define ref(item, jl) mk_ref((item), (jl), QKV, OD, ACAT, FBIAS, ZEROB)
        int slot = 0;
#define FETCH(dst, dstj) do { if (F.wave == 0) { unsigned v_ = 0; if (F.lane == 0) { const unsigned i_ = __hip_atomic_fetch_add(F.ctl + CW_ATTQ + 64 * rep, 1u, RLX_AGENT); v_ = i_ < 256u ? (i_ & 31u) * 24u + 16u + F.MISC[24 + ((i_ >> 5) & 7u)] : (unsigned)NITEM; } const int it_ = (int)__builtin_amdgcn_readfirstlane(v_); int jl_ = 0; \
        if (it_ < NITEM && (it_ % 24) >= 16) { const int h_ = it_ % 24 - 16, qb_ = 31 - it_ / 24, nt_ = 4 * qb_ + 4; const float* Bh_ = FBIAS + (size_t)h_ * S; \
            float qn_ = 0.f, kd_ = 0.f; \
            for (int d_ = 0; d_ < 4; ++d_) { const f32x4 a_ = *(const f32x4*)(NPB + ((size_t)h_ * 128 + 4 * qb_ + d_) * 4), b_ = *(const f32x4*)(NPB + ((size_t)(8 + h_) * 128 + 4 * qb_ + d_) * 4); \
                qn_ = fmaxf(qn_, (a_[0] + a_[1]) + (a_[2] + a_[3])); kd_ = fmaxf(kd_, (b_[0] + b_[1]) + (b_[2] + b_[3])); } \
            qn_ = sqrtf(qn_) * 1.005f; kd_ = sqrtf(kd_) * 1.005f; \
            const float lowm_ = -qn_ * kd_ * 1.0001f + Bh_[qb_ * 256]; int first_ = nt_; \
            for (int c_ = 0; c_ < 2; ++c_) { const int t_ = c_ * 64 + F.lane; bool keep_ = true; \
                if (t_ < nt_) { const f32x4 b_ = *(const f32x4*)(NPB + ((size_t)(8 + h_) * 128 + t_) * 4); const float kn_ = sqrtf((b_[0] + b_[1]) + (b_[2] + b_[3])) * 1.005f; keep_ = !(qn_ * kn_ * 1.0001f + Bh_[64 * t_ + 63] - lowm_ < -FOX_THR_RAW); } else keep_ = (t_ == nt_); \
                const unsigned long long bm_ = __ballot(keep_ && t_ <= nt_); if (bm_ && first_ == nt_) first_ = c_ * 64 + (int)__builtin_ctzll(bm_); } \
            jl_ = first_ & ~1; if (jl_ > nt_ - 4) jl_ = nt_ - 4; if (jl_ < 0) jl_ = 0; } \
        if (F.lane == 0) { F.MISC[16 + slot] = (unsigned)it_; F.MISC[18 + slot] = (unsigned)jl_; } } \
        __syncthreads(); dst = __builtin_amdgcn_readfirstlane((int)F.MISC[16 + slot]); dstj = __builtin_amdgcn_readfirstlane((int)F.MISC[18 + slot]); slot ^= 1; } while (0)
        if (F.tid < 8) { const float mine_ = b_forget[F.tid]; int rk_ = 0;
            for (int h2 = 0; h2 < 8; ++h2) { const float o_ = b_forget[h2]; rk_ += (o_ > mine_ || (o_ == mine_ && h2 < F.tid)) ? 1 : 0; }
            F.MISC[24 + rk_] = (unsigned)F.tid; }
        __syncthreads();
        { att::Seam Sm;
          for (;;) {
            int item, jl; FETCH(item, jl);
            if (item >= NITEM) break;
            const att::BlockRef cur = ref(item, jl);
            att::attn_prime(cur, (char*)lds, F.lds, Sm);
            att::attn_block(cur, cur, (char*)lds, F.lds, Sm);
          } }
        VM_WAIT(); __syncthreads();
#undef FETCH
#undef ref
        STAMP(24 + 4);
        }
        }
        { FRESH(); if (F.tid == 0) (void)__hip_atomic_fetch_add(F.ctl + CW_AD, 1u, RLX_AGENT); int sl = 0;
          for (;;) { if (F.tid == 0) { unsigned b = 0xFFFFFFFFu; if (__hip_atomic_load(F.ctl + CW_AD, RLX_AGENT) < (unsigned)F.G) b = __hip_atomic_fetch_add(F.ctl + CW_BG, 1u, RLX_AGENT); F.MISC[20 + sl] = b; }
              __syncthreads(); const unsigned b = F.MISC[20 + sl]; sl ^= 1; if (b >= 2048u) break; BG_BATCH(b); } }
    }
    SEAM(2);

    if (IN(3)) {
        FRESH();
        float a = lq1[F.lane] * lk1[F.lane] + lq1[F.lane + 64] * lk1[F.lane + 64], b = lq2[F.lane] * lk2[F.lane] + lq2[F.lane + 64] * lk2[F.lane + 64];
        const float lam = __expf(wave_sum(a)) - __expf(wave_sum(b)) + LAM_INIT;
        const int c = F.lane >> 5, dd = (F.lane & 31) * 4;
        for (int p = gw; p < S * 4; p += NGW) { const int s = p >> 2, h = p & 3;
            const u32x2 w1 = *(const u32x2*)(OD + ((size_t)(4 * h + c) * S + s) * 128 + dd), w2 = *(const u32x2*)(OD + ((size_t)(4 * h + 2 + c) * S + s) * 128 + dd);
            const f32x4 o1 = {bf_lo(w1.x), bf_hi(w1.x), bf_lo(w1.y), bf_hi(w1.y)}, o2 = {bf_lo(w2.x), bf_hi(w2.x), bf_lo(w2.y), bf_hi(w2.y)};
            const f32x4 v = o1 - o2 * lam;
            const float ss = wave_sum(v[0] * v[0] + v[1] * v[1] + v[2] * v[2] + v[3] * v[3]);
            const float r = rsqrtf(ss * (1.f / 256.f) + LN_EPS) * (1.f - LAM_INIT);
            const f32x4 gg = *(const f32x4*)(dng + h * 256 + 4 * F.lane);
            u32x2 w; w.x = cvt_pk_bf16(v[0] * r * gg[0], v[1] * r * gg[1]); w.y = cvt_pk_bf16(v[2] * r * gg[2], v[3] * r * gg[3]);
            *(u32x2*)(ACAT + (size_t)s * DM + h * 256 + 4 * F.lane) = w; }
    }
    SEAM(3);

    if (IN(4)) {
        pg8::Gemm g{ACAT, WPC, DM, DM, DM, nullptr}; pg8::StaticOrder So; So.init(S, DM, F.G, (int)blockIdx.x);
        pg8::EpiGateHook E{GB, MB};
        pg8::gemm_phase<pg8::EpiGateHook, pg8::StaticOrder, false, true>(F.lds + RING_OFF, g, So, E);
    }
    STAMP(9); if (IN(4) && IN(6)) xcd_barrier(bar); STAMP(10);

    if (IN(6)) {
        pg8::Gemm g{MB, WOUT, DM, DM, DM, nullptr};
        pg8::StaticOrder So; So.init(S, DM, F.G, (int)blockIdx.x);
        pg8::EpiZ E{X1B};
        pg8::gemm_phase<pg8::EpiZ, pg8::StaticOrder, false>(F.lds + RING_OFF, g, So, E);
    }
    SEAM(6);

    if (IN(7)) {
        FRESH();
        unsigned* ecnt = F.ctl + CW_ECNT + rep * 2048; int* LISTr = rep ? (int*)(ws + WS_H) : LIST; int* TOKr = rep ? (int*)(ws + WS_H + 2 * MiB) : TOKINFO; float* Zw = rep ? (float*)(ws + WS_Y) : Z; bf16_t* X1Bw = rep ? (bf16_t*)(ws + WS_Y + 64 * MiB) : X1B;
        LAS float* Wl = (LAS float*)F.lds;
        LAS float* Lw = (LAS float*)(F.lds + 81920) + F.wave * 128;
#pragma unroll 1
        for (int pr = 0; pr < 2; ++pr) {
            const int rowA = gw * 4 + 2 * pr;
            f32x4 xa[8], xb[8];
            {
                const u32x2* za = (const u32x2*)(XB + (size_t)rowA * DM) + F.lane; const u32x2* zb = za + DM / 4;
                const u32x2* ya = (const u32x2*)(X1B + (size_t)rowA * DM) + F.lane; const u32x2* yb = ya + DM / 4;
                float sa = 0.f, sb = 0.f;
#pragma unroll
                for (int j = 0; j < 8; ++j) { const u32x2 wa_ = ya[64 * j], wb_ = yb[64 * j], xa_ = za[64 * j], xb_ = zb[64 * j];
                    xa[j] = (f32x4){bf_lo(xa_.x), bf_hi(xa_.x), bf_lo(xa_.y), bf_hi(xa_.y)} * ALPHA + (f32x4){bf_lo(wa_.x), bf_hi(wa_.x), bf_lo(wa_.y), bf_hi(wa_.y)}; xb[j] = (f32x4){bf_lo(xb_.x), bf_hi(xb_.x), bf_lo(xb_.y), bf_hi(xb_.y)} * ALPHA + (f32x4){bf_lo(wb_.x), bf_hi(wb_.x), bf_lo(wb_.y), bf_hi(wb_.y)}; sa += (xa[j][0] + xa[j][1]) + (xa[j][2] + xa[j][3]); sb += (xb[j][0] + xb[j][1]) + (xb[j][2] + xb[j][3]); }
                const float ma = wave_sum(sa) * (1.f / DM), mb = wave_sum(sb) * (1.f / DM); float qa = 0.f, qb = 0.f;
#pragma unroll
                for (int j = 0; j < 8; ++j) { xa[j] = xa[j] - ma; xb[j] = xb[j] - mb; qa += (xa[j][0] * xa[j][0] + xa[j][1] * xa[j][1]) + (xa[j][2] * xa[j][2] + xa[j][3] * xa[j][3]);
                    qb += (xb[j][0] * xb[j][0] + xb[j][1] * xb[j][1]) + (xb[j][2] * xb[j][2] + xb[j][3] * xb[j][3]); }
                const float ra = rsqrtf(wave_sum(qa) * (1.f / DM) + LN_EPS), rb = rsqrtf(wave_sum(qb) * (1.f / DM) + LN_EPS);
                u32x2* ha = (u32x2*)(X1Bw + (size_t)rowA * DM) + F.lane; u32x2* hb = ha + DM / 4;
#pragma unroll
                for (int j = 0; j < 8; ++j) { const f32x4 gg = *((const f32x4*)ln1g + F.lane + 64 * j), bb = *((const f32x4*)ln1b + F.lane + 64 * j);
                    xa[j] = xa[j] * ra * gg + bb; xb[j] = xb[j] * rb * gg + bb;
                    u32x2 w; w.x = cvt_pk_bf16(xa[j][0], xa[j][1]); w.y = cvt_pk_bf16(xa[j][2], xa[j][3]); ha[64 * j] = w;
                    w.x = cvt_pk_bf16(xb[j][0], xb[j][1]); w.y = cvt_pk_bf16(xb[j][2], xb[j][3]); hb[64 * j] = w; }
            }
            float la[36], lb[36];
#pragma unroll
            for (int c = 0; c < 36; ++c) { la[c] = 0.f; lb[c] = 0.f; }
#define P7_STAGE(j, b) do { unsigned lo_ = (unsigned)F.lane * 16u; asm volatile("" : "+v"(lo_)); _Pragma("unroll") for (int n_ = 0; n_ < 5; ++n_) { const int c_ = F.wave + 8 * n_; if (c_ < 36) { \
        const char* ub_ = (const char*)(WRT + (size_t)c_ * DM + 256 * (j)); __builtin_amdgcn_global_load_lds((const unsigned*)(ub_ + lo_), (LAS unsigned*)(Wl + (b) * 9216 + c_ * 256), 16, 0, 0); } } } while (0)
#define P7_COMMIT(b) do { VM_WAIT(); } while (0)
            __syncthreads();
            P7_STAGE(0, 0); P7_COMMIT(0); __syncthreads();
#pragma unroll
            for (int j = 0; j < 8; ++j) {
                if (j + 1 < 8) P7_STAGE(j + 1, (j + 1) & 1);
                const LAS float* Wb = Wl + (j & 1) * 9216;
#pragma unroll
                for (int cg = 0; cg < 9; ++cg) { f32x4 w[4];
#pragma unroll
                    for (int q = 0; q < 4; ++q) w[q] = *(const LAS f32x4*)(Wb + (4 * cg + q) * 256 + 4 * F.lane);
                    asm volatile("" ::: "memory");
#pragma unroll
                    for (int q = 0; q < 4; ++q) { const int c = 4 * cg + q;
                        la[c] = fmaf(xa[j][0], w[q][0], fmaf(xa[j][1], w[q][1], fmaf(xa[j][2], w[q][2], fmaf(xa[j][3], w[q][3], la[c]))));
                        lb[c] = fmaf(xb[j][0], w[q][0], fmaf(xb[j][1], w[q][1], fmaf(xb[j][2], w[q][2], fmaf(xb[j][3], w[q][3], lb[c]))));
                        asm volatile("" : "+v"(la[c]), "+v"(lb[c])); }
                    asm volatile("" ::: "memory"); __builtin_amdgcn_sched_barrier(0); }
                if (j + 1 < 8) { P7_COMMIT((j + 1) & 1); __syncthreads(); }
                __builtin_amdgcn_sched_barrier(0);
            }
#undef P7_STAGE
#undef P7_COMMIT
#pragma unroll
            for (int c = 0; c < 36; ++c) { la[c] = wave_sum(la[c]); lb[c] = wave_sum(lb[c]); asm volatile("" : "+v"(la[c]), "+v"(lb[c])); }
            if (F.lane == 0) {
#pragma unroll
                for (int c = 0; c < 36; ++c) { Lw[c] = la[c]; Lw[64 + c] = lb[c]; } }
            LDS_WAIT(); asm volatile("" ::: "memory");
            if (F.lane < 2) {
                const LAS float* L = Lw + 64 * F.lane; const int tok = rowA + F.lane;
                int g = 0; float gm = L[0] + brg[0];
                for (int c = 1; c < 4; ++c) { const float v = L[c] + brg[c]; if (v > gm) { gm = v; g = c; } }
                float den = 0.f;
                for (int c = 0; c < 4; ++c) den += expf(L[c] + brg[c] - gm);
                const float top_gp = 1.f / den;
                int e1 = 0; float l1 = L[4 + g * 8] + bre[g * 8];
                for (int e = 1; e < 8; ++e) { const float v = L[4 + g * 8 + e] + bre[g * 8 + e]; if (v > l1) { l1 = v; e1 = e; } }
                int e2 = 0; float l2 = -INFINITY;
                for (int e = 0; e < 8; ++e) { const float v = L[4 + g * 8 + e] + bre[g * 8 + e]; if (e != e1 && v > l2) { l2 = v; e2 = e; } }
                const float w1 = 1.f / (1.f + expf(l2 - l1));
                const int ea = g * 8 + e1, eb = g * 8 + e2;
                const int pa = (int)__hip_atomic_fetch_add(ecnt + 64 * ea, 1u, RLX_AGENT), pb = (int)__hip_atomic_fetch_add(ecnt + 64 * eb, 1u, RLX_AGENT);
                LISTr[(size_t)ea * S + pa] = tok; LISTr[(size_t)eb * S + pb] = tok;
                int* ti = TOKr + (size_t)tok * 8; ti[0] = ea; ti[1] = pa; ti[2] = __float_as_int(top_gp * w1); ti[3] = eb; ti[4] = pb; ti[5] = __float_as_int(top_gp * (1.f - w1));
            }
            asm volatile("" ::: "memory");
        }
    }
    SEAM(7);

    if (IN(8) || IN(9) || IN(10)) {
        FRESH();
        if (F.tid < 32) { const int c = (int)__hip_atomic_load(F.ctl + CW_ECNT + 64 * F.tid, RLX_AGENT); sm_cnt[F.tid] = c; }
        __syncthreads();
        if (F.tid == 0) { int a = 0; for (int e = 0; e < NEXP; ++e) { sm_pre[e] = a; a += (sm_cnt[e] + 255) >> 8; } sm_pre[32] = a; }
        __syncthreads();
    }
    if (IN(8)) {
        FRESH();
        const int ntile = sm_pre[32], n8 = ntile * 4, n9 = ntile * 8, NB = 1024, total = n8 + NB + n9;
        unsigned* mq = F.ctl + CW_DQ; unsigned* tdone = F.ctl + CW_TD; unsigned* cdone = F.ctl + CW_CD;
        LAS float* scr = (LAS float*)(F.lds + F.wave * 16640); int sl = 0;
        for (;;) {
            if (F.tid == 0) F.MISC[20 + sl] = __hip_atomic_fetch_add(F.ctl + CW_BG, 1u, RLX_AGENT);
            __syncthreads(); const unsigned b = F.MISC[20 + sl]; sl ^= 1; if (b >= 2048u) break; BG_BATCH(b); }
        const int myx = (int)(bar.x & 7u); int stage = 0, sk = 0;
        for (;;) {
            if (F.tid == 0) { unsigned code = 3u << 28;
                for (;;) {
                    if (stage == 1) { const unsigned b = __hip_atomic_fetch_add(mq, 1u, RLX_AGENT); if (b < 1024u) { code = (1u << 28) | b; break; } stage = 2; sk = 0; continue; }
                    if (sk > 7) { if (stage == 0) { stage = 1; continue; } break; }
                    const int y = (myx + sk) & 7, tb = sm_pre[4 * y], nj = (sm_pre[4 * y + 4] - tb) * 4;
                    const int v = (int)__hip_atomic_fetch_add(F.ctl + (stage == 0 ? CW_MQ8 : CW_MQ9) + 64 * y, 1u, RLX_AGENT);
                    if (v < nj) { code = (stage == 0 ? 0u : (2u << 28)) | (unsigned)(tb * 4 + v); break; }
                    ++sk; }
                F.MISC[20 + sl] = code; }
            __syncthreads(); const unsigned code = F.MISC[20 + sl]; sl ^= 1; const int kind = (int)(code >> 28), q = (int)(code & 0xFFFFFFFu);
            if (kind == 3) break;
            if (kind == 0) {
                const int mtile = q >> 2, nt4 = q & 3; int e = 0;
                for (int k = 1; k < NEXP; ++k) if (sm_pre[k] <= mtile) e = k;
                const int mt = mtile - sm_pre[e], cnt = sm_cnt[e];
                if (F.tid < 256) { int r = mt * 256 + F.tid; r = r < cnt ? r : cnt - 1; sm_rowidx[F.tid] = LIST[(size_t)e * S + r]; }
                if (F.tid == 0) { XB_SPIN(__hip_atomic_load(F.ctl + CW_GD + e, RLX_AGENT) < 64u, F.ctl + CW_BAR); __builtin_amdgcn_fence(__ATOMIC_ACQUIRE, "agent"); }
                __syncthreads();
                pg8::Gemm g{X1B, WGU + (size_t)e * 1024 * DM, DM, DM, DM, sm_rowidx}; pg8::SingleUnit Su{{mtile, nt4}};
                pg8::EpiSwiGLU E{HB};
                pg8::gemm_phase<pg8::EpiSwiGLU, pg8::SingleUnit, true>(F.lds + RING_OFF, g, Su, E);
                VM_WAIT(); __syncthreads();
                if (F.tid == 0) (void)__hip_atomic_fetch_add(tdone + mtile, 1u, RLX_AGENT);
            } else if (kind == 1) {
                const int r = q * 8 + F.wave, e = r >> 8, qq = r & 255;
                tr_item<RmId, true>(wdown + (size_t)e * FF * DM, DM, 64 * (qq >> 5), 64 * (qq & 31), WD + (size_t)e * DM * FF, FF, 0, RmId{}, scr, F.lane);
                VM_WAIT(); __syncthreads();
                if (F.tid == 0) (void)__hip_atomic_fetch_add(cdone + e, 1u, RLX_AGENT);
            } else {
                const int u = q, mtile = u >> 2; int e = 0;
                for (int k = 1; k < NEXP; ++k) if (sm_pre[k] <= mtile) e = k;
                if (F.tid == 0) {
                    XB_SPIN(__hip_atomic_load(tdone + mtile, RLX_AGENT) < 4u || __hip_atomic_load(cdone + e, RLX_AGENT) < 32u, F.ctl + CW_BAR);
                    __builtin_amdgcn_fence(__ATOMIC_ACQUIRE, "agent");
                }
                __syncthreads();
                pg8::Gemm g{HB, WD, FF, FF, FF, nullptr}; pg8::UnitRun Su{{mtile, e * 8 + (u & 3) * 2}, 2}; pg8::EpiY E{YB};
                pg8::gemm_phase<pg8::EpiY, pg8::UnitRun, false>(F.lds + RING_OFF, g, Su, E);
            }
        }
    }
    STAMP(17); STAMP(18); STAMP(19);
    if (IN(8) && IN(10)) xcd_barrier(bar);
    STAMP(20);

    if (IN(10)) {
        FRESH();
        float* out = args.out;
        for (int m = gw; m < S; m += NGW) {
            const int* ti = TOKINFO + (size_t)m * 8;
            const int ea = ti[0], pa = ti[1], eb = ti[3], pb = ti[4]; float wa = __int_as_float(ti[2]), wb = __int_as_float(ti[5]);
            const size_t ra = (size_t)sm_pre[ea] * 256 + pa, rb = (size_t)sm_pre[eb] * 256 + pb;
            const u32x2* xr = (const u32x2*)(X1B + (size_t)m * DM) + F.lane; const u32x2* ya = (const u32x2*)(YB + ra * DM) + F.lane; const u32x2* yb = (const u32x2*)(YB + rb * DM) + F.lane;
            f32x4 v[8]; float s = 0.f;
#pragma unroll
            for (int j = 0; j < 8; ++j) { const u32x2 xw = xr[64 * j]; const f32x4 xv = {bf_lo(xw.x), bf_hi(xw.x), bf_lo(xw.y), bf_hi(xw.y)}; const u32x2 a = ya[64 * j], b = yb[64 * j];
                const f32x4 fa = {bf_lo(a.x), bf_hi(a.x), bf_lo(a.y), bf_hi(a.y)}, fb = {bf_lo(b.x), bf_hi(b.x), bf_lo(b.y), bf_hi(b.y)};
                v[j] = xv * ALPHA + fa * wa + fb * wb; s += (v[j][0] + v[j][1]) + (v[j][2] + v[j][3]); }
            const float mean = wave_sum(s) * (1.f / DM); float q = 0.f;
#pragma unroll
            for (int j = 0; j < 8; ++j) { v[j] = v[j] - mean; q += (v[j][0] * v[j][0] + v[j][1] * v[j][1]) + (v[j][2] * v[j][2] + v[j][3] * v[j][3]); }
            const float rstd = rsqrtf(wave_sum(q) * (1.f / DM) + LN_EPS);
            f32x4* o = (f32x4*)(out + (size_t)m * DM) + F.lane;
#pragma unroll
            for (int j = 0; j < 8; ++j) { const f32x4 gg = *((const f32x4*)ln2g + F.lane + 64 * j), bb = *((const f32x4*)ln2b + F.lane + 64 * j); o[64 * j] = v[j] * rstd * gg + bb; }
        }
    }
    STAMP(21);
#if PROBE_SEL >= 0
    xcd_barrier(bar);
    if (blockIdx.x == 0) {
        FRESH();
        const unsigned long long* SB = (const unsigned long long*)(ws + WS_CTL + 512 * KiB);
        LAS int* red = (LAS int*)(F.lds + RING_OFF);
        const int c = F.tid & 255;
#define S_of(j) ((j) < 6 ? 2 * (j) : 2 * (j) + 2)
#define E_of(j) ((j) < 5 ? 2 * (j) + 1 : 2 * (j) + 3)
        const unsigned long long t00 = SB[0];
        long long metric = 0;
#define REDUCE(expr, AVG, MAX) do { __syncthreads(); if (F.tid < 256) red[F.tid] = (int)(expr); __syncthreads(); long long a_ = 0; int m_ = -2000000000; for (int i_ = 0; i_ < 256; ++i_) { a_ += red[i_]; m_ = red[i_] > m_ ? red[i_] : m_; } AVG = (int)(a_ / 256); MAX = m_; } while (0)
#define ST(i) ((long long)(SB[(size_t)c * 32 + (i)] - t00))
        int av, mx, av2, mx2;
        if (PROBE_SEL == 1) { for (int j = 0; j < 10; ++j) { REDUCE(ST(E_of(j)), av, mx); metric += mx - av; } }
        else if (PROBE_SEL == 2) { for (int j = 0; j < 9; ++j) { REDUCE(ST(E_of(j)), av, mx); REDUCE(ST(S_of(j + 1)), av2, mx2); metric += av2 - mx; } }
        else if (PROBE_SEL >= 10 && PROBE_SEL < 20) { const int j = PROBE_SEL - 10; REDUCE(ST(E_of(j)) - ST(S_of(j)), av, mx); metric = av; }
        else if (PROBE_SEL >= 30 && PROBE_SEL < 40) { const int j = PROBE_SEL - 30; REDUCE(ST(E_of(j)), av, mx); metric = mx - av; }
        else if (PROBE_SEL == 50) { REDUCE(ST(22) - ST(4), av, mx); metric = av; }
        else if (PROBE_SEL == 51) { REDUCE(ST(5) - ST(22), av, mx); metric = av; }
        else if (PROBE_SEL == 52) { REDUCE(ST(17) - ST(23), av, mx); metric = av; }
        else if (PROBE_SEL == 53) { REDUCE(ST(22), av, mx); metric = mx - av; }
        else if (PROBE_SEL == 54) { REDUCE(-ST(22), av, mx); metric = mx - av; }
        else if (PROBE_SEL == 55) { REDUCE(ST(22), av, mx); const int thr_ = av + 3000; REDUCE(ST(22) > thr_ ? 25600 : 0, av2, mx2); metric = av2; }
        else if (PROBE_SEL == 57) { REDUCE((ST(24) - ST(4)) * 100 / (long long)SB[(size_t)c * 32 + 25], av, mx); metric = av; }
        else if (PROBE_SEL == 58) { REDUCE((ST(24) - ST(4)) * 100 / (long long)SB[(size_t)c * 32 + 25], av, mx); metric = mx; }
        else if (PROBE_SEL == 59) { REDUCE(-((ST(24) - ST(4)) * 100 / (long long)SB[(size_t)c * 32 + 25]), av, mx); metric = -mx; }
        else if (PROBE_SEL == 61) { REDUCE(SB[(size_t)c * 32 + 26] ? (ST(26) - ST(24)) * 100 / (long long)SB[(size_t)c * 32 + 27] : 200, av, mx); metric = av; }
        else if (PROBE_SEL == 62) { REDUCE(SB[(size_t)c * 32 + 26] ? (ST(26) - ST(24)) * 100 / (long long)SB[(size_t)c * 32 + 27] : 200, av, mx); metric = mx; }
        else if (PROBE_SEL == 63) { REDUCE(SB[(size_t)c * 32 + 26] && SB[(size_t)c * 32 + 27] > 40 ? (ST(26) - ST(24)) * 100 / (long long)SB[(size_t)c * 32 + 27] : 0, av, mx); REDUCE(SB[(size_t)c * 32 + 26] && SB[(size_t)c * 32 + 27] > 40 ? 256 : 0, av2, mx2); metric = av2 > 0 ? (long long)av * 256 / av2 : 0; }
        else if (PROBE_SEL == 60) { metric = 10000; }
#undef REDUCE
#undef ST
        if (metric < 0) metric = 0;
        if (F.tid == 0) { const unsigned long long t1 = __builtin_amdgcn_s_memrealtime(); while ((long long)(__builtin_amdgcn_s_memrealtime() - t1) < metric * PROBE_AMP) __builtin_amdgcn_s_sleep(8); }
        __syncthreads();
    }
#endif
#undef IN
#undef SEAM
#undef gw
#undef FRESH
}

extern "C" void kernel_launch(void* const* d_in, const int* in_sizes, int n_in, void* d_out, int out_size, void* d_ws, size_t ws_size, hipStream_t stream) {
    static int grid = 0;
    if (grid == 0) {
        if (n_in != 22 || in_sizes[0] != S * DM || in_sizes[1] != DM * INC || out_size != S * DM || ws_size < WS_END) {
            fprintf(stderr, "kernel_launch: unexpected shapes (n_in %d, in0 %d, out %d, ws %zu); nothing launched\n", n_in, n_in > 0 ? in_sizes[0] : -1, out_size, ws_size); grid = -1; return; }
        int dev = 0, cus = 0, per_cu = 0;
        if (hipGetDevice(&dev) != hipSuccess || hipDeviceGetAttribute(&cus, hipDeviceAttributeMultiprocessorCount, dev) != hipSuccess) { fprintf(stderr, "kernel_launch: device query failed\n"); grid = -1; return; }
        if (hipFuncSetAttribute((const void*)mk_fwd, hipFuncAttributeMaxDynamicSharedMemorySize, LDS_BYTES) != hipSuccess) { fprintf(stderr, "kernel_launch: hipFuncSetAttribute failed\n"); grid = -1; return; }
        if (hipOccupancyMaxActiveBlocksPerMultiprocessor(&per_cu, (const void*)mk_fwd, NWAVES * 64, LDS_BYTES) != hipSuccess || per_cu < 1) fprintf(stderr, "kernel_launch: occupancy query reports %d\n", per_cu);
        (void)hipGetLastError();
        grid = cus;
        if (grid != 256) fprintf(stderr, "kernel_launch: %d CUs; this build assumes 256\n", grid);
    }
    if (grid < 0) return;
    (void)hipMemsetAsync((char*)d_ws + WS_CTL, 0, CTL_ZERO_BYTES, stream);
    Args a{};
    for (int i = 0; i < 22; ++i) a.in[i] = (const float*)d_in[i];
    a.out = (float*)d_out; a.ws = (unsigned char*)d_ws;
    if (MK_N_LAUNCHES == 1) { a.ph_lo = 0; a.ph_hi = NPHASE; hipLaunchKernelGGL(mk_fwd, dim3(grid), dim3(NWAVES * 64), LDS_BYTES, stream, a); }
    else { for (int p = 0; p < NPHASE; ++p) { a.ph_lo = p; a.ph_hi = p + 1; hipLaunchKernelGGL(mk_fwd, dim3(grid), dim3(NWAVES * 64), LDS_BYTES, stream, a); } }
}
```

```cpp
#include <hip/hip_runtime.h>
#ifndef PROBE_SEL
#define PROBE_SEL -1
#endif
#ifndef PROBE_AMP
#define PROBE_AMP 1
#endif
#include <hip/hip_bf16.h>
#include <cstdio>
#include <cstdint>
#include <cmath>

#ifndef PH_MASK
#define PH_MASK 0x7ff
#endif
#ifndef MK_N_LAUNCHES
#define MK_N_LAUNCHES 1
#endif

constexpr int S = 8192, DM = 2048, INC = 10248, NIN = 10240, NEXP = 32, FF = 512;
constexpr size_t QUS = (size_t)S * 128 + 40960;
constexpr float ALPHA = 1.189207115002721f;
constexpr float LN_EPS = 1e-5f;
constexpr float LAM_INIT = 0.2f;
constexpr float INV_SCALE = 11.313708498984761f;
constexpr float FOX_THR_RAW = 36.f * 11.313708498984761f;

#define LAS __attribute__((address_space(3)))
#define GAS __attribute__((address_space(1)))
typedef unsigned short bf16_t;
typedef short bf16x8 __attribute__((ext_vector_type(8)));
typedef short s16x4 __attribute__((ext_vector_type(4)));
typedef float f32x4 __attribute__((ext_vector_type(4)));
typedef float f32x2 __attribute__((ext_vector_type(2)));
typedef float f32x16 __attribute__((ext_vector_type(16)));
typedef unsigned u32x4 __attribute__((ext_vector_type(4)));
typedef unsigned u32x2 __attribute__((ext_vector_type(2)));
typedef GAS unsigned gu32;

typedef __bf16 bf16x2_t __attribute__((ext_vector_type(2)));
__device__ __forceinline__ unsigned cvt_pk_bf16(float lo, float hi) { f32x2 v = {lo, hi}; bf16x2_t b = __builtin_convertvector(v, bf16x2_t); return __builtin_bit_cast(unsigned, b); }
__device__ __forceinline__ float bf_lo(unsigned w) { return __uint_as_float(w << 16); }
__device__ __forceinline__ float bf_hi(unsigned w) { return __uint_as_float(w & 0xffff0000u); }
__device__ __forceinline__ float wave_sum(float v) {
#define WS_DPP(ctrl, rmask) v += __int_as_float(__builtin_amdgcn_update_dpp(0, __float_as_int(v), ctrl, rmask, 0xf, false))
    WS_DPP(0xB1, 0xf);
    WS_DPP(0x4E, 0xf);
    WS_DPP(0x141, 0xf);
    WS_DPP(0x140, 0xf);
    WS_DPP(0x142, 0xa);
    WS_DPP(0x143, 0xc);
#undef WS_DPP
    return __int_as_float(__builtin_amdgcn_readlane(__float_as_int(v), 63));
}

namespace pg8 {
constexpr int BM = 256, BK = 64, HALF = 128, HTB = HALF * BK * 2, STAGE_BYTES = 8 * HTB, NXCD = 8, WGM = 8;
__host__ __device__ __forceinline__ int lds_byte(int r, int c) { const int st = (r >> 4) * 2 + (c >> 5), rr = r & 15, cc = c & 31, ob = rr * 64 + cc * 2; return st * 1024 + (ob ^ (((ob >> 9) & 1) << 5)); }
__host__ __device__ __forceinline__ void stage_rc(int b, int& R, int& C) { const int st = b / 1024, sb = b % 1024, swz = sb ^ (((sb >> 9) & 1) << 5); R = (st >> 1) * 16 + swz / 64; C = (st & 1) * 32 + (swz % 64) / 2; }
__host__ __device__ __forceinline__ int perm32(int rho) { const int n = rho >> 4, i = rho & 15; return 8 * (i >> 2) + 4 * n + (i & 3); }

struct Unit { int pm, pn; };
struct Gemm { const bf16_t* A; const bf16_t* Bt; int K, lda, ldb; const LAS int* rowidx; };

struct StaticOrder {
    int nM, nN, nwg, G, c;
    __device__ void init(int M, int N, int G_, int c_) { nM = M / BM; nN = N / BM; nwg = nM * nN; G = G_; c = c_; }
    __device__ bool next(int i, Unit& u) const {
        const long L = (long)i * G + c; if (L >= nwg) return false;
        int wgid = (int)L; { const int q = nwg / NXCD, r = nwg % NXCD, xcd = wgid % NXCD, off = wgid / NXCD; wgid = (xcd < r ? xcd * (q + 1) : r * (q + 1) + (xcd - r) * q) + off; }
        const int nig = WGM * nN, gid = wgid / nig, fm = gid * WGM, gsz = (nM - fm) < WGM ? (nM - fm) : WGM;
        u.pm = fm + ((wgid % nig) % gsz); u.pn = (wgid % nig) / gsz; return true;
    }
};
struct SingleUnit { Unit u; __device__ bool next(int i, Unit& o) const { if (i) return false; o = u; return true; } };
struct UnitRun { Unit u; int n; __device__ bool next(int i, Unit& o) const { if (i >= n) return false; o.pm = u.pm; o.pn = u.pn + i; return true; } };

typedef f32x4 Acc[2][2][4][2];

template <class Epi, class Sched, bool GATHER, bool HOOK = false>
__device__ __forceinline__ void gemm_phase(LAS unsigned char* lds, const Gemm g, const Sched& S, const Epi& E) {
    int tid = threadIdx.x; asm volatile("" : "+v"(tid));
    const int wid = __builtin_amdgcn_readfirstlane(tid >> 6), lane = tid & 63, wr = wid >> 2, wc = wid & 3, fr = lane & 15, fq = lane >> 4;
    const int K = g.K, nt = K / BK;
    unsigned voffA[2], voffA1[2], voffB[2];
#pragma unroll
    for (int i = 0; i < 2; ++i) { int R, C; stage_rc(tid * 16 + i * 8192, R, C); const int Rb = (R & ~31) + perm32(R & 31);
        if constexpr (GATHER) { voffA[i] = (unsigned)(g.rowidx[R] * g.lda + C) * 2u; voffA1[i] = (unsigned)(g.rowidx[HALF + R] * g.lda + C) * 2u; }
        else { voffA[i] = (unsigned)(R * g.lda + C) * 2u; voffA1[i] = 0u; }
        voffB[i] = (unsigned)(Rb * g.ldb + C) * 2u; }
    const size_t kstep = (size_t)(BK * 2);
    const size_t hstepA = GATHER ? 0 : (size_t)HALF * g.lda * 2, hstepB = (size_t)HALF * g.ldb * 2;
    const size_t tstepA = GATHER ? 0 : 2 * hstepA, tstepB = 2 * hstepB;
    const unsigned ldsw = (unsigned)wid * 1024u;
    const int aoff = lds_byte(wr * 64 + fr, fq * 8), boff = lds_byte(wc * 32 + fr, fq * 8);
#define PG8_SA(b, h) (((b) * 2 + (h)) * HTB)
#define PG8_SB(b, h) ((4 + (b) * 2 + (h)) * HTB)
#define PG8_STAGE(bufoff, gbase, voff) do { _Pragma("unroll") for (int _i = 0; _i < 2; ++_i) \
        __builtin_amdgcn_global_load_lds((const unsigned*)((const char*)(gbase) + (voff)[_i]), (LAS unsigned*)(lds + (bufoff) + ldsw + _i * 8192), 16, 0, 0); } while (0)
#define PG8_STAGE_A0(bufoff, gbase) PG8_STAGE(bufoff, gbase, voffA)
#define PG8_STAGE_A1(bufoff, gbase) do { if constexpr (GATHER) { PG8_STAGE(bufoff, gbase, voffA1); } else { PG8_STAGE(bufoff, (gbase) + hstepA, voffA); } } while (0)
#define PG8_LDA(dst, b, h) do { _Pragma("unroll") for (int m = 0; m < 4; ++m) _Pragma("unroll") for (int k = 0; k < 2; ++k) dst[m][k] = *(const LAS bf16x8*)(lds + PG8_SA(b, h) + aoff + m * 2048 + k * 1024); } while (0)
#define PG8_LDB(dst, b, h) do { _Pragma("unroll") for (int n = 0; n < 2; ++n) _Pragma("unroll") for (int k = 0; k < 2; ++k) dst[n][k] = *(const LAS bf16x8*)(lds + PG8_SB(b, h) + boff + n * 2048 + k * 1024); } while (0)
#define PG8_MMA(ai, bj, At, Bt) do { __builtin_amdgcn_s_setprio(1); _Pragma("unroll") for (int m = 0; m < 4; ++m) _Pragma("unroll") for (int n = 0; n < 2; ++n) _Pragma("unroll") for (int k = 0; k < 2; ++k) \
        acc[ai][bj][m][n] = __builtin_amdgcn_mfma_f32_16x16x32_bf16(Bt[n][k], At[m][k], acc[ai][bj][m][n], 0, 0, 0); __builtin_amdgcn_s_setprio(0); } while (0)
#define PG8_WAIT_V(n) asm volatile("s_waitcnt vmcnt(" #n ")" ::: "memory")
#define PG8_WAIT_L(n) asm volatile("s_waitcnt lgkmcnt(" #n ")" ::: "memory")
#define PG8_BAR __builtin_amdgcn_s_barrier()
#define PG8_SCHED __builtin_amdgcn_sched_barrier(0)
    Unit cur, nxt; int ui = 0;
    if (!S.next(0, cur)) return;
    Acc acc;
#pragma unroll
    for (int a = 0; a < 2; ++a)
#pragma unroll
        for (int b = 0; b < 2; ++b)
#pragma unroll
            for (int m = 0; m < 4; ++m)
#pragma unroll
                for (int n = 0; n < 2; ++n) acc[a][b][m][n] = (f32x4){0.f, 0.f, 0.f, 0.f};
    bf16x8 At[4][2], B0[2][2], B1[2][2];
    const char* cA = (const char*)g.A + (size_t)cur.pm * tstepA; const char* cB = (const char*)g.Bt + (size_t)cur.pn * tstepB;
    PG8_STAGE(PG8_SB(0, 0), cB, voffB); PG8_STAGE(PG8_SB(0, 1), cB + hstepB, voffB); PG8_STAGE_A0(PG8_SA(0, 0), cA); PG8_STAGE_A1(PG8_SA(0, 1), cA);
    if (wr == 1) PG8_BAR;
    PG8_WAIT_V(2); PG8_BAR;
    PG8_STAGE(PG8_SB(1, 0), cB + kstep, voffB); PG8_STAGE_A0(PG8_SA(1, 0), cA + kstep); PG8_STAGE(PG8_SB(1, 1), cB + hstepB + kstep, voffB);
    PG8_WAIT_V(6); PG8_BAR;
    for (;;) {
        const bool has_next = S.next(ui + 1, nxt);
        const char* nA = has_next ? (const char*)g.A + (size_t)nxt.pm * tstepA : cA; const char* nB = has_next ? (const char*)g.Bt + (size_t)nxt.pn * tstepB : cB;
        for (int t = 0; t < nt; t += 2) {
            if constexpr (HOOK) { if (t == nt / 2) { E.hook(acc, cur, wr, wc, fr, fq); PG8_SCHED; } }
            const bool last = (t == nt - 2);
            const char* a1 = cA + (size_t)(t + 1) * kstep;
            const char* a2 = last ? nA : cA + (size_t)(t + 2) * kstep; const char* b2 = last ? nB : cB + (size_t)(t + 2) * kstep;
            const char* a3 = a2 + kstep; const char* b3 = b2 + kstep;
            PG8_LDB(B0, 0, 0); PG8_LDB(B1, 0, 1); PG8_SCHED; PG8_LDA(At, 0, 0); PG8_STAGE_A1(PG8_SA(1, 1), a1);
            PG8_WAIT_V(8); PG8_WAIT_L(0); PG8_BAR; PG8_MMA(0, 0, At, B0); PG8_MMA(0, 1, At, B1); PG8_BAR; PG8_SCHED;
            PG8_LDA(At, 0, 1); PG8_STAGE(PG8_SB(0, 0), b2, voffB); PG8_STAGE(PG8_SB(0, 1), b2 + hstepB, voffB); PG8_STAGE_A0(PG8_SA(0, 0), a2);
            PG8_WAIT_V(8); PG8_WAIT_L(0); PG8_BAR; PG8_MMA(1, 0, At, B0); PG8_MMA(1, 1, At, B1); PG8_BAR; PG8_SCHED;
            PG8_LDB(B0, 1, 0); PG8_LDB(B1, 1, 1); PG8_SCHED; PG8_LDA(At, 1, 0); PG8_STAGE_A1(PG8_SA(0, 1), a2);
            PG8_WAIT_V(8); PG8_WAIT_L(0); PG8_BAR; PG8_MMA(0, 0, At, B0); PG8_MMA(0, 1, At, B1); PG8_BAR; PG8_SCHED;
            PG8_LDA(At, 1, 1); PG8_STAGE(PG8_SB(1, 0), b3, voffB); PG8_STAGE(PG8_SB(1, 1), b3 + hstepB, voffB); PG8_STAGE_A0(PG8_SA(1, 0), a3);
            PG8_WAIT_V(8); PG8_WAIT_L(0); PG8_BAR; PG8_MMA(1, 0, At, B0); PG8_MMA(1, 1, At, B1); PG8_BAR; PG8_SCHED;
        }
        if (wr == 0) PG8_BAR;
        E(acc, cur, wr, wc, fr, fq);
        if (!has_next) break;
#pragma unroll
        for (int a = 0; a < 2; ++a)
#pragma unroll
            for (int b = 0; b < 2; ++b)
#pragma unroll
                for (int m = 0; m < 4; ++m)
#pragma unroll
                    for (int n = 0; n < 2; ++n) acc[a][b][m][n] = (f32x4){0.f, 0.f, 0.f, 0.f};
        cur = nxt; cA = nA; cB = nB; ++ui;
        if (wr == 1) PG8_BAR;
    }
    PG8_WAIT_V(0);
    PG8_BAR;
#undef PG8_SA
#undef PG8_SB
#undef PG8_STAGE
#undef PG8_STAGE_A0
#undef PG8_STAGE_A1
#undef PG8_LDA
#undef PG8_LDB
#undef PG8_MMA
#undef PG8_WAIT_V
#undef PG8_WAIT_L
#undef PG8_BAR
#undef PG8_SCHED
}

__device__ __forceinline__ void store16_wt(void* p, u32x4 v) { asm volatile("global_store_dwordx4 %0, %1, off sc1\n\ts_nop 1" :: "v"(p), "v"(v) : "memory"); }
__device__ __forceinline__ u32x4 pack8(f32x4 a, f32x4 b) { u32x4 w; w.x = cvt_pk_bf16(a[0], a[1]); w.y = cvt_pk_bf16(a[2], a[3]); w.z = cvt_pk_bf16(b[0], b[1]); w.w = cvt_pk_bf16(b[2], b[3]); return w; }
__device__ __forceinline__ f32x4 sigmoid4(f32x4 v) { f32x4 r;
#pragma unroll
    for (int i = 0; i < 4; ++i) r[i] = __builtin_amdgcn_rcpf(1.f + __builtin_amdgcn_exp2f(-1.4426950408889634f * v[i])); return r; }

struct EpiInProj {
    bf16_t* QKV; bf16_t* G; const float* rope; float* NP;
    __device__ __forceinline__ void operator()(const Acc& acc, const Unit& u, int wr, int wc, int fr, int fq) const {
        const int row0 = u.pm * BM + wr * 64 + fr;
        if (u.pn < 8) {
            const int g4 = 4 * (4 * wc + fq);
#pragma unroll
            for (int ai = 0; ai < 2; ++ai)
#pragma unroll
                for (int m = 0; m < 4; ++m) { const int r = row0 + ai * HALF + m * 16;
                    const f32x4 cs = *(const f32x4*)(rope + (size_t)r * 128 + g4), sn = *(const f32x4*)(rope + (size_t)r * 128 + 64 + g4);
#pragma unroll
                    for (int bj = 0; bj < 2; ++bj) { const f32x4 t1 = acc[ai][bj][m][0], t2 = acc[ai][bj][m][1];
                        const f32x4 o1 = t1 * cs - t2 * sn, o2 = t1 * sn + t2 * cs;
                        bf16_t* dst = QKV + (size_t)(2 * u.pn + bj) * QUS + (size_t)r * 128;
                        u32x2 w1, w2; w1.x = cvt_pk_bf16(o1[0], o1[1]); w1.y = cvt_pk_bf16(o1[2], o1[3]); w2.x = cvt_pk_bf16(o2[0], o2[1]); w2.y = cvt_pk_bf16(o2[2], o2[3]);
                        *(u32x2*)(dst + g4) = w1; *(u32x2*)(dst + 64 + g4) = w2; } }
        } else if (u.pn < 24) {
#pragma unroll
            for (int ai = 0; ai < 2; ++ai)
#pragma unroll
                for (int m = 0; m < 4; ++m) { const int r = row0 + ai * HALF + m * 16;
#pragma unroll
                    for (int bj = 0; bj < 2; ++bj) *(u32x4*)(QKV + (size_t)(2 * u.pn + bj) * QUS + (size_t)r * 128 + wc * 32 + 8 * fq) = pack8(acc[ai][bj][m][0], acc[ai][bj][m][1]); }
            if (u.pn >= 12 && u.pn < 20) {
#pragma unroll
                for (int ai = 0; ai < 2; ++ai)
#pragma unroll
                    for (int bj = 0; bj < 2; ++bj) { float mx = 0.f;
#pragma unroll
                        for (int m = 0; m < 4; ++m) { const f32x4 a = acc[ai][bj][m][0], b = acc[ai][bj][m][1];
                            float ss = (a[0] * a[0] + a[1] * a[1]) + (a[2] * a[2] + a[3] * a[3]) + (b[0] * b[0] + b[1] * b[1]) + (b[2] * b[2] + b[3] * b[3]);
                            ss += __shfl_xor(ss, 16); ss += __shfl_xor(ss, 32); mx = fmaxf(mx, ss); }
                        mx = fmaxf(mx, __shfl_xor(mx, 1)); mx = fmaxf(mx, __shfl_xor(mx, 2)); mx = fmaxf(mx, __shfl_xor(mx, 4)); mx = fmaxf(mx, __shfl_xor(mx, 8));
                        if (fr == 0 && fq == 0) NP[((size_t)(2 * u.pn + bj - 24) * 128 + 4 * u.pm + 2 * ai + wr) * 4 + wc] = mx; }
            }
        } else {
            const int col0 = (u.pn - 24) * BM + wc * 32 + 8 * fq;
#pragma unroll
            for (int ai = 0; ai < 2; ++ai)
#pragma unroll
                for (int m = 0; m < 4; ++m) { const int r = row0 + ai * HALF + m * 16;
#pragma unroll
                    for (int bj = 0; bj < 2; ++bj) *(u32x4*)(G + (size_t)r * 4096 + col0 + bj * HALF) = pack8(sigmoid4(acc[ai][bj][m][0]), sigmoid4(acc[ai][bj][m][1])); }
        }
    }
};
struct EpiGateT {
    float* T; const bf16_t* G;
    __device__ __forceinline__ void operator()(const Acc& acc, const Unit& u, int wr, int wc, int fr, int fq) const {
        const int row0 = u.pm * BM + wr * 64 + fr, col0 = u.pn * BM + wc * 32 + 8 * fq;
#pragma unroll
        for (int ai = 0; ai < 2; ++ai)
#pragma unroll
            for (int m = 0; m < 4; ++m) { const int r = row0 + ai * HALF + m * 16;
#pragma unroll
                for (int bj = 0; bj < 2; ++bj) { const int c = col0 + bj * HALF; const u32x4 gw = *(const u32x4*)(G + (size_t)r * 4096 + c);
                    const f32x4 g0 = {bf_lo(gw.x), bf_hi(gw.x), bf_lo(gw.y), bf_hi(gw.y)}, g1 = {bf_lo(gw.z), bf_hi(gw.z), bf_lo(gw.w), bf_hi(gw.w)};
                    *(f32x4*)(T + (size_t)r * DM + c) = acc[ai][bj][m][0] * g0; *(f32x4*)(T + (size_t)r * DM + c + 4) = acc[ai][bj][m][1] * g1; } }
    }
};
struct EpiGateM {
    const float* T; const bf16_t* G; bf16_t* MB;
    __device__ __forceinline__ void operator()(const Acc& acc, const Unit& u, int wr, int wc, int fr, int fq) const {
        const int row0 = u.pm * BM + wr * 64 + fr, col0 = u.pn * BM + wc * 32 + 8 * fq;
#pragma unroll
        for (int ai = 0; ai < 2; ++ai)
#pragma unroll
            for (int m = 0; m < 4; ++m) { const int r = row0 + ai * HALF + m * 16;
#pragma unroll
                for (int bj = 0; bj < 2; ++bj) { const int c = col0 + bj * HALF; const u32x4 gw = *(const u32x4*)(G + (size_t)r * 4096 + 2048 + c);
                    const f32x4 g0 = {bf_lo(gw.x), bf_hi(gw.x), bf_lo(gw.y), bf_hi(gw.y)}, g1 = {bf_lo(gw.z), bf_hi(gw.z), bf_lo(gw.w), bf_hi(gw.w)};
                    const f32x4 t0 = *(const f32x4*)(T + (size_t)r * DM + c), t1 = *(const f32x4*)(T + (size_t)r * DM + c + 4);
                    *(u32x4*)(MB + (size_t)r * DM + c) = pack8(t0 + acc[ai][bj][m][0] * g0, t1 + acc[ai][bj][m][1] * g1); } }
    }
};
struct EpiGateHook {
    const bf16_t* G; bf16_t* MB;
    __device__ __forceinline__ void hook(Acc& acc, const Unit& u, int wr, int wc, int fr, int fq) const {
        int row0 = u.pm * BM + wr * 64 + fr, col0 = u.pn * BM + wc * 32 + 8 * fq;
        asm volatile("" : "+v"(row0), "+v"(col0));
#pragma unroll
        for (int ai = 0; ai < 2; ++ai)
#pragma unroll
            for (int m = 0; m < 4; ++m) { int r = row0 + ai * HALF + m * 16; asm volatile("" : "+v"(r));
#pragma unroll
                for (int bj = 0; bj < 2; ++bj) { const int c = col0 + bj * HALF; const u32x4 gd = *(const u32x4*)(G + (size_t)r * 4096 + c), gf = *(const u32x4*)(G + (size_t)r * 4096 + 2048 + c);
                    const f32x4 d0 = {bf_lo(gd.x), bf_hi(gd.x), bf_lo(gd.y), bf_hi(gd.y)}, d1 = {bf_lo(gd.z), bf_hi(gd.z), bf_lo(gd.w), bf_hi(gd.w)};
                    f32x4 f0 = {bf_lo(gf.x), bf_hi(gf.x), bf_lo(gf.y), bf_hi(gf.y)}, f1 = {bf_lo(gf.z), bf_hi(gf.z), bf_lo(gf.w), bf_hi(gf.w)};
#pragma unroll
                    for (int i = 0; i < 4; ++i) { f0[i] = __builtin_amdgcn_rcpf(fmaxf(f0[i], 1e-30f)); f1[i] = __builtin_amdgcn_rcpf(fmaxf(f1[i], 1e-30f)); }
                    acc[ai][bj][m][0] = acc[ai][bj][m][0] * (d0 * f0); acc[ai][bj][m][1] = acc[ai][bj][m][1] * (d1 * f1); }
                asm volatile("" ::: "memory"); }
    }
    __device__ __forceinline__ void operator()(const Acc& acc, const Unit& u, int wr, int wc, int fr, int fq) const {
        const int row0 = u.pm * BM + wr * 64 + fr, col0 = u.pn * BM + wc * 32 + 8 * fq;
#pragma unroll
        for (int ai = 0; ai < 2; ++ai)
#pragma unroll
            for (int m = 0; m < 4; ++m) { const int r = row0 + ai * HALF + m * 16;
#pragma unroll
                for (int bj = 0; bj < 2; ++bj) { const int c = col0 + bj * HALF; const u32x4 gw = *(const u32x4*)(G + (size_t)r * 4096 + 2048 + c);
                    const f32x4 g0 = {bf_lo(gw.x), bf_hi(gw.x), bf_lo(gw.y), bf_hi(gw.y)}, g1 = {bf_lo(gw.z), bf_hi(gw.z), bf_lo(gw.w), bf_hi(gw.w)};
                    *(u32x4*)(MB + (size_t)r * DM + c) = pack8(acc[ai][bj][m][0] * g0, acc[ai][bj][m][1] * g1); } }
    }
};
struct EpiZ {
    bf16_t* YO;
    __device__ __forceinline__ void operator()(const Acc& acc, const Unit& u, int wr, int wc, int fr, int fq) const {
        const int row0 = u.pm * BM + wr * 64 + fr, col0 = u.pn * BM + wc * 32 + 8 * fq;
#pragma unroll
        for (int ai = 0; ai < 2; ++ai)
#pragma unroll
            for (int m = 0; m < 4; ++m) { const int r = row0 + ai * HALF + m * 16;
#pragma unroll
                for (int bj = 0; bj < 2; ++bj) *(u32x4*)(YO + (size_t)r * DM + col0 + bj * HALF) = pack8(acc[ai][bj][m][0], acc[ai][bj][m][1]); }
    }
};
struct EpiSwiGLU {
    bf16_t* H;
    __device__ __forceinline__ void operator()(const Acc& acc, const Unit& u, int wr, int wc, int fr, int fq) const {
        const int row0 = u.pm * BM + wr * 64 + fr, col0 = u.pn * HALF + wc * 32 + 8 * fq;
#pragma unroll
        for (int ai = 0; ai < 2; ++ai)
#pragma unroll
            for (int m = 0; m < 4; ++m) { const int r = row0 + ai * HALF + m * 16; f32x4 h[2];
#pragma unroll
                for (int n = 0; n < 2; ++n) { const f32x4 gt = acc[ai][0][m][n], up = acc[ai][1][m][n]; h[n] = gt * sigmoid4(gt) * up; }
                store16_wt(H + (size_t)r * FF + col0, pack8(h[0], h[1])); }
    }
};
struct EpiY {
    bf16_t* Y;
    __device__ __forceinline__ void operator()(const Acc& acc, const Unit& u, int wr, int wc, int fr, int fq) const {
        const int row0 = u.pm * BM + wr * 64 + fr, col0 = (u.pn & 7) * BM + wc * 32 + 8 * fq;
#pragma unroll
        for (int ai = 0; ai < 2; ++ai)
#pragma unroll
            for (int m = 0; m < 4; ++m) { unsigned bo = (unsigned)((row0 + ai * HALF + m * 16) * DM + col0) * 2u; asm volatile("" : "+v"(bo));
#pragma unroll
                for (int bj = 0; bj < 2; ++bj) *(u32x4*)((char*)Y + bo + bj * HALF * 2) = pack8(acc[ai][bj][m][0], acc[ai][bj][m][1]); }
    }
};
}

namespace att {
using bf16 = __hip_bfloat16;
constexpr int D = 128, NW = 8, QBLK = 32, KVBLK = 64, QB = NW * QBLK;
constexpr int SHM_V = KVBLK * D * 2, SHM_K = KVBLK * D * 2;
constexpr int LDS_WS_OFF = 2 * SHM_V + 2 * SHM_K, LDS_BIAS_OFF = LDS_WS_OFF + NW * 64 * 4, LDS_BYTES = LDS_BIAS_OFF + 512;
constexpr float SCALE = 0.08838834764831845f;
constexpr float THR = 8.f;
#define KSWZ(row, colB) ((row) * 256 + ((colB) ^ (((row) & 7) << 4)))
#define SBAR() __builtin_amdgcn_sched_barrier(0)
__device__ __forceinline__ int v_st(int k, int c) { const int kk = (k & ~0xC) | ((k & 4) << 1) | ((k & 8) >> 1); return ((kk >> 3) * 4 + (c >> 5)) * 512 + ((kk & 7) * 32 + (c & 31)) * 2; }
__device__ __forceinline__ int v_rd_base(int lane) { return ((lane & 3) << 3) | (((lane >> 2) & 3) << 6) | (((lane >> 4) & 1) << 5) | (((lane >> 5) & 1) << 8); }
constexpr int v_rd_off(int d0, int ks, int half) { return d0 * 512 + ks * 4096 + half * 2048; }
__device__ __forceinline__ int crow(int r, int hi) { return (r & 3) + 8 * (r >> 2) + 4 * hi; }
__device__ __forceinline__ unsigned cvtpk(float lo, float hi) { unsigned r; asm volatile("v_cvt_pk_bf16_f32 %0, %1, %2" : "=v"(r) : "v"(lo), "v"(hi)); return r; }
__device__ __forceinline__ bf16x8 load8(const bf16* p) { return *reinterpret_cast<const bf16x8*>(p); }
__device__ __forceinline__ void mask_tile(f32x16& p0, f32x16& p1, int dq) {
    const float NEG = -__builtin_inff();
#pragma unroll
    for (int r = 0; r < 16; ++r) { const int c = (r & 3) + 8 * (r >> 2); if (dq - c < 0) p0[r] = NEG; if (dq - c - 32 < 0) p1[r] = NEG; }
}
__device__ __forceinline__ void partialSM(f32x16& p0, f32x16& p1, float& m_reg, float& mn, float& alpha) {
    float pmax = p0[0];
#pragma unroll
    for (int r = 1; r < 16; ++r) pmax = fmaxf(pmax, p0[r]);
#pragma unroll
    for (int r = 0; r < 16; ++r) pmax = fmaxf(pmax, p1[r]);
    { auto rr = __builtin_amdgcn_permlane32_swap(__float_as_uint(pmax), __float_as_uint(pmax), false, false); pmax = fmaxf(__uint_as_float(rr[0]), __uint_as_float(rr[1])); }
    constexpr float C2 = 1.4426950408889634f * SCALE;
    if (__builtin_expect(__all((pmax - m_reg) * SCALE <= THR), 1)) { mn = m_reg; alpha = 1.f; }
    else { mn = fmaxf(m_reg, pmax); alpha = __builtin_amdgcn_exp2f((m_reg - mn) * C2); m_reg = mn; }
    const float mnL = -mn * C2;
#pragma unroll
    for (int r = 0; r < 16; ++r) p0[r] = fmaf(p0[r], C2, mnL);
#pragma unroll
    for (int r = 0; r < 16; ++r) p1[r] = fmaf(p1[r], C2, mnL);
#pragma unroll
    for (int r = 0; r < 16; ++r) p0[r] = __builtin_amdgcn_exp2f(p0[r]);
}
__device__ __forceinline__ void finishSM(f32x16& p0, f32x16& p1, float alpha, float& l_reg, bf16x8& pa0, bf16x8& pa1, bf16x8& pa2, bf16x8& pa3) {
#pragma unroll
    for (int r = 0; r < 16; ++r) p1[r] = __builtin_amdgcn_exp2f(p1[r]);
    float ps = 0;
#pragma unroll
    for (int r = 0; r < 16; ++r) ps += p0[r];
#pragma unroll
    for (int r = 0; r < 16; ++r) ps += p1[r];
    { auto rr = __builtin_amdgcn_permlane32_swap(__float_as_uint(ps), __float_as_uint(ps), false, false); ps = __uint_as_float(rr[0]) + __uint_as_float(rr[1]); }
    l_reg = l_reg * alpha + ps;
#define PK4(P, B_, OUT) do { unsigned a0 = cvtpk(P[B_+0], P[B_+1]), a1 = cvtpk(P[B_+2], P[B_+3]);                          \
        unsigned b0 = cvtpk(P[B_+4], P[B_+5]), b1 = cvtpk(P[B_+6], P[B_+7]);                                             \
        auto r0 = __builtin_amdgcn_permlane32_swap(a0, b0, false, false); auto r1 = __builtin_amdgcn_permlane32_swap(a1, b1, false, false); \
        u32x4 w = {r0[0], r1[0], r0[1], r1[1]}; OUT = *reinterpret_cast<bf16x8*>(&w); } while (0)
    PK4(p0, 0, pa0); PK4(p0, 8, pa1); PK4(p1, 0, pa2); PK4(p1, 8, pa3);
#undef PK4
}
template <int KB>
__device__ __forceinline__ void qkt(f32x16& p0, f32x16& p1, const char* K_lds, const char* B_lds, int r32, int hi, const bf16x8* qr) {
    const float* bl = (const float*)(B_lds + KB * 256) + 4 * hi;
#pragma unroll
    for (int g = 0; g < 4; ++g) { const f32x4 b0 = *(const f32x4*)(bl + 8 * g), b1 = *(const f32x4*)(bl + 32 + 8 * g);
#pragma unroll
        for (int i = 0; i < 4; ++i) { p0[4 * g + i] = b0[i]; p1[4 * g + i] = b1[i]; } }
    const char* kb[4];
#pragma unroll
    for (int dd = 0; dd < 4; ++dd) kb[dd] = K_lds + KB * SHM_K + KSWZ(r32, (dd * 16 + hi * 8) * 2);
#pragma unroll
    for (int d0 = 0; d0 < 8; ++d0) { const char* a = kb[d0 & 3] + (d0 >> 2) * 128;
        bf16x8 b0 = *reinterpret_cast<const bf16x8*>(a);
        bf16x8 b1 = *reinterpret_cast<const bf16x8*>(a + 32 * 256);
        p0 = __builtin_amdgcn_mfma_f32_32x32x16_bf16(b0, qr[d0], p0, 0, 0, 0);
        p1 = __builtin_amdgcn_mfma_f32_32x32x16_bf16(b1, qr[d0], p1, 0, 0, 0); }
}
template <int VB>
__device__ __forceinline__ void pv_tile(f32x16* o, int vb0, bf16x8 pa0, bf16x8 pa1, bf16x8 pa2, bf16x8 pa3) {
#define TRRD(dst, off) asm volatile("ds_read_b64_tr_b16 %0, %1 offset:%2" : "=&v"(dst) : "v"(vb0), "i"(off) : "memory")
#define PV_D0(d0) do { s16x4 l0, l1, l2, l3, h0, h1, h2, h3; constexpr int b_ = VB * SHM_V + v_rd_off(d0, 0, 0); \
        TRRD(l0, b_); TRRD(h0, b_ + 2048); TRRD(l1, b_ + 4096); TRRD(h1, b_ + 6144); TRRD(l2, b_ + 8192); TRRD(h2, b_ + 10240); TRRD(l3, b_ + 12288); TRRD(h3, b_ + 14336); \
        asm volatile("s_waitcnt lgkmcnt(0)" ::: "memory"); SBAR();   \
        o[d0] = __builtin_amdgcn_mfma_f32_32x32x16_bf16(pa0, (bf16x8){l0[0], l0[1], l0[2], l0[3], h0[0], h0[1], h0[2], h0[3]}, o[d0], 0, 0, 0);   \
        o[d0] = __builtin_amdgcn_mfma_f32_32x32x16_bf16(pa1, (bf16x8){l1[0], l1[1], l1[2], l1[3], h1[0], h1[1], h1[2], h1[3]}, o[d0], 0, 0, 0);   \
        o[d0] = __builtin_amdgcn_mfma_f32_32x32x16_bf16(pa2, (bf16x8){l2[0], l2[1], l2[2], l2[3], h2[0], h2[1], h2[2], h2[3]}, o[d0], 0, 0, 0);   \
        o[d0] = __builtin_amdgcn_mfma_f32_32x32x16_bf16(pa3, (bf16x8){l3[0], l3[1], l3[2], l3[3], h3[0], h3[1], h3[2], h3[3]}, o[d0], 0, 0, 0); } while (0)
    PV_D0(0); PV_D0(1); PV_D0(2); PV_D0(3);
#undef PV_D0
#undef TRRD
}
struct BlockRef { const bf16* Q; const bf16* K; const bf16* V; const float* B; bf16* O; int ostride; int P0; int jlo; };
struct Seam { bf16x8 qr[8]; bf16x8 st_v0, st_v1, st_k0, st_k1; };
#define ROW(p, k0, rr) ((p) + (size_t)((k0) + (rr)) * D + sc)
#define VMW() asm volatile("s_waitcnt vmcnt(0)" ::: "memory")
#define VMWN(n) asm volatile("s_waitcnt vmcnt(%0)" :: "i"(n) : "memory")
#define SLOAD_H(Kp, Vp, k0) do { S.st_v0 = load8(ROW(Vp, k0, sr)); S.st_v1 = load8(ROW(Vp, k0, 32 + sr));              \
                         S.st_k0 = load8(ROW(Kp, k0, sr)); S.st_k1 = load8(ROW(Kp, k0, 32 + sr)); } while (0)
#define BLOAD(Bp, k0, bf) do { if (wid == 0) __builtin_amdgcn_global_load_lds((const unsigned*)((Bp) + (k0) + lane), (LAS unsigned*)(lds3 + LDS_BIAS_OFF + (bf) * 256), 4, 0, 0); } while (0)
#define SWRITE_HK(bf) do { *(bf16x8*)(K_lds + (bf) * SHM_K + kws) = S.st_k0; *(bf16x8*)(K_lds + (bf) * SHM_K + kws + 32 * 256) = S.st_k1; } while (0)
#define SWRITE_HV(bf) do { *(bf16x8*)(V_lds + (bf) * SHM_V + vst0) = S.st_v0; *(bf16x8*)(V_lds + (bf) * SHM_V + vst1) = S.st_v1; } while (0)
#define SWRITE_H(bf) do { SWRITE_HV(bf); SWRITE_HK(bf); } while (0)
__device__ __forceinline__ void attn_prime(const BlockRef& cur, char* lds, LAS unsigned char* lds3, Seam& S) {
    int tid = threadIdx.x; asm volatile("" : "+v"(tid)); const int wid = __builtin_amdgcn_readfirstlane(tid >> 6), lane = tid & 63, r32 = lane & 31, hi = lane >> 5;
    const int sr = tid >> 4, sc = (tid & 15) * 8, kws = KSWZ(sr, sc * 2); char* K_lds = lds + 2 * SHM_V;
#pragma unroll
    for (int d0 = 0; d0 < 8; ++d0) S.qr[d0] = load8(cur.Q + (size_t)(wid * QBLK + r32) * D + d0 * 16 + hi * 8);
    SLOAD_H(cur.K, cur.V, 0); BLOAD(cur.B, 0, 0); VMW(); SWRITE_HK(0);
    __syncthreads();
}
__device__ __forceinline__ void attn_block(const BlockRef& cur, const BlockRef& nxt, char* lds, LAS unsigned char* lds3, Seam& S) {
    int tid = threadIdx.x; asm volatile("" : "+v"(tid)); const int wid = __builtin_amdgcn_readfirstlane(tid >> 6), lane = tid & 63, r32 = lane & 31, hi = lane >> 5;
    const int NT = (cur.P0 + QB) / KVBLK - cur.jlo;
    const int qlo = cur.P0 + wid * QBLK, qm = qlo + r32 - 4 * hi;
    char* V_lds = lds; char* K_lds = lds + 2 * SHM_V; const char* B_lds = lds + LDS_BIAS_OFF;
    float* ws = (float*)(lds + LDS_WS_OFF) + wid * 64; float* li_l = ws, * al_l = ws + 32;
    float m_reg = -1e30f, l_reg = 0; f32x16 o[4] = {};
    const int sr = tid >> 4, sc = (tid & 15) * 8, vst0 = v_st(sr, sc), vst1 = v_st(32 + sr, sc), kws = KSWZ(sr, sc * 2);
    const int vb0 = (int)(uintptr_t)V_lds + v_rd_base(lane);
    const bf16* Kh = cur.K; const bf16* Vh = cur.V; const float* Bh = cur.B;
#define RESC(a) do { if (__any((a) < 1.f)) { if (hi == 0) al_l[r32] = (a); asm volatile("s_waitcnt lgkmcnt(0)" ::: "memory");              \
                     _Pragma("unroll") for (int d_ = 0; d_ < 4; ++d_) _Pragma("unroll") for (int r = 0; r < 16; ++r) o[d_][r] *= al_l[crow(r, hi)]; } } while (0)
#define KBASE(t) ((t) * KVBLK)
#define MASKT(P0_, P1_, t) do { const int kb_ = KBASE((t) + cur.jlo); if (kb_ + KVBLK - 1 > qlo) mask_tile(P0_, P1_, qm - kb_); } while (0)
    f32x16 pA0, pA1, pB0, pB1; float mnA, mnB, alA, alB; bf16x8 pa0, pa1, pa2, pa3;
    SWRITE_HV(0); SBAR();
    SLOAD_H(Kh, Vh, KBASE(1)); BLOAD(Bh, KBASE(1), 1);
    SBAR(); qkt<0>(pA0, pA1, K_lds, B_lds, r32, hi, S.qr);
    MASKT(pA0, pA1, 0); partialSM(pA0, pA1, m_reg, mnA, alA);
    VMW(); SWRITE_H(1);
    __syncthreads();
#define HALF_STEP(PX0, PX1, mnX, alX, PY0, PY1, alY, t, KB, VB, SB) do {                                                      \
        SBAR(); qkt<KB>(PX0, PX1, K_lds, B_lds, r32, hi, S.qr);                                                               \
        finishSM(PY0, PY1, alY, l_reg, pa0, pa1, pa2, pa3); SBAR();                                                           \
        if ((t) + 1 < NT) { SLOAD_H(Kh, Vh, KBASE((t) + 1)); BLOAD(Bh, KBASE((t) + 1), SB); SBAR(); }                        \
        pv_tile<VB>(o, vb0, pa0, pa1, pa2, pa3); MASKT(PX0, PX1, (t)); partialSM(PX0, PX1, m_reg, mnX, alX);                  \
        __syncthreads();                                                                                                      \
        if ((t) + 1 < NT) { VMW(); SWRITE_H(SB); }                                                                            \
        RESC(alX); __syncthreads(); } while (0)
    for (int t = 1; t + 1 < NT; t += 2) {
        HALF_STEP(pB0, pB1, mnB, alB, pA0, pA1, alA, t, 1, 0, 0);
        HALF_STEP(pA0, pA1, mnA, alA, pB0, pB1, alB, t + 1, 0, 1, 1);
    }
    SBAR(); qkt<1>(pB0, pB1, K_lds, B_lds, r32, hi, S.qr); SBAR();
    SLOAD_H(nxt.K, nxt.V, 0); BLOAD(nxt.B, 0, 0); SBAR();
#pragma unroll
    for (int d0 = 0; d0 < 8; ++d0) S.qr[d0] = load8(nxt.Q + (size_t)(wid * QBLK + r32) * D + d0 * 16 + hi * 8);
    SBAR();
    finishSM(pA0, pA1, alA, l_reg, pa0, pa1, pa2, pa3); SBAR();
    pv_tile<0>(o, vb0, pa0, pa1, pa2, pa3);
    MASKT(pB0, pB1, NT - 1); partialSM(pB0, pB1, m_reg, mnB, alB); __syncthreads(); RESC(alB);
    finishSM(pB0, pB1, alB, l_reg, pa0, pa1, pa2, pa3); SBAR(); pv_tile<1>(o, vb0, pa0, pa1, pa2, pa3);
    SBAR(); VMWN(8); SWRITE_HK(0); SBAR();
    if (hi == 0) li_l[r32] = l_reg; asm volatile("s_waitcnt lgkmcnt(0)" ::: "memory");
    float rli[16];
#pragma unroll
    for (int r = 0; r < 16; ++r) rli[r] = __builtin_amdgcn_rcpf(li_l[crow(r, hi)]);
    bf16* Ow = cur.O + (size_t)(wid * QBLK) * cur.ostride;
#pragma unroll
    for (int r = 0; r < 16; ++r) { const int orow = crow(r, hi);
#pragma unroll
        for (int d0 = 0; d0 < 4; ++d0) { const float v = o[d0][r] * rli[r];
            const float vn = __shfl_xor(v, 1);
            if ((r32 & 1) == 0) *(unsigned*)(Ow + (size_t)orow * cur.ostride + d0 * 32 + r32) = cvtpk(v, vn); } }
    __syncthreads();
#undef RESC
#undef KBASE
#undef MASKT
#undef HALF_STEP
}

constexpr int DV1_OFF = 32768, DK_OFF = 65536, DP_OFF = 98304, DWS_OFF = 131072, DATT_LDS_END = DWS_OFF + 2048;
struct DRef { const bf16* Q; const bf16* K; const bf16* V0; const bf16* V1; bf16* O0; bf16* O1; int P0; };
template <int KB>
__device__ __forceinline__ void qkt0(f32x16& p0, f32x16& p1, const char* K_lds, int r32, int hi, const bf16x8* qr) {
    p0 = f32x16{}; p1 = f32x16{};
    const char* kb[4];
#pragma unroll
    for (int dd = 0; dd < 4; ++dd) kb[dd] = K_lds + KB * SHM_K + KSWZ(r32, (dd * 16 + hi * 8) * 2);
#pragma unroll
    for (int d0 = 0; d0 < 8; ++d0) { const char* a = kb[d0 & 3] + (d0 >> 2) * 128;
        bf16x8 b0 = *reinterpret_cast<const bf16x8*>(a);
        bf16x8 b1 = *reinterpret_cast<const bf16x8*>(a + 32 * 256);
        p0 = __builtin_amdgcn_mfma_f32_32x32x16_bf16(b0, qr[d0], p0, 0, 0, 0);
        p1 = __builtin_amdgcn_mfma_f32_32x32x16_bf16(b1, qr[d0], p1, 0, 0, 0); }
}
#define D_KLOAD(Kp, k0) do { _Pragma("unroll") for (int j_ = 0; j_ < 4; ++j_) kst[j_] = load8((Kp) + (size_t)((k0) + sr + 16 * j_) * D + sc); } while (0)
#define D_KWRITE(bf) do { _Pragma("unroll") for (int j_ = 0; j_ < 4; ++j_) *(bf16x8*)(K_lds + (bf) * SHM_K + kws + j_ * 4096) = kst[j_]; } while (0)
#define D_VLOAD(V0p, V1p, k0) do { unsigned vo_ = (unsigned)(sr * D + sc) * 2u; asm volatile("" : "+v"(vo_));   \
        _Pragma("unroll") for (int j_ = 0; j_ < 4; ++j_) { vs[j_] = load8((const bf16*)((const char*)((V0p) + (size_t)((k0) + 16 * j_) * D) + vo_)); vs[4 + j_] = load8((const bf16*)((const char*)((V1p) + (size_t)((k0) + 16 * j_) * D) + vo_)); } } while (0)
#define D_VWRITE(sl_) do { int sr_ = sr; asm volatile("" : "+v"(sr_)); _Pragma("unroll") for (int j_ = 0; j_ < 4; ++j_) { const int vs_ = v_st(sr_ + 16 * j_, sc); *(bf16x8*)(V_lds + (sl_) * SHM_V + vs_) = vs[j_]; *(bf16x8*)(V1_lds + (sl_) * SHM_V + vs_) = vs[4 + j_]; } } while (0)
#define D_PEXPORT(pb_) do { bf16x8* pp_ = (bf16x8*)(P_lds + (pb_) * 16384) + lane; pp_[0] = pa0; pp_[64] = pa1; pp_[128] = pa2; pp_[192] = pa3; } while (0)
#define D_PIMPORT(pb_) do { const bf16x8* pp_ = (const bf16x8*)(P_lds + (pb_) * 16384) + lane; pa0 = pp_[0]; pa1 = pp_[64]; pa2 = pp_[128]; pa3 = pp_[192]; } while (0)
#define D_AEXPORT(par, a) do { if (hi == 0) al_l[(par) * 32 + r32] = (a); } while (0)
#define D_RESC(par) do { const float* ap_ = al_l + (par) * 32; const float a_ = ap_[r32]; if (__any(a_ < 1.f)) { _Pragma("unroll") for (int d_ = 0; d_ < 4; ++d_) _Pragma("unroll") for (int r = 0; r < 16; ++r) { const float f_ = ap_[crow(r, hi)]; o0[d_][r] *= f_; o1[d_][r] *= f_; } } } while (0)
#define D_OSTORE(Op, oo) do { int rq_ = r32, hq_ = hi; asm volatile("" : "+v"(rq_), "+v"(hq_));   bf16* Ow = (Op) + (size_t)((wid & 3) * QBLK) * D + rq_; \
        _Pragma("unroll") for (int r = 0; r < 16; ++r) { const int orow = crow(r, hq_); \
            const float rl_ = __builtin_amdgcn_rcpf(li_l[orow]); \
            _Pragma("unroll") for (int d0 = 0; d0 < 4; ++d0) { const float v = oo[d0][r] * rl_; const float vn = __shfl_xor(v, 1); \
                if ((r32 & 1) == 0) *(unsigned*)(Ow + (size_t)orow * D + d0 * 32) = cvtpk(v, vn); } } } while (0)
__device__ __forceinline__ void pv_both(f32x16* o0, f32x16* o1, int vb0s, int vb1s, bf16x8 pa0, bf16x8 pa1, bf16x8 pa2, bf16x8 pa3) {
#define TRRD(dst, base, off) asm volatile("ds_read_b64_tr_b16 %0, %1 offset:%2" : "=&v"(dst) : "v"(base), "i"(off) : "memory")
#define TR8(P, base, d0) do { constexpr int b_ = v_rd_off(d0, 0, 0); TRRD(P##l0, base, b_); TRRD(P##h0, base, b_ + 2048); TRRD(P##l1, base, b_ + 4096); TRRD(P##h1, base, b_ + 6144); \
        TRRD(P##l2, base, b_ + 8192); TRRD(P##h2, base, b_ + 10240); TRRD(P##l3, base, b_ + 12288); TRRD(P##h3, base, b_ + 14336); } while (0)
#define MM4(P, acc) do { \
        acc = __builtin_amdgcn_mfma_f32_32x32x16_bf16(pa0, (bf16x8){P##l0[0], P##l0[1], P##l0[2], P##l0[3], P##h0[0], P##h0[1], P##h0[2], P##h0[3]}, acc, 0, 0, 0); \
        acc = __builtin_amdgcn_mfma_f32_32x32x16_bf16(pa1, (bf16x8){P##l1[0], P##l1[1], P##l1[2], P##l1[3], P##h1[0], P##h1[1], P##h1[2], P##h1[3]}, acc, 0, 0, 0); \
        acc = __builtin_amdgcn_mfma_f32_32x32x16_bf16(pa2, (bf16x8){P##l2[0], P##l2[1], P##l2[2], P##l2[3], P##h2[0], P##h2[1], P##h2[2], P##h2[3]}, acc, 0, 0, 0); \
        acc = __builtin_amdgcn_mfma_f32_32x32x16_bf16(pa3, (bf16x8){P##l3[0], P##l3[1], P##l3[2], P##l3[3], P##h3[0], P##h3[1], P##h3[2], P##h3[3]}, acc, 0, 0, 0); } while (0)
#define WAIT8() do { asm volatile("s_waitcnt lgkmcnt(8)" ::: "memory"); SBAR(); } while (0)
#define WAIT0() do { asm volatile("s_waitcnt lgkmcnt(0)" ::: "memory"); SBAR(); } while (0)
    s16x4 Al0, Al1, Al2, Al3, Ah0, Ah1, Ah2, Ah3, Bl0, Bl1, Bl2, Bl3, Bh0, Bh1, Bh2, Bh3;
    TR8(A, vb0s, 0);
    TR8(B, vb1s, 0); WAIT8(); MM4(A, o0[0]);
    TR8(A, vb0s, 1); WAIT8(); MM4(B, o1[0]);
    TR8(B, vb1s, 1); WAIT8(); MM4(A, o0[1]);
    TR8(A, vb0s, 2); WAIT8(); MM4(B, o1[1]);
    TR8(B, vb1s, 2); WAIT8(); MM4(A, o0[2]);
    TR8(A, vb0s, 3); WAIT8(); MM4(B, o1[2]);
    TR8(B, vb1s, 3); WAIT8(); MM4(A, o0[3]);
    WAIT0(); MM4(B, o1[3]);
#undef TRRD
#undef TR8
#undef MM4
#undef WAIT8
#undef WAIT0
}
__device__ __forceinline__ void pv_one(f32x16* o, int vbs, bf16x8 pa0, bf16x8 pa1, bf16x8 pa2, bf16x8 pa3) {
#define TRRD(dst, base, off) asm volatile("ds_read_b64_tr_b16 %0, %1 offset:%2" : "=&v"(dst) : "v"(base), "i"(off) : "memory")
#define TR8(P, base, d0) do { constexpr int b_ = v_rd_off(d0, 0, 0); TRRD(P##l0, base, b_); TRRD(P##h0, base, b_ + 2048); TRRD(P##l1, base, b_ + 4096); TRRD(P##h1, base, b_ + 6144); \
        TRRD(P##l2, base, b_ + 8192); TRRD(P##h2, base, b_ + 10240); TRRD(P##l3, base, b_ + 12288); TRRD(P##h3, base, b_ + 14336); } while (0)
#define MM4(P, acc) do { \
        acc = __builtin_amdgcn_mfma_f32_32x32x16_bf16(pa0, (bf16x8){P##l0[0], P##l0[1], P##l0[2], P##l0[3], P##h0[0], P##h0[1], P##h0[2], P##h0[3]}, acc, 0, 0, 0); \
        acc = __builtin_amdgcn_mfma_f32_32x32x16_bf16(pa1, (bf16x8){P##l1[0], P##l1[1], P##l1[2], P##l1[3], P##h1[0], P##h1[1], P##h1[2], P##h1[3]}, acc, 0, 0, 0); \
        acc = __builtin_amdgcn_mfma_f32_32x32x16_bf16(pa2, (bf16x8){P##l2[0], P##l2[1], P##l2[2], P##l2[3], P##h2[0], P##h2[1], P##h2[2], P##h2[3]}, acc, 0, 0, 0); \
        acc = __builtin_amdgcn_mfma_f32_32x32x16_bf16(pa3, (bf16x8){P##l3[0], P##l3[1], P##l3[2], P##l3[3], P##h3[0], P##h3[1], P##h3[2], P##h3[3]}, acc, 0, 0, 0); } while (0)
    s16x4 Al0, Al1, Al2, Al3, Ah0, Ah1, Ah2, Ah3, Bl0, Bl1, Bl2, Bl3, Bh0, Bh1, Bh2, Bh3;
    TR8(A, vbs, 0);
    TR8(B, vbs, 1); asm volatile("s_waitcnt lgkmcnt(8)" ::: "memory"); SBAR(); MM4(A, o[0]);
    TR8(A, vbs, 2); asm volatile("s_waitcnt lgkmcnt(8)" ::: "memory"); SBAR(); MM4(B, o[1]);
    TR8(B, vbs, 3); asm volatile("s_waitcnt lgkmcnt(8)" ::: "memory"); SBAR(); MM4(A, o[2]);
    asm volatile("s_waitcnt lgkmcnt(0)" ::: "memory"); SBAR(); MM4(B, o[3]);
#undef TRRD
#undef TR8
#undef MM4
}
struct DQueue { unsigned* ctr; volatile LAS unsigned* slot; const bf16* QKV; bf16* OD; int xcd; unsigned long long* stp; int half; };
constexpr int DS_ = 8192, DNITEM = 512;
__device__ __forceinline__ int dfetch(const DQueue& q, int& par, int tid) {
    if (tid == 0) { unsigned it_ = (unsigned)DNITEM;
        for (int k_ = 0; k_ < 8; ++k_) { const unsigned x_ = (unsigned)(q.xcd + k_) & 7u; const unsigned v_ = __hip_atomic_fetch_add(q.ctr + 64 * x_, 1u, __ATOMIC_RELAXED, __HIP_MEMORY_SCOPE_AGENT); if (v_ < 32u) { it_ = ((unsigned)q.half * 32u + v_) * 8u + x_; break; } }
        q.slot[par] = it_; }
    __syncthreads(); const int v = __builtin_amdgcn_readfirstlane((int)q.slot[par]); par ^= 1; return v;
}
__device__ __forceinline__ DRef dref_of(const DQueue& q, int item) {
    DRef r; const int m = item & 7, qb = 63 - (item >> 3);
    r.Q = q.QKV + (size_t)m * QUS + (size_t)(qb * 128) * 128; r.K = q.QKV + (size_t)(8 + m) * QUS;
    r.V0 = q.QKV + (size_t)(16 + (m >> 1) * 2) * QUS; r.V1 = r.V0 + QUS;
    r.O0 = q.OD + ((size_t)(2 * m) * DS_ + qb * 128) * 128; r.O1 = q.OD + ((size_t)(2 * m + 1) * DS_ + qb * 128) * 128; r.P0 = qb * 128; return r;
}
#define KBASE(t) ((t) * KVBLK)
__device__ __forceinline__ void dattn_S(char* lds, const DQueue& Q_) {
    int tid = threadIdx.x; asm volatile("" : "+v"(tid)); const int wid = __builtin_amdgcn_readfirstlane(tid >> 6), lane = tid & 63, r32 = lane & 31, hi = lane >> 5;
    const int t8 = tid & 255, sr = t8 >> 4, sc = (t8 & 15) * 8, kws = KSWZ(sr, sc * 2);
    char* K_lds = lds + DK_OFF; char* P_lds = lds + DP_OFF + (wid & 3) * 4096;
    float* ws = (float*)(lds + DWS_OFF) + (wid & 3) * 128; float* li_l = ws, * al_l = ws + 32;
    int par = 0; int item = dfetch(Q_, par, tid); if (item >= DNITEM) return;
    DRef cur = dref_of(Q_, item);
    bf16x8 qr[8], kst[4], pa0, pa1, pa2, pa3;
#pragma unroll
    for (int d0 = 0; d0 < 8; ++d0) qr[d0] = load8(cur.Q + (size_t)(wid * QBLK + r32) * D + d0 * 16 + hi * 8);
    D_KLOAD(cur.K, 0); VMW(); D_KWRITE(0); D_KLOAD(cur.K, KBASE(1));
    __syncthreads();
    for (;;) {
        bool more = false; DRef nxt = cur;
#define LATE_FETCH() do { const int nitem_ = dfetch(Q_, par, tid); more = nitem_ < DNITEM; if (more) nxt = dref_of(Q_, nitem_); } while (0)
        const int NT = (cur.P0 + 128) / KVBLK;
        const int qlo = cur.P0 + wid * QBLK, qm = qlo + r32 - 4 * hi;
        float m_reg = -1e30f, l_reg = 0; const bf16* Kh = cur.K;
        f32x16 pA0, pA1, pB0, pB1; float mnA, mnB, alA = 1.f, alB = 1.f;
#define MASKT(P0_, P1_, t) do { const int kb_ = KBASE(t); if (kb_ + KVBLK - 1 > qlo) mask_tile(P0_, P1_, qm - kb_); } while (0)
#define SSTEP(PX0, PX1, mnX, alX, PY0, PY1, mnY, alY, t, KB, FS) do {                                                              \
        VMW(); D_KWRITE((KB) ^ 1); SBAR();                                       \
        if ((t) + 2 < NT) { D_KLOAD(Kh, KBASE((t) + 2)); } else if ((t) + 2 == NT) { D_KLOAD(nxt.K, 0); }                     \
        SBAR(); qkt0<KB>(PX0, PX1, K_lds, r32, hi, qr);                                                                       \
        if (FS) { MASKT(PY0, PY1, (t) - 1); partialSM(PY0, PY1, m_reg, mnY, alY);          \
                  finishSM(PY0, PY1, alY, l_reg, pa0, pa1, pa2, pa3); D_PEXPORT((KB) ^ 1); D_AEXPORT((KB) ^ 1, alY); } SBAR(); \
        __syncthreads();                                                                                             \
        } while (0)
        if (NT == 2) LATE_FETCH();
        SSTEP(pA0, pA1, mnA, alA, pB0, pB1, mnB, alB, 0, 0, false);
        for (int t = 1; t < NT; t += 2) {
            SSTEP(pB0, pB1, mnB, alB, pA0, pA1, mnA, alA, t, 1, true);
            if (t + 1 < NT) { if (t + 1 == NT - 2) LATE_FETCH(); SSTEP(pA0, pA1, mnA, alA, pB0, pB1, mnB, alB, t + 1, 0, true); }
        }
        MASKT(pB0, pB1, NT - 1); partialSM(pB0, pB1, m_reg, mnB, alB);
        finishSM(pB0, pB1, alB, l_reg, pa0, pa1, pa2, pa3); D_PEXPORT(1); D_AEXPORT(1, alB); if (hi == 0) li_l[r32] = l_reg;
#pragma unroll
        for (int d0 = 0; d0 < 8; ++d0) qr[d0] = load8(nxt.Q + (size_t)(wid * QBLK + r32) * D + d0 * 16 + hi * 8);
        __syncthreads();
        D_KLOAD(nxt.K, KBASE(1));
        __syncthreads();
#undef MASKT
#undef SSTEP
#undef LATE_FETCH
        if (PROBE_SEL >= 0 && tid == 0) { if (Q_.stp[24] == 0ull) { Q_.stp[24] = __builtin_amdgcn_s_memrealtime(); Q_.stp[25] = (unsigned long long)(NT + 2); } else if (Q_.stp[26] == 0ull) { Q_.stp[26] = __builtin_amdgcn_s_memrealtime(); Q_.stp[27] = (unsigned long long)(NT + 2); } }
        if (!more) break;
        cur = nxt;
    }
    VMW();
}
__device__ __forceinline__ void dattn_V(char* lds, const DQueue& Q_) {
    int tid = threadIdx.x; asm volatile("" : "+v"(tid)); const int wid = __builtin_amdgcn_readfirstlane(tid >> 6), lane = tid & 63, r32 = lane & 31, hi = lane >> 5;
    const int t8 = tid & 255, sr = t8 >> 4, sc = (t8 & 15) * 8;
    char* V_lds = lds; char* V1_lds = lds + DV1_OFF; char* P_lds = lds + DP_OFF + (wid & 3) * 4096;
    float* ws = (float*)(lds + DWS_OFF) + (wid & 3) * 128; float* li_l = ws, * al_l = ws + 32;
    const int vb0 = (int)(uintptr_t)V_lds + v_rd_base(lane), vb1 = (int)(uintptr_t)V1_lds + v_rd_base(lane);
    int par = 0; int item = dfetch(Q_, par, tid); if (item >= DNITEM) return;
    DRef cur = dref_of(Q_, item);
    bf16x8 vs[8], pa0, pa1, pa2, pa3;
    __syncthreads();
    for (;;) {
        bool more = false; DRef nxt = cur;
        const int NT = (cur.P0 + 128) / KVBLK;
        f32x16 o0[4] = {}, o1[4] = {};
        int t = 0;
        do {
            if (t == NT - 2) { const int nitem_ = dfetch(Q_, par, tid); more = nitem_ < DNITEM; if (more) nxt = dref_of(Q_, nitem_); }
            if (t >= 1 && t <= NT) { VMW(); D_VWRITE((t - 1) & 1); }
            if (t < NT) D_VLOAD(cur.V0, cur.V1, KBASE(t));
            if (t >= 2) { const int pb = t & 1; D_RESC(pb); D_PIMPORT(pb); asm volatile("s_waitcnt lgkmcnt(0)" ::: "memory");
                pv_both(o0, o1, vb0 + pb * SHM_V, vb1 + pb * SHM_V, pa0, pa1, pa2, pa3); }
            if (t == NT + 1) { D_OSTORE(cur.O0, o0); D_OSTORE(cur.O1, o1); }
            __syncthreads();
        } while (++t < NT + 2);
        if (!more) break;
        cur = nxt;
    }
}
#undef KBASE
#undef D_KLOAD
#undef D_KWRITE
#undef D_VLOAD
#undef D_VWRITE
#undef D_PEXPORT
#undef D_PIMPORT
#undef D_AEXPORT
#undef D_RESC
#undef D_OSTORE
#undef ROW
#undef VMW
#undef VMWN
#undef SLOAD_H
#undef BLOAD
#undef SWRITE_HK
#undef SWRITE_HV
#undef SWRITE_H
#undef KSWZ
#undef SBAR
}

constexpr size_t MiB = 1u << 20, KiB = 1u << 10;
constexpr size_t WS_CTL = 0, CTL_ZERO_BYTES = 1 * MiB;
constexpr size_t WS_FLOG = 1 * MiB, WS_FBIAS = WS_FLOG + 256 * KiB, WS_ZEROB = WS_FBIAS + 256 * KiB, WS_WRT = WS_ZEROB + 64 * KiB;
constexpr size_t WS_NP = 1920 * KiB;
constexpr size_t WS_TOKINFO = 2 * MiB, WS_LIST = 3 * MiB;
constexpr size_t WS_ROPE = 4 * MiB;
constexpr size_t WS_WPC = 8 * MiB, WS_WOUT = 16 * MiB, WS_WIN = 24 * MiB, WS_WGU = 64 * MiB, WS_WD = 192 * MiB;
constexpr size_t WS_QKV = 256 * MiB, WS_G = 356 * MiB, WS_XB = 420 * MiB, WS_OD = 24 * MiB, WS_ACAT = 452 * MiB;
constexpr size_t WS_LOCAL = 56 * MiB, WS_CNTT = 58 * MiB;
constexpr size_t WS_MB = 256 * MiB, WS_Z = 288 * MiB, WS_X1B = 352 * MiB, WS_H = 384 * MiB, WS_Y = 408 * MiB, WS_END = 504 * MiB;
constexpr int CW_TMO = 0, CW_BAR = 4096, CW_ATTQ = 8192, CW_ECNT = 12288, CW_QN = 16384, CW_KN = 17408, CW_DQ = 18560, CW_TD = 20480, CW_CD = 20736, CW_BG = 21504, CW_GD = 21632, CW_AD = 21760, CW_MQ8 = 22528, CW_MQ9 = 23552;
constexpr int HROWS = 24576;

constexpr int RING_OFF = 0, RING_BYTES = 131072;
constexpr int SM_OFF = 135168;
constexpr int PFX_OFF = 137216;
constexpr int LDSCTL_OFF = 155648, MISC_OFF = LDSCTL_OFF + 320;
constexpr int LDS_BYTES = 163840;
static_assert(att::DATT_LDS_END <= LDSCTL_OFF, "attention LDS map");

#define RLX_AGENT __ATOMIC_RELAXED, __HIP_MEMORY_SCOPE_AGENT
#define LDS_WAIT() asm volatile("s_waitcnt lgkmcnt(0)" ::: "memory")
#define VM_WAIT() asm volatile("s_waitcnt vmcnt(0)" ::: "memory")

#define XB_TMO      128
#define XB_XCNT(j)  (256  + 64 * (j))
#define XB_XSUB(j)  (1280 + 64 * (j))
#define XB_XGEN(j)  (2304 + 64 * (j))
#define XB_TOP      3328
#define XB_TOPGEN   3392
#define XCD_BAR_WORDS 3456
#define XB_SPIN_CAP (1u << 18)
__device__ __forceinline__ unsigned xb_ld(unsigned* p)              { return __hip_atomic_load(p, __ATOMIC_RELAXED, __HIP_MEMORY_SCOPE_AGENT); }
__device__ __forceinline__ unsigned xb_add(unsigned* p, unsigned v) { return __hip_atomic_fetch_add(p, v, __ATOMIC_RELAXED, __HIP_MEMORY_SCOPE_AGENT); }
__device__ __forceinline__ unsigned xb_xcc_id() { return (unsigned)__builtin_amdgcn_s_getreg((3 << 11) | 20) & 0xFu; }
#define XB_SPIN(cond, bar) do { unsigned _sp = 0; while (cond) { __builtin_amdgcn_s_sleep(1); \
    if ((++_sp & 255u) == 0u) { if (xb_ld(&(bar)[XB_TMO])) break; if (_sp > XB_SPIN_CAP) { atomicAdd(&(bar)[XB_TMO], 1u); break; } } } } while (0)
struct XcdBarrier { unsigned* bar; unsigned x; volatile LAS unsigned* st; };
__device__ __forceinline__ XcdBarrier xcd_barrier_post(unsigned* bar, volatile LAS unsigned* st) {
    XcdBarrier b; b.bar = bar; b.x = xb_xcc_id(); b.st = st;
    if (threadIdx.x == 0) (void)xb_add(&bar[XB_XCNT(b.x)], 1u);
    return b;
}
__device__ __forceinline__ void xcd_barrier_complete(unsigned* bar, unsigned x, unsigned& nloc, unsigned& nx) {
    const unsigned G = gridDim.x * gridDim.y * gridDim.z;
    unsigned sum, cnt, mine, sp = 0u;
    for (;;) {
        sum = 0u; cnt = 0u; mine = 0u;
#pragma unroll
        for (unsigned j = 0; j < 16; ++j) { const unsigned c = xb_ld(&bar[XB_XCNT(j)]); sum += c; cnt += (c > 0u) ? 1u : 0u; mine = (j == x) ? c : mine; }
        if (sum == G) break;
        __builtin_amdgcn_s_sleep(1);
        if ((++sp & 255u) == 0u) { if (xb_ld(&bar[XB_TMO])) break; if (sp > XB_SPIN_CAP) { atomicAdd(&bar[XB_TMO], 1u); break; } }
    }
    nloc = mine > 0u ? mine : 1u; nx = cnt > 0u ? cnt : 1u;
}
__device__ __forceinline__ void xcd_barrier(const XcdBarrier& b) {
    asm volatile("s_waitcnt vmcnt(0)" ::: "memory");
    __syncthreads();
    if (threadIdx.x == 0) {
        unsigned* bar = b.bar;
        __builtin_amdgcn_s_waitcnt(0);
        unsigned nloc = b.st[0], nx = b.st[1];
        if (nloc == 0u) { xcd_barrier_complete(bar, b.x, nloc, nx); b.st[0] = nloc; b.st[1] = nx; }
        const unsigned old = xb_add(&bar[XB_XSUB(b.x)], 1u);
        const unsigned gen = old / nloc;
        if (old + 1u == (gen + 1u) * nloc) {
            __builtin_amdgcn_fence(__ATOMIC_RELEASE, "agent");
            asm volatile("s_waitcnt vmcnt(0)" ::: "memory");
            const unsigned og = xb_add(&bar[XB_TOP], 1u);
            const unsigned tg = og / nx;
            if (og + 1u == (tg + 1u) * nx) xb_add(&bar[XB_TOPGEN], 1u);
            else XB_SPIN(xb_ld(&bar[XB_TOPGEN]) == tg, bar);
            __builtin_amdgcn_fence(__ATOMIC_ACQUIRE, "agent");
            xb_add(&bar[XB_XGEN(b.x)], 1u);
            asm volatile("s_waitcnt vmcnt(0)" ::: "memory");
        } else {
            XB_SPIN(xb_ld(&bar[XB_XGEN(b.x)]) == gen, bar);
            __builtin_amdgcn_fence(__ATOMIC_ACQUIRE, "agent");
            asm volatile("s_waitcnt vmcnt(0)" ::: "memory");
        }
    }
    __syncthreads();
}

constexpr int NWAVES = 8, NPHASE = 11;
struct Args { const float* in[22]; float* out; unsigned char* ws; int ph_lo, ph_hi; };
struct Frame {
    LAS unsigned char* lds; volatile LAS unsigned* MISC; unsigned* ctl;
    int tid, lane, wave, vcu, G;
};

template <class RM, bool WTHROUGH = false>
__device__ __forceinline__ void tr_item(const float* W, int N, int k0, int nsrc0, bf16_t* WT, int ldw, int kdst, const RM& rowmap, LAS float* scr, int lane) {
    const int lr = lane >> 4, lc = (lane & 15) * 4;
#pragma unroll 4
    for (int i = 0; i < 16; ++i) { const int kk = 4 * i + lr; const f32x4 v = *(const f32x4*)(W + (size_t)(k0 + kk) * N + nsrc0 + lc);
        scr[kk * 65 + lc] = v[0]; scr[kk * 65 + lc + 1] = v[1]; scr[kk * 65 + lc + 2] = v[2]; scr[kk * 65 + lc + 3] = v[3]; }
    LDS_WAIT(); asm volatile("" ::: "memory");
    const int c = lane & 7;
#pragma unroll
    for (int j = 0; j < 8; ++j) { const int n = (lane >> 3) + 8 * j; const LAS float* s = scr + (8 * c) * 65 + n;
        u32x4 o; o.x = cvt_pk_bf16(s[0 * 65], s[1 * 65]); o.y = cvt_pk_bf16(s[2 * 65], s[3 * 65]); o.z = cvt_pk_bf16(s[4 * 65], s[5 * 65]); o.w = cvt_pk_bf16(s[6 * 65], s[7 * 65]);
        if (WTHROUGH) pg8::store16_wt(WT + (size_t)rowmap(nsrc0 + n) * ldw + kdst + k0 + 8 * c, o); else *(u32x4*)(WT + (size_t)rowmap(nsrc0 + n) * ldw + kdst + k0 + 8 * c) = o; }
    LDS_WAIT(); asm volatile("" ::: "memory");
}
struct RmId { __device__ __forceinline__ int operator()(int c) const { return c; } };
struct RmIn { __device__ __forceinline__ int operator()(int c) const {
        if (c < 2048) { const int jj = c & 127, j6 = jj & 63; return (c & ~127) + 8 * (j6 >> 2) + (jj >= 64 ? 4 : 0) + (j6 & 3); }
        return c < 6144 ? c : c - 8; } };
struct RmGate { int up; __device__ __forceinline__ int operator()(int c) const { return 256 * (c >> 7) + 128 * up + (c & 127); } };

__device__ __forceinline__ att::BlockRef mk_ref(int item, int jlo, const bf16_t* QKV, bf16_t* OD, bf16_t* ACAT, const float* FBIAS, const float* ZEROB) {
    att::BlockRef r; const int qb = 31 - item / 24, u = item % 24; int hq, hk, hv;
    if (u < 16) { const int m = u >> 1, c = u & 1; hq = m; hk = 8 + m; hv = 16 + (m >> 1) * 2 + c; r.B = ZEROB; r.O = (att::bf16*)OD + ((size_t)u * S + qb * 256) * 128; r.ostride = 128; }
    else { const int h = u - 16; hq = 24 + h; hk = 32 + h; hv = 40 + h; r.B = FBIAS + (size_t)h * S; r.O = (att::bf16*)ACAT + (size_t)(qb * 256) * DM + 1024 + h * 128; r.ostride = DM; }
    r.Q = (const att::bf16*)QKV + (size_t)hq * QUS + (size_t)(qb * 256) * 128; r.K = (const att::bf16*)QKV + (size_t)hk * QUS + (size_t)(jlo * 64) * 128; r.V = (const att::bf16*)QKV + (size_t)hv * QUS + (size_t)(jlo * 64) * 128; r.B += jlo * 64; r.P0 = qb * 256; r.jlo = jlo; return r;
}
__global__ void __launch_bounds__(NWAVES * 64, 2) mk_fwd(Args args) {
    extern __shared__ __attribute__((aligned(16))) unsigned char lds[];
    Frame F;
    F.lds = (LAS unsigned char*)lds;
    F.MISC = (volatile LAS unsigned*)(F.lds + MISC_OFF);
    F.tid = threadIdx.x; F.lane = F.tid & 63; F.wave = __builtin_amdgcn_readfirstlane(F.tid >> 6);
    F.G = gridDim.x; { const int bx = blockIdx.x; F.vcu = (F.G % 8 == 0) ? (bx % 8) * (F.G / 8) + bx / 8 : bx; }
    unsigned char* ws = args.ws;
    F.ctl = (unsigned*)(ws + WS_CTL);
    const float* x = args.in[0]; const float* w_in = args.in[1]; const float* b_forget = args.in[2];
    const float* lq1 = args.in[3]; const float* lk1 = args.in[4]; const float* lq2 = args.in[5]; const float* lk2 = args.in[6];
    const float* dng = args.in[7]; const float* wpd = args.in[8]; const float* wpf = args.in[9]; const float* wout = args.in[10];
    const float* ln1g = args.in[11]; const float* ln1b = args.in[12]; const float* wrg = args.in[13]; const float* brg = args.in[14];
    const float* wre = args.in[15]; const float* bre = args.in[16]; const float* wgate = args.in[17]; const float* wup = args.in[18];
    const float* wdown = args.in[19]; const float* ln2g = args.in[20]; const float* ln2b = args.in[21];
    float* FLOG = (float*)(ws + WS_FLOG); float* FBIAS = (float*)(ws + WS_FBIAS); float* ZEROB = (float*)(ws + WS_ZEROB); float* WRT = (float*)(ws + WS_WRT);
    float* NPB = (float*)(ws + WS_NP);
    int* TOKINFO = (int*)(ws + WS_TOKINFO); int* LIST = (int*)(ws + WS_LIST); float* ROPE = (float*)(ws + WS_ROPE);
    bf16_t* WPC = (bf16_t*)(ws + WS_WPC); bf16_t* WOUT = (bf16_t*)(ws + WS_WOUT); bf16_t* WIN = (bf16_t*)(ws + WS_WIN); bf16_t* WGU = (bf16_t*)(ws + WS_WGU); bf16_t* WD = (bf16_t*)(ws + WS_WD);
    bf16_t* QKV = (bf16_t*)(ws + WS_QKV); bf16_t* GB = (bf16_t*)(ws + WS_G); bf16_t* XB = (bf16_t*)(ws + WS_XB); bf16_t* OD = (bf16_t*)(ws + WS_OD); bf16_t* ACAT = (bf16_t*)(ws + WS_ACAT);
    bf16_t* MB = (bf16_t*)(ws + WS_MB); float* Z = (float*)(ws + WS_Z); bf16_t* X1B = (bf16_t*)(ws + WS_X1B); bf16_t* HB = (bf16_t*)(ws + WS_H); bf16_t* YB = (bf16_t*)(ws + WS_Y);

    for (int u = F.tid; u < (LDS_BYTES - LDSCTL_OFF) / 4; u += NWAVES * 64) ((LAS unsigned*)(F.lds + LDSCTL_OFF))[u] = 0u;
    __syncthreads();
    XcdBarrier bar; bar.bar = F.ctl + CW_BAR; bar.x = 0; bar.st = nullptr;
    if (MK_N_LAUNCHES == 1) bar = xcd_barrier_post(F.ctl + CW_BAR, F.MISC + 8);
    const int lo = args.ph_lo, hi = args.ph_hi; constexpr int rep = 0;
#define FRESH() do { int t_ = threadIdx.x; asm volatile("" : "+v"(t_)); F.tid = t_; F.lane = t_ & 63; F.wave = __builtin_amdgcn_readfirstlane(t_ >> 6); } while (0)
#define IN(k) ((((PH_MASK) >> (k)) & 1) && lo <= (k) && (k) < hi)
#if PROBE_SEL >= 0
    unsigned long long* stamps = (unsigned long long*)(ws + WS_CTL + 512 * KiB) + (size_t)blockIdx.x * 32;
#define STAMP(i) do { if (threadIdx.x == 0) stamps[i] = __builtin_amdgcn_s_memrealtime(); } while (0)
#else
#define STAMP(i) do { } while (0)
#endif
#define SEAM(k) do { STAMP(2 * (k) + 1); if (IN(k) && IN((k) + 1)) xcd_barrier(bar); STAMP(2 * (k) + 2); } while (0)
#define gw (F.vcu * NWAVES + F.wave)
#define BG_BATCH(b_) do { const int r_ = (int)(b_) * 8 + F.wave, e_ = r_ >> 9, up_ = (r_ >> 8) & 1, q_ = r_ & 255;                                               \
        tr_item<RmGate, true>((up_ ? wup : wgate) + (size_t)e_ * DM * FF, FF, 64 * (q_ >> 3), 64 * (q_ & 7), WGU + (size_t)e_ * 1024 * DM, DM, 0, RmGate{up_}, (LAS float*)(F.lds + F.wave * 16640), F.lane); \
        VM_WAIT(); __syncthreads();                                                                                                                                  \
        if (F.tid == 0) (void)__hip_atomic_fetch_add(F.ctl + CW_GD + e_, 1u, RLX_AGENT); } while (0)
    const int NGW = F.G * NWAVES;
    LAS int* sm_rowidx = (LAS int*)(F.lds + SM_OFF); LAS int* sm_pre = sm_rowidx + 256; LAS int* sm_cnt = sm_pre + 40;

    STAMP(0);
    if (IN(0)) {
        FRESH();
        LAS float* scr = (LAS float*)(F.lds + F.wave * 16640);
        constexpr int I_IN = 32 * 160, I_P = 16 * 32, I_O = 32 * 32, I_E = 32 * 256, NITEMS = I_IN + 2 * I_P + I_O;
        for (int it = gw; it < NITEMS; it += NGW) {
            int r = it;
            if (r < I_IN) { const int kb = r / 160, nb = r % 160; tr_item(w_in, INC, 64 * kb, 64 * nb + (nb >= 96 ? 8 : 0), WIN, DM, 0, RmIn{}, scr, F.lane); continue; } r -= I_IN;
            if (r < I_P) { tr_item(wpd, DM, 64 * (r / 32), 64 * (r % 32), WPC, DM, 0, RmId{}, scr, F.lane); continue; } r -= I_P;
            if (r < I_P) { tr_item(wpf, DM, 64 * (r / 32), 64 * (r % 32), WPC, DM, 1024, RmId{}, scr, F.lane); continue; } r -= I_P;
            if (r < I_O) { tr_item(wout, DM, 64 * (r / 32), 64 * (r % 32), WOUT, DM, 0, RmId{}, scr, F.lane); continue; } r -= I_O;
        }
        const int gt = F.vcu * (NWAVES * 64) + F.tid, NGT = F.G * NWAVES * 64;
        for (int i = gt; i < S * 64; i += NGT) { const int pos = i >> 6, j = i & 63; const double ang = (double)pos * pow(10000.0, -(double)j / 64.0);
            ROPE[(size_t)pos * 128 + j] = (float)cos(ang); ROPE[(size_t)pos * 128 + 64 + j] = (float)sin(ang); }
        for (int i = gt; i < 36 * DM; i += NGT) { const int c = i / DM, k = i % DM; WRT[i] = c < 4 ? wrg[k * 4 + c] : wre[((size_t)((c - 4) >> 3) * DM + k) * 8 + ((c - 4) & 7)]; }
        for (int i = gt; i < S; i += NGT) ZEROB[i] = 0.f;
        __syncthreads();
        { LAS float* Wf = (LAS float*)F.lds;
          for (int i = F.tid; i < DM * 2; i += NWAVES * 64) { const int k = i >> 1, h4 = (i & 1) * 4; const f32x4 v = *(const f32x4*)(w_in + (size_t)k * INC + 6144 + h4);
              Wf[(h4 + 0) * DM + k] = v[0]; Wf[(h4 + 1) * DM + k] = v[1]; Wf[(h4 + 2) * DM + k] = v[2]; Wf[(h4 + 3) * DM + k] = v[3]; }
          __syncthreads();
          for (int m = gw; m < S; m += NGW) {
              const f32x4* xr = (const f32x4*)(x + (size_t)m * DM) + F.lane; f32x4 v[8];
#pragma unroll
              for (int j = 0; j < 8; ++j) v[j] = xr[64 * j];
              u32x2* o8 = (u32x2*)(XB + (size_t)m * DM) + F.lane;
#pragma unroll
              for (int j = 0; j < 8; ++j) { u32x2 w; w.x = cvt_pk_bf16(v[j][0], v[j][1]); w.y = cvt_pk_bf16(v[j][2], v[j][3]); o8[64 * j] = w; }
              float fl[8];
#pragma unroll
              for (int c = 0; c < 8; ++c) { float a = 0.f;
#pragma unroll
                  for (int j = 0; j < 8; ++j) { const f32x4 w = *(const LAS f32x4*)(Wf + c * DM + 256 * j + 4 * F.lane); a = fmaf(v[j][0], w[0], fmaf(v[j][1], w[1], fmaf(v[j][2], w[2], fmaf(v[j][3], w[3], a)))); }
                  asm volatile("" ::: "memory");
                  fl[c] = wave_sum(a); asm volatile("" : "+v"(fl[c])); }
              if (F.lane == 0) { *(f32x4*)(FLOG + (size_t)m * 8) = (f32x4){fl[0], fl[1], fl[2], fl[3]}; *(f32x4*)(FLOG + (size_t)m * 8 + 4) = (f32x4){fl[4], fl[5], fl[6], fl[7]}; }
          }
          __syncthreads();
        }
    }
    SEAM(0);

    if (IN(1)) {
        FRESH();
        if (F.vcu < 8) {
            const int h = F.vcu; LAS double* part = (LAS double*)F.lds; const double b = (double)b_forget[h];
            double ls[16]; double run = 0.0;
#pragma unroll
            for (int i = 0; i < 16; ++i) { const double z = (double)FLOG[(size_t)(F.tid * 16 + i) * 8 + h] + b; run += (z < 0.0 ? z : 0.0) - log1p(exp(-fabs(z))); ls[i] = run; }
            part[F.tid] = run; __syncthreads();
            if (F.tid == 0) { double a = 0.0; for (int i = 0; i < NWAVES * 64; ++i) { const double t = part[i]; part[i] = a; a += t; } }
            __syncthreads();
            const double off = part[F.tid];
#pragma unroll
            for (int i = 0; i < 16; ++i) FBIAS[(size_t)h * S + F.tid * 16 + i] = (float)(-(off + ls[i]) * (double)INV_SCALE);
            __syncthreads();
        }
        pg8::Gemm g{XB, WIN, DM, DM, DM, nullptr}; pg8::StaticOrder So; So.init(S, NIN, F.G, (int)blockIdx.x);
        pg8::EpiInProj E{QKV, GB, ROPE, NPB};
        pg8::gemm_phase<pg8::EpiInProj, pg8::StaticOrder, false>(F.lds + RING_OFF, g, So, E);
    }
    SEAM(1);

    if (IN(2)) {
        FRESH();
        constexpr int NITEM = 24 * 32;
#pragma nounroll
        for (int pass = 0; pass < 2; ++pass) {
        { att::DQueue dq{F.ctl + CW_ATTQ + 64 * (8 + 8 * pass), F.MISC + 22, (const att::bf16*)QKV, (att::bf16*)OD, (int)bar.x, PROBE_SEL >= 0 ? (unsigned long long*)(ws + WS_CTL + 512 * KiB) + (size_t)blockIdx.x * 32 : nullptr, pass};
          if (F.wave < 4) att::dattn_S((char*)lds, dq); else att::dattn_V((char*)lds, dq);
          VM_WAIT(); __syncthreads();
        }
        if (pass == 0) {
        STAMP(22);
        #define ref(item, jl) mk_ref((item), (jl), QKV, OD, ACAT, FBIAS, ZEROB)
        int slot = 0;
#define FETCH(dst, dstj) do { if (F.wave == 0) { unsigned v_ = 0; if (F.lane == 0) { const unsigned i_ = __hip_atomic_fetch_add(F.ctl + CW_ATTQ + 64 * rep, 1u, RLX_AGENT); v_ = i_ < 256u ? (i_ & 31u) * 24u + 16u + F.MISC[24 + ((i_ >> 5) & 7u)] : (unsigned)NITEM; } const int it_ = (int)__builtin_amdgcn_readfirstlane(v_); int jl_ = 0; \
        if (it_ < NITEM && (it_ % 24) >= 16) { const int h_ = it_ % 24 - 16, qb_ = 31 - it_ / 24, nt_ = 4 * qb_ + 4; const float* Bh_ = FBIAS + (size_t)h_ * S; \
            float qn_ = 0.f, kd_ = 0.f; \
            for (int d_ = 0; d_ < 4; ++d_) { const f32x4 a_ = *(const f32x4*)(NPB + ((size_t)h_ * 128 + 4 * qb_ + d_) * 4), b_ = *(const f32x4*)(NPB + ((size_t)(8 + h_) * 128 + 4 * qb_ + d_) * 4); \
                qn_ = fmaxf(qn_, (a_[0] + a_[1]) + (a_[2] + a_[3])); kd_ = fmaxf(kd_, (b_[0] + b_[1]) + (b_[2] + b_[3])); } \
            qn_ = sqrtf(qn_) * 1.005f; kd_ = sqrtf(kd_) * 1.005f; \
            const float lowm_ = -qn_ * kd_ * 1.0001f + Bh_[qb_ * 256]; int first_ = nt_; \
            for (int c_ = 0; c_ < 2; ++c_) { const int t_ = c_ * 64 + F.lane; bool keep_ = true; \
                if (t_ < nt_) { const f32x4 b_ = *(const f32x4*)(NPB + ((size_t)(8 + h_) * 128 + t_) * 4); const float kn_ = sqrtf((b_[0] + b_[1]) + (b_[2] + b_[3])) * 1.005f; keep_ = !(qn_ * kn_ * 1.0001f + Bh_[64 * t_ + 63] - lowm_ < -FOX_THR_RAW); } else keep_ = (t_ == nt_); \
                const unsigned long long bm_ = __ballot(keep_ && t_ <= nt_); if (bm_ && first_ == nt_) first_ = c_ * 64 + (int)__builtin_ctzll(bm_); } \
            jl_ = first_ & ~1; if (jl_ > nt_ - 4) jl_ = nt_ - 4; if (jl_ < 0) jl_ = 0; } \
        if (F.lane == 0) { F.MISC[16 + slot] = (unsigned)it_; F.MISC[18 + slot] = (unsigned)jl_; } } \
        __syncthreads(); dst = __builtin_amdgcn_readfirstlane((int)F.MISC[16 + slot]); dstj = __builtin_amdgcn_readfirstlane((int)F.MISC[18 + slot]); slot ^= 1; } while (0)
        if (F.tid < 8) { const float mine_ = b_forget[F.tid]; int rk_ = 0;
            for (int h2 = 0; h2 < 8; ++h2) { const float o_ = b_forget[h2]; rk_ += (o_ > mine_ || (o_ == mine_ && h2 < F.tid)) ? 1 : 0; }
            F.MISC[24 + rk_] = (unsigned)F.tid; }
        __syncthreads();
        { att::Seam Sm;
          for (;;) {
            int item, jl; FETCH(item, jl);
            if (item >= NITEM) break;
            const att::BlockRef cur = ref(item, jl);
            att::attn_prime(cur, (char*)lds, F.lds, Sm);
            att::attn_block(cur, cur, (char*)lds, F.lds, Sm);
          } }
        VM_WAIT(); __syncthreads();
#undef FETCH
#undef ref
        STAMP(24 + 4);
        }
        }
        { FRESH(); if (F.tid == 0) (void)__hip_atomic_fetch_add(F.ctl + CW_AD, 1u, RLX_AGENT); int sl = 0;
          for (;;) { if (F.tid == 0) { unsigned b = 0xFFFFFFFFu; if (__hip_atomic_load(F.ctl + CW_AD, RLX_AGENT) < (unsigned)F.G) b = __hip_atomic_fetch_add(F.ctl + CW_BG, 1u, RLX_AGENT); F.MISC[20 + sl] = b; }
              __syncthreads(); const unsigned b = F.MISC[20 + sl]; sl ^= 1; if (b >= 2048u) break; BG_BATCH(b); } }
    }
    SEAM(2);

    if (IN(3)) {
        FRESH();
        float a = lq1[F.lane] * lk1[F.lane] + lq1[F.lane + 64] * lk1[F.lane + 64], b = lq2[F.lane] * lk2[F.lane] + lq2[F.lane + 64] * lk2[F.lane + 64];
        const float lam = __expf(wave_sum(a)) - __expf(wave_sum(b)) + LAM_INIT;
        const int c = F.lane >> 5, dd = (F.lane & 31) * 4;
        for (int p = gw; p < S * 4; p += NGW) { const int s = p >> 2, h = p & 3;
            const u32x2 w1 = *(const u32x2*)(OD + ((size_t)(4 * h + c) * S + s) * 128 + dd), w2 = *(const u32x2*)(OD + ((size_t)(4 * h + 2 + c) * S + s) * 128 + dd);
            const f32x4 o1 = {bf_lo(w1.x), bf_hi(w1.x), bf_lo(w1.y), bf_hi(w1.y)}, o2 = {bf_lo(w2.x), bf_hi(w2.x), bf_lo(w2.y), bf_hi(w2.y)};
            const f32x4 v = o1 - o2 * lam;
            const float ss = wave_sum(v[0] * v[0] + v[1] * v[1] + v[2] * v[2] + v[3] * v[3]);
            const float r = rsqrtf(ss * (1.f / 256.f) + LN_EPS) * (1.f - LAM_INIT);
            const f32x4 gg = *(const f32x4*)(dng + h * 256 + 4 * F.lane);
            u32x2 w; w.x = cvt_pk_bf16(v[0] * r * gg[0], v[1] * r * gg[1]); w.y = cvt_pk_bf16(v[2] * r * gg[2], v[3] * r * gg[3]);
            *(u32x2*)(ACAT + (size_t)s * DM + h * 256 + 4 * F.lane) = w; }
    }
    SEAM(3);

    if (IN(4)) {
        pg8::Gemm g{ACAT, WPC, DM, DM, DM, nullptr}; pg8::StaticOrder So; So.init(S, DM, F.G, (int)blockIdx.x);
        pg8::EpiGateHook E{GB, MB};
        pg8::gemm_phase<pg8::EpiGateHook, pg8::StaticOrder, false, true>(F.lds + RING_OFF, g, So, E);
    }
    STAMP(9); if (IN(4) && IN(6)) xcd_barrier(bar); STAMP(10);

    if (IN(6)) {
        pg8::Gemm g{MB, WOUT, DM, DM, DM, nullptr};
        pg8::StaticOrder So; So.init(S, DM, F.G, (int)blockIdx.x);
        pg8::EpiZ E{X1B};
        pg8::gemm_phase<pg8::EpiZ, pg8::StaticOrder, false>(F.lds + RING_OFF, g, So, E);
    }
    SEAM(6);

    if (IN(7)) {
        FRESH();
        unsigned* ecnt = F.ctl + CW_ECNT + rep * 2048; int* LISTr = rep ? (int*)(ws + WS_H) : LIST; int* TOKr = rep ? (int*)(ws + WS_H + 2 * MiB) : TOKINFO; float* Zw = rep ? (float*)(ws + WS_Y) : Z; bf16_t* X1Bw = rep ? (bf16_t*)(ws + WS_Y + 64 * MiB) : X1B;
        LAS float* Wl = (LAS float*)F.lds;
        LAS float* Lw = (LAS float*)(F.lds + 81920) + F.wave * 128;
        LAS unsigned* lcnt = (LAS unsigned*)(F.lds + 90112); int* LOCALL = (int*)(ws + WS_LOCAL) + (size_t)F.vcu * 32 * 64; int* CNTT = (int*)(ws + WS_CNTT);
        if (F.tid < 32) lcnt[F.tid] = 0u;
        __syncthreads();
#pragma unroll 1
        for (int pr = 0; pr < 2; ++pr) {
            const int rowA = gw * 4 + 2 * pr;
            f32x4 xa[8], xb[8];
            {
                const u32x2* za = (const u32x2*)(XB + (size_t)rowA * DM) + F.lane; const u32x2* zb = za + DM / 4;
                const u32x2* ya = (const u32x2*)(X1B + (size_t)rowA * DM) + F.lane; const u32x2* yb = ya + DM / 4;
                float sa = 0.f, sb = 0.f;
#pragma unroll
                for (int j = 0; j < 8; ++j) { const u32x2 wa_ = ya[64 * j], wb_ = yb[64 * j], xa_ = za[64 * j], xb_ = zb[64 * j];
                    xa[j] = (f32x4){bf_lo(xa_.x), bf_hi(xa_.x), bf_lo(xa_.y), bf_hi(xa_.y)} * ALPHA + (f32x4){bf_lo(wa_.x), bf_hi(wa_.x), bf_lo(wa_.y), bf_hi(wa_.y)}; xb[j] = (f32x4){bf_lo(xb_.x), bf_hi(xb_.x), bf_lo(xb_.y), bf_hi(xb_.y)} * ALPHA + (f32x4){bf_lo(wb_.x), bf_hi(wb_.x), bf_lo(wb_.y), bf_hi(wb_.y)}; sa += (xa[j][0] + xa[j][1]) + (xa[j][2] + xa[j][3]); sb += (xb[j][0] + xb[j][1]) + (xb[j][2] + xb[j][3]); }
                const float ma = wave_sum(sa) * (1.f / DM), mb = wave_sum(sb) * (1.f / DM); float qa = 0.f, qb = 0.f;
#pragma unroll
                for (int j = 0; j < 8; ++j) { xa[j] = xa[j] - ma; xb[j] = xb[j] - mb; qa += (xa[j][0] * xa[j][0] + xa[j][1] * xa[j][1]) + (xa[j][2] * xa[j][2] + xa[j][3] * xa[j][3]);
                    qb += (xb[j][0] * xb[j][0] + xb[j][1] * xb[j][1]) + (xb[j][2] * xb[j][2] + xb[j][3] * xb[j][3]); }
                const float ra = rsqrtf(wave_sum(qa) * (1.f / DM) + LN_EPS), rb = rsqrtf(wave_sum(qb) * (1.f / DM) + LN_EPS);
                u32x2* ha = (u32x2*)(X1Bw + (size_t)rowA * DM) + F.lane; u32x2* hb = ha + DM / 4;
#pragma unroll
                for (int j = 0; j < 8; ++j) { const f32x4 gg = *((const f32x4*)ln1g + F.lane + 64 * j), bb = *((const f32x4*)ln1b + F.lane + 64 * j);
                    xa[j] = xa[j] * ra * gg + bb; xb[j] = xb[j] * rb * gg + bb;
                    u32x2 w; w.x = cvt_pk_bf16(xa[j][0], xa[j][1]); w.y = cvt_pk_bf16(xa[j][2], xa[j][3]); ha[64 * j] = w;
                    w.x = cvt_pk_bf16(xb[j][0], xb[j][1]); w.y = cvt_pk_bf16(xb[j][2], xb[j][3]); hb[64 * j] = w; }
            }
            float la[36], lb[36];
#pragma unroll
            for (int c = 0; c < 36; ++c) { la[c] = 0.f; lb[c] = 0.f; }
#define P7_STAGE(j, b) do { unsigned lo_ = (unsigned)F.lane * 16u; asm volatile("" : "+v"(lo_)); _Pragma("unroll") for (int n_ = 0; n_ < 5; ++n_) { const int c_ = F.wave + 8 * n_; if (c_ < 36) { \
        const char* ub_ = (const char*)(WRT + (size_t)c_ * DM + 256 * (j)); __builtin_amdgcn_global_load_lds((const unsigned*)(ub_ + lo_), (LAS unsigned*)(Wl + (b) * 9216 + c_ * 256), 16, 0, 0); } } } while (0)
#define P7_COMMIT(b) do { VM_WAIT(); } while (0)
            __syncthreads();
            P7_STAGE(0, 0); P7_COMMIT(0); __syncthreads();
#pragma unroll
            for (int j = 0; j < 8; ++j) {
                if (j + 1 < 8) P7_STAGE(j + 1, (j + 1) & 1);
                const LAS float* Wb = Wl + (j & 1) * 9216;
#pragma unroll
                for (int cg = 0; cg < 9; ++cg) { f32x4 w[4];
#pragma unroll
                    for (int q = 0; q < 4; ++q) w[q] = *(const LAS f32x4*)(Wb + (4 * cg + q) * 256 + 4 * F.lane);
                    asm volatile("" ::: "memory");
#pragma unroll
                    for (int q = 0; q < 4; ++q) { const int c = 4 * cg + q;
                        la[c] = fmaf(xa[j][0], w[q][0], fmaf(xa[j][1], w[q][1], fmaf(xa[j][2], w[q][2], fmaf(xa[j][3], w[q][3], la[c]))));
                        lb[c] = fmaf(xb[j][0], w[q][0], fmaf(xb[j][1], w[q][1], fmaf(xb[j][2], w[q][2], fmaf(xb[j][3], w[q][3], lb[c]))));
                        asm volatile("" : "+v"(la[c]), "+v"(lb[c])); }
                    asm volatile("" ::: "memory"); __builtin_amdgcn_sched_barrier(0); }
                if (j + 1 < 8) { P7_COMMIT((j + 1) & 1); __syncthreads(); }
                __builtin_amdgcn_sched_barrier(0);
            }
#undef P7_STAGE
#undef P7_COMMIT
#pragma unroll
            for (int c = 0; c < 36; ++c) { la[c] = wave_sum(la[c]); lb[c] = wave_sum(lb[c]); asm volatile("" : "+v"(la[c]), "+v"(lb[c])); }
            if (F.lane == 0) {
#pragma unroll
                for (int c = 0; c < 36; ++c) { Lw[c] = la[c]; Lw[64 + c] = lb[c]; } }
            LDS_WAIT(); asm volatile("" ::: "memory");
            if (F.lane < 2) {
                const LAS float* L = Lw + 64 * F.lane; const int tok = rowA + F.lane;
                int g = 0; float gm = L[0] + brg[0];
                for (int c = 1; c < 4; ++c) { const float v = L[c] + brg[c]; if (v > gm) { gm = v; g = c; } }
                float den = 0.f;
                for (int c = 0; c < 4; ++c) den += expf(L[c] + brg[c] - gm);
                const float top_gp = 1.f / den;
                int e1 = 0; float l1 = L[4 + g * 8] + bre[g * 8];
                for (int e = 1; e < 8; ++e) { const float v = L[4 + g * 8 + e] + bre[g * 8 + e]; if (v > l1) { l1 = v; e1 = e; } }
                int e2 = 0; float l2 = -INFINITY;
                for (int e = 0; e < 8; ++e) { const float v = L[4 + g * 8 + e] + bre[g * 8 + e]; if (e != e1 && v > l2) { l2 = v; e2 = e; } }
                const float w1 = 1.f / (1.f + expf(l2 - l1));
                const int ea = g * 8 + e1, eb = g * 8 + e2;
                const int pa = (int)__hip_atomic_fetch_add(lcnt + ea, 1u, __ATOMIC_RELAXED, __HIP_MEMORY_SCOPE_WORKGROUP), pb = (int)__hip_atomic_fetch_add(lcnt + eb, 1u, __ATOMIC_RELAXED, __HIP_MEMORY_SCOPE_WORKGROUP);
                LOCALL[ea * 64 + pa] = tok; LOCALL[eb * 64 + pb] = tok;
                int* ti = TOKr + (size_t)tok * 8; ti[0] = ea; ti[1] = pa; ti[2] = __float_as_int(top_gp * w1); ti[3] = eb; ti[4] = pb; ti[5] = __float_as_int(top_gp * (1.f - w1));
            }
            asm volatile("" ::: "memory");
        }
        __syncthreads();
        if (F.tid < 32) CNTT[F.tid * 256 + F.vcu] = (int)lcnt[F.tid];
    }
    SEAM(7);

    if (IN(8) || IN(9) || IN(10)) {
        FRESH();
        { const int* CNTT = (const int*)(ws + WS_CNTT); LAS unsigned short* pfx = (LAS unsigned short*)(F.lds + PFX_OFF); LAS int* part = (LAS int*)F.lds;
          const int e = F.tid >> 4, seg = F.tid & 15; int v[16]; int ssum = 0;
#pragma unroll
          for (int i = 0; i < 16; ++i) { v[i] = CNTT[e * 256 + seg * 16 + i]; ssum += v[i]; }
          part[F.tid] = ssum; __syncthreads();
          int base = 0; for (int q = 0; q < seg; ++q) base += part[e * 16 + q];
#pragma unroll
          for (int i = 0; i < 16; ++i) { pfx[e * 256 + seg * 16 + i] = (unsigned short)base; base += v[i]; }
          if (seg == 15) sm_cnt[e] = base; }
        __syncthreads();
        if (F.tid == 0) { int a = 0; for (int e = 0; e < NEXP; ++e) { sm_pre[e] = a; a += (sm_cnt[e] + 255) >> 8; } sm_pre[32] = a; }
        __syncthreads();
    }
    if (IN(8)) {
        FRESH();
        const int ntile = sm_pre[32], n8 = ntile * 4, n9 = ntile * 8, NB = 1024, total = n8 + NB + n9;
        unsigned* mq = F.ctl + CW_DQ; unsigned* tdone = F.ctl + CW_TD; unsigned* cdone = F.ctl + CW_CD;
        LAS float* scr = (LAS float*)(F.lds + F.wave * 16640); int sl = 0;
        for (;;) {
            if (F.tid == 0) F.MISC[20 + sl] = __hip_atomic_fetch_add(F.ctl + CW_BG, 1u, RLX_AGENT);
            __syncthreads(); const unsigned b = F.MISC[20 + sl]; sl ^= 1; if (b >= 2048u) break; BG_BATCH(b); }
        const int myx = (int)(bar.x & 7u); int stage = 0, sk = 0;
        for (;;) {
            if (F.tid == 0) { unsigned code = 3u << 28;
                for (;;) {
                    if (stage == 1) { const unsigned b = __hip_atomic_fetch_add(mq, 1u, RLX_AGENT); if (b < 1024u) { code = (1u << 28) | b; break; } stage = 2; sk = 0; continue; }
                    if (sk > 7) { if (stage == 0) { stage = 1; continue; } break; }
                    const int y = (myx + sk) & 7, tb = sm_pre[4 * y], nj = (sm_pre[4 * y + 4] - tb) * 4;
                    const int v = (int)__hip_atomic_fetch_add(F.ctl + (stage == 0 ? CW_MQ8 : CW_MQ9) + 64 * y, 1u, RLX_AGENT);
                    if (v < nj) { code = (stage == 0 ? 0u : (2u << 28)) | (unsigned)(tb * 4 + v); break; }
                    ++sk; }
                F.MISC[20 + sl] = code; }
            __syncthreads(); const unsigned code = F.MISC[20 + sl]; sl ^= 1; const int kind = (int)(code >> 28), q = (int)(code & 0xFFFFFFFu);
            if (kind == 3) break;
            if (kind == 0) {
                const int mtile = q >> 2, nt4 = q & 3; int e = 0;
                for (int k = 1; k < NEXP; ++k) if (sm_pre[k] <= mtile) e = k;
                const int mt = mtile - sm_pre[e], cnt = sm_cnt[e];
                if (F.tid < 256) { int r = mt * 256 + F.tid; r = r < cnt ? r : cnt - 1;
                    const LAS unsigned short* pe = (const LAS unsigned short*)(F.lds + PFX_OFF) + e * 256; int c = 0;
#pragma unroll
                    for (int st = 128; st >= 1; st >>= 1) if ((int)pe[c + st] <= r) c += st;
                    sm_rowidx[F.tid] = ((const int*)(ws + WS_LOCAL))[((size_t)c * 32 + e) * 64 + (r - (int)pe[c])]; }
                if (F.tid == 0) { XB_SPIN(__hip_atomic_load(F.ctl + CW_GD + e, RLX_AGENT) < 64u, F.ctl + CW_BAR); __builtin_amdgcn_fence(__ATOMIC_ACQUIRE, "agent"); }
                __syncthreads();
                pg8::Gemm g{X1B, WGU + (size_t)e * 1024 * DM, DM, DM, DM, sm_rowidx}; pg8::SingleUnit Su{{mtile, nt4}};
                pg8::EpiSwiGLU E{HB};
                pg8::gemm_phase<pg8::EpiSwiGLU, pg8::SingleUnit, true>(F.lds + RING_OFF, g, Su, E);
                VM_WAIT(); __syncthreads();
                if (F.tid == 0) (void)__hip_atomic_fetch_add(tdone + mtile, 1u, RLX_AGENT);
            } else if (kind == 1) {
                const int r = q * 8 + F.wave, e = r >> 8, qq = r & 255;
                tr_item<RmId, true>(wdown + (size_t)e * FF * DM, DM, 64 * (qq >> 5), 64 * (qq & 31), WD + (size_t)e * DM * FF, FF, 0, RmId{}, scr, F.lane);
                VM_WAIT(); __syncthreads();
                if (F.tid == 0) (void)__hip_atomic_fetch_add(cdone + e, 1u, RLX_AGENT);
            } else {
                const int u = q, mtile = u >> 2; int e = 0;
                for (int k = 1; k < NEXP; ++k) if (sm_pre[k] <= mtile) e = k;
                if (F.tid == 0) {
                    XB_SPIN(__hip_atomic_load(tdone + mtile, RLX_AGENT) < 4u || __hip_atomic_load(cdone + e, RLX_AGENT) < 32u, F.ctl + CW_BAR);
                    __builtin_amdgcn_fence(__ATOMIC_ACQUIRE, "agent");
                }
                __syncthreads();
                pg8::Gemm g{HB, WD, FF, FF, FF, nullptr}; pg8::UnitRun Su{{mtile, e * 8 + (u & 3) * 2}, 2}; pg8::EpiY E{YB};
                pg8::gemm_phase<pg8::EpiY, pg8::UnitRun, false>(F.lds + RING_OFF, g, Su, E);
            }
        }
    }
    STAMP(17); STAMP(18); STAMP(19);
    if (IN(8) && IN(10)) xcd_barrier(bar);
    STAMP(20);

    if (IN(10)) {
        FRESH();
        float* out = args.out;
        for (int m = gw; m < S; m += NGW) {
            const int* ti = TOKINFO + (size_t)m * 8;
            const LAS unsigned short* pfx = (const LAS unsigned short*)(F.lds + PFX_OFF); const int cw = m >> 5;
            const int ea = ti[0], eb = ti[3], pa = ti[1] + (int)pfx[ea * 256 + cw], pb = ti[4] + (int)pfx[eb * 256 + cw]; float wa = __int_as_float(ti[2]), wb = __int_as_float(ti[5]);
            const size_t ra = (size_t)sm_pre[ea] * 256 + pa, rb = (size_t)sm_pre[eb] * 256 + pb;
            const u32x2* xr = (const u32x2*)(X1B + (size_t)m * DM) + F.lane; const u32x2* ya = (const u32x2*)(YB + ra * DM) + F.lane; const u32x2* yb = (const u32x2*)(YB + rb * DM) + F.lane;
            f32x4 v[8]; float s = 0.f;
#pragma unroll
            for (int j = 0; j < 8; ++j) { const u32x2 xw = xr[64 * j]; const f32x4 xv = {bf_lo(xw.x), bf_hi(xw.x), bf_lo(xw.y), bf_hi(xw.y)}; const u32x2 a = ya[64 * j], b = yb[64 * j];
                const f32x4 fa = {bf_lo(a.x), bf_hi(a.x), bf_lo(a.y), bf_hi(a.y)}, fb = {bf_lo(b.x), bf_hi(b.x), bf_lo(b.y), bf_hi(b.y)};
                v[j] = xv * ALPHA + fa * wa + fb * wb; s += (v[j][0] + v[j][1]) + (v[j][2] + v[j][3]); }
            const float mean = wave_sum(s) * (1.f / DM); float q = 0.f;
#pragma unroll
            for (int j = 0; j < 8; ++j) { v[j] = v[j] - mean; q += (v[j][0] * v[j][0] + v[j][1] * v[j][1]) + (v[j][2] * v[j][2] + v[j][3] * v[j][3]); }
            const float rstd = rsqrtf(wave_sum(q) * (1.f / DM) + LN_EPS);
            f32x4* o = (f32x4*)(out + (size_t)m * DM) + F.lane;
#pragma unroll
            for (int j = 0; j < 8; ++j) { const f32x4 gg = *((const f32x4*)ln2g + F.lane + 64 * j), bb = *((const f32x4*)ln2b + F.lane + 64 * j); o[64 * j] = v[j] * rstd * gg + bb; }
        }
    }
    STAMP(21);
#if PROBE_SEL >= 0
    xcd_barrier(bar);
    if (blockIdx.x == 0) {
        FRESH();
        const unsigned long long* SB = (const unsigned long long*)(ws + WS_CTL + 512 * KiB);
        LAS int* red = (LAS int*)(F.lds + RING_OFF);
        const int c = F.tid & 255;
#define S_of(j) ((j) < 6 ? 2 * (j) : 2 * (j) + 2)
#define E_of(j) ((j) < 5 ? 2 * (j) + 1 : 2 * (j) + 3)
        const unsigned long long t00 = SB[0];
        long long metric = 0;
#define REDUCE(expr, AVG, MAX) do { __syncthreads(); if (F.tid < 256) red[F.tid] = (int)(expr); __syncthreads(); long long a_ = 0; int m_ = -2000000000; for (int i_ = 0; i_ < 256; ++i_) { a_ += red[i_]; m_ = red[i_] > m_ ? red[i_] : m_; } AVG = (int)(a_ / 256); MAX = m_; } while (0)
#define ST(i) ((long long)(SB[(size_t)c * 32 + (i)] - t00))
        int av, mx, av2, mx2;
        if (PROBE_SEL == 1) { for (int j = 0; j < 10; ++j) { REDUCE(ST(E_of(j)), av, mx); metric += mx - av; } }
        else if (PROBE_SEL == 2) { for (int j = 0; j < 9; ++j) { REDUCE(ST(E_of(j)), av, mx); REDUCE(ST(S_of(j + 1)), av2, mx2); metric += av2 - mx; } }
        else if (PROBE_SEL >= 10 && PROBE_SEL < 20) { const int j = PROBE_SEL - 10; REDUCE(ST(E_of(j)) - ST(S_of(j)), av, mx); metric = av; }
        else if (PROBE_SEL >= 30 && PROBE_SEL < 40) { const int j = PROBE_SEL - 30; REDUCE(ST(E_of(j)), av, mx); metric = mx - av; }
        else if (PROBE_SEL == 50) { REDUCE(ST(22) - ST(4), av, mx); metric = av; }
        else if (PROBE_SEL == 51) { REDUCE(ST(5) - ST(22), av, mx); metric = av; }
        else if (PROBE_SEL == 52) { REDUCE(ST(17) - ST(23), av, mx); metric = av; }
        else if (PROBE_SEL == 53) { REDUCE(ST(22), av, mx); metric = mx - av; }
        else if (PROBE_SEL == 54) { REDUCE(-ST(22), av, mx); metric = mx - av; }
        else if (PROBE_SEL == 55) { REDUCE(ST(22), av, mx); const int thr_ = av + 3000; REDUCE(ST(22) > thr_ ? 25600 : 0, av2, mx2); metric = av2; }
        else if (PROBE_SEL == 57) { REDUCE((ST(24) - ST(4)) * 100 / (long long)SB[(size_t)c * 32 + 25], av, mx); metric = av; }
        else if (PROBE_SEL == 58) { REDUCE((ST(24) - ST(4)) * 100 / (long long)SB[(size_t)c * 32 + 25], av, mx); metric = mx; }
        else if (PROBE_SEL == 59) { REDUCE(-((ST(24) - ST(4)) * 100 / (long long)SB[(size_t)c * 32 + 25]), av, mx); metric = -mx; }
        else if (PROBE_SEL == 61) { REDUCE(SB[(size_t)c * 32 + 26] ? (ST(26) - ST(24)) * 100 / (long long)SB[(size_t)c * 32 + 27] : 200, av, mx); metric = av; }
        else if (PROBE_SEL == 62) { REDUCE(SB[(size_t)c * 32 + 26] ? (ST(26) - ST(24)) * 100 / (long long)SB[(size_t)c * 32 + 27] : 200, av, mx); metric = mx; }
        else if (PROBE_SEL == 63) { REDUCE(SB[(size_t)c * 32 + 26] && SB[(size_t)c * 32 + 27] > 40 ? (ST(26) - ST(24)) * 100 / (long long)SB[(size_t)c * 32 + 27] : 0, av, mx); REDUCE(SB[(size_t)c * 32 + 26] && SB[(size_t)c * 32 + 27] > 40 ? 256 : 0, av2, mx2); metric = av2 > 0 ? (long long)av * 256 / av2 : 0; }
        else if (PROBE_SEL == 60) { metric = 10000; }
#undef REDUCE
#undef ST
        if (metric < 0) metric = 0;
        if (F.tid == 0) { const unsigned long long t1 = __builtin_amdgcn_s_memrealtime(); while ((long long)(__builtin_amdgcn_s_memrealtime() - t1) < metric * PROBE_AMP) __builtin_amdgcn_s_sleep(8); }
        __syncthreads();
    }
#endif
#undef IN
#undef SEAM
#undef gw
#undef FRESH
}

extern "C" void kernel_launch(void* const* d_in, const int* in_sizes, int n_in, void* d_out, int out_size, void* d_ws, size_t ws_size, hipStream_t stream) {
    static int grid = 0;
    if (grid == 0) {
        if (n_in != 22 || in_sizes[0] != S * DM || in_sizes[1] != DM * INC || out_size != S * DM || ws_size < WS_END) {
            fprintf(stderr, "kernel_launch: unexpected shapes (n_in %d, in0 %d, out %d, ws %zu); nothing launched\n", n_in, n_in > 0 ? in_sizes[0] : -1, out_size, ws_size); grid = -1; return; }
        int dev = 0, cus = 0, per_cu = 0;
        if (hipGetDevice(&dev) != hipSuccess || hipDeviceGetAttribute(&cus, hipDeviceAttributeMultiprocessorCount, dev) != hipSuccess) { fprintf(stderr, "kernel_launch: device query failed\n"); grid = -1; return; }
        if (hipFuncSetAttribute((const void*)mk_fwd, hipFuncAttributeMaxDynamicSharedMemorySize, LDS_BYTES) != hipSuccess) { fprintf(stderr, "kernel_launch: hipFuncSetAttribute failed\n"); grid = -1; return; }
        if (hipOccupancyMaxActiveBlocksPerMultiprocessor(&per_cu, (const void*)mk_fwd, NWAVES * 64, LDS_BYTES) != hipSuccess || per_cu < 1) fprintf(stderr, "kernel_launch: occupancy query reports %d\n", per_cu);
        (void)hipGetLastError();
        grid = cus;
        if (grid != 256) fprintf(stderr, "kernel_launch: %d CUs; this build assumes 256\n", grid);
    }
    if (grid < 0) return;
    (void)hipMemsetAsync((char*)d_ws + WS_CTL, 0, CTL_ZERO_BYTES, stream);
    Args a{};
    for (int i = 0; i < 22; ++i) a.in[i] = (const float*)d_in[i];
    a.out = (float*)d_out; a.ws = (unsigned char*)d_ws;
    if (MK_N_LAUNCHES == 1) { a.ph_lo = 0; a.ph_hi = NPHASE; hipLaunchKernelGGL(mk_fwd, dim3(grid), dim3(NWAVES * 64), LDS_BYTES, stream, a); }
    else { for (int p = 0; p < NPHASE; ++p) { a.ph_lo = p; a.ph_hi = p + 1; hipLaunchKernelGGL(mk_fwd, dim3(grid), dim3(NWAVES * 64), LDS_BYTES, stream, a); } }
}
```

```cpp
#include <hip/hip_runtime.h>
#ifndef PROBE_SEL
#define PROBE_SEL -1
#endif
#ifndef PROBE_AMP
#define PROBE_AMP 1
#endif
#include <hip/hip_bf16.h>
#include <cstdio>
#include <cstdint>
#include <cmath>

#ifndef PH_MASK
#define PH_MASK 0x7ff
#endif
#ifndef MK_N_LAUNCHES
#define MK_N_LAUNCHES 1
#endif

constexpr int S = 8192, DM = 2048, INC = 10248, NIN = 10240, NEXP = 32, FF = 512;
constexpr size_t QUS = (size_t)S * 128 + 40960;
constexpr float ALPHA = 1.189207115002721f;
constexpr float LN_EPS = 1e-5f;
constexpr float LAM_INIT = 0.2f;
constexpr float INV_SCALE = 11.313708498984761f;
constexpr float FOX_THR_RAW = 36.f * 11.313708498984761f;

#define LAS __attribute__((address_space(3)))
#define GAS __attribute__((address_space(1)))
typedef unsigned short bf16_t;
typedef short bf16x8 __attribute__((ext_vector_type(8)));
typedef short s16x4 __attribute__((ext_vector_type(4)));
typedef float f32x4 __attribute__((ext_vector_type(4)));
typedef float f32x2 __attribute__((ext_vector_type(2)));
typedef float f32x16 __attribute__((ext_vector_type(16)));
typedef unsigned u32x4 __attribute__((ext_vector_type(4)));
typedef unsigned u32x2 __attribute__((ext_vector_type(2)));
typedef GAS unsigned gu32;

typedef __bf16 bf16x2_t __attribute__((ext_vector_type(2)));
__device__ __forceinline__ unsigned cvt_pk_bf16(float lo, float hi) { f32x2 v = {lo, hi}; bf16x2_t b = __builtin_convertvector(v, bf16x2_t); return __builtin_bit_cast(unsigned, b); }
__device__ __forceinline__ float bf_lo(unsigned w) { return __uint_as_float(w << 16); }
__device__ __forceinline__ float bf_hi(unsigned w) { return __uint_as_float(w & 0xffff0000u); }
__device__ __forceinline__ float wave_sum(float v) {
#define WS_DPP(ctrl, rmask) v += __int_as_float(__builtin_amdgcn_update_dpp(0, __float_as_int(v), ctrl, rmask, 0xf, false))
    WS_DPP(0xB1, 0xf);
    WS_DPP(0x4E, 0xf);
    WS_DPP(0x141, 0xf);
    WS_DPP(0x140, 0xf);
    WS_DPP(0x142, 0xa);
    WS_DPP(0x143, 0xc);
#undef WS_DPP
    return __int_as_float(__builtin_amdgcn_readlane(__float_as_int(v), 63));
}

namespace pg8 {
constexpr int BM = 256, BK = 64, HALF = 128, HTB = HALF * BK * 2, STAGE_BYTES = 8 * HTB, NXCD = 8, WGM = 8;
__host__ __device__ __forceinline__ int lds_byte(int r, int c) { const int st = (r >> 4) * 2 + (c >> 5), rr = r & 15, cc = c & 31, ob = rr * 64 + cc * 2; return st * 1024 + (ob ^ (((ob >> 9) & 1) << 5)); }
__host__ __device__ __forceinline__ void stage_rc(int b, int& R, int& C) { const int st = b / 1024, sb = b % 1024, swz = sb ^ (((sb >> 9) & 1) << 5); R = (st >> 1) * 16 + swz / 64; C = (st & 1) * 32 + (swz % 64) / 2; }
__host__ __device__ __forceinline__ int perm32(int rho) { const int n = rho >> 4, i = rho & 15; return 8 * (i >> 2) + 4 * n + (i & 3); }

struct Unit { int pm, pn; };
struct Gemm { const bf16_t* A; const bf16_t* Bt; int K, lda, ldb; const LAS int* rowidx; };

struct StaticOrder {
    int nM, nN, nwg, G, c;
    __device__ void init(int M, int N, int G_, int c_) { nM = M / BM; nN = N / BM; nwg = nM * nN; G = G_; c = c_; }
    __device__ bool next(int i, Unit& u) const {
        const long L = (long)i * G + c; if (L >= nwg) return false;
        int wgid = (int)L; { const int q = nwg / NXCD, r = nwg % NXCD, xcd = wgid % NXCD, off = wgid / NXCD; wgid = (xcd < r ? xcd * (q + 1) : r * (q + 1) + (xcd - r) * q) + off; }
        const int nig = WGM * nN, gid = wgid / nig, fm = gid * WGM, gsz = (nM - fm) < WGM ? (nM - fm) : WGM;
        u.pm = fm + ((wgid % nig) % gsz); u.pn = (wgid % nig) / gsz; return true;
    }
};
struct SingleUnit { Unit u; __device__ bool next(int i, Unit& o) const { if (i) return false; o = u; return true; } };
struct UnitRun { Unit u; int n; __device__ bool next(int i, Unit& o) const { if (i >= n) return false; o.pm = u.pm; o.pn = u.pn + i; return true; } };

typedef f32x4 Acc[2][2][4][2];

template <class Epi, class Sched, bool GATHER, bool HOOK = false>
__device__ __forceinline__ void gemm_phase(LAS unsigned char* lds, const Gemm g, const Sched& S, const Epi& E) {
    int tid = threadIdx.x; asm volatile("" : "+v"(tid));
    const int wid = __builtin_amdgcn_readfirstlane(tid >> 6), lane = tid & 63, wr = wid >> 2, wc = wid & 3, fr = lane & 15, fq = lane >> 4;
    const int K = g.K, nt = K / BK;
    unsigned voffA[2], voffA1[2], voffB[2];
#pragma unroll
    for (int i = 0; i < 2; ++i) { int R, C; stage_rc(tid * 16 + i * 8192, R, C); const int Rb = (R & ~31) + perm32(R & 31);
        if constexpr (GATHER) { voffA[i] = (unsigned)(g.rowidx[R] * g.lda + C) * 2u; voffA1[i] = (unsigned)(g.rowidx[HALF + R] * g.lda + C) * 2u; }
        else { voffA[i] = (unsigned)(R * g.lda + C) * 2u; voffA1[i] = 0u; }
        voffB[i] = (unsigned)(Rb * g.ldb + C) * 2u; }
    const size_t kstep = (size_t)(BK * 2);
    const size_t hstepA = GATHER ? 0 : (size_t)HALF * g.lda * 2, hstepB = (size_t)HALF * g.ldb * 2;
    const size_t tstepA = GATHER ? 0 : 2 * hstepA, tstepB = 2 * hstepB;
    const unsigned ldsw = (unsigned)wid * 1024u;
    const int aoff = lds_byte(wr * 64 + fr, fq * 8), boff = lds_byte(wc * 32 + fr, fq * 8);
#define PG8_SA(b, h) (((b) * 2 + (h)) * HTB)
#define PG8_SB(b, h) ((4 + (b) * 2 + (h)) * HTB)
#define PG8_STAGE(bufoff, gbase, voff) do { _Pragma("unroll") for (int _i = 0; _i < 2; ++_i) \
        __builtin_amdgcn_global_load_lds((const unsigned*)((const char*)(gbase) + (voff)[_i]), (LAS unsigned*)(lds + (bufoff) + ldsw + _i * 8192), 16, 0, 0); } while (0)
#define PG8_STAGE_A0(bufoff, gbase) PG8_STAGE(bufoff, gbase, voffA)
#define PG8_STAGE_A1(bufoff, gbase) do { if constexpr (GATHER) { PG8_STAGE(bufoff, gbase, voffA1); } else { PG8_STAGE(bufoff, (gbase) + hstepA, voffA); } } while (0)
#define PG8_LDA(dst, b, h) do { _Pragma("unroll") for (int m = 0; m < 4; ++m) _Pragma("unroll") for (int k = 0; k < 2; ++k) dst[m][k] = *(const LAS bf16x8*)(lds + PG8_SA(b, h) + aoff + m * 2048 + k * 1024); } while (0)
#define PG8_LDB(dst, b, h) do { _Pragma("unroll") for (int n = 0; n < 2; ++n) _Pragma("unroll") for (int k = 0; k < 2; ++k) dst[n][k] = *(const LAS bf16x8*)(lds + PG8_SB(b, h) + boff + n * 2048 + k * 1024); } while (0)
#define PG8_MMA(ai, bj, At, Bt) do { __builtin_amdgcn_s_setprio(1); _Pragma("unroll") for (int m = 0; m < 4; ++m) _Pragma("unroll") for (int n = 0; n < 2; ++n) _Pragma("unroll") for (int k = 0; k < 2; ++k) \
        acc[ai][bj][m][n] = __builtin_amdgcn_mfma_f32_16x16x32_bf16(Bt[n][k], At[m][k], acc[ai][bj][m][n], 0, 0, 0); __builtin_amdgcn_s_setprio(0); } while (0)
#define PG8_WAIT_V(n) asm volatile("s_waitcnt vmcnt(" #n ")" ::: "memory")
#define PG8_WAIT_L(n) asm volatile("s_waitcnt lgkmcnt(" #n ")" ::: "memory")
#define PG8_BAR __builtin_amdgcn_s_barrier()
#define PG8_SCHED __builtin_amdgcn_sched_barrier(0)
    Unit cur, nxt; int ui = 0;
    if (!S.next(0, cur)) return;
    Acc acc;
#pragma unroll
    for (int a = 0; a < 2; ++a)
#pragma unroll
        for (int b = 0; b < 2; ++b)
#pragma unroll
            for (int m = 0; m < 4; ++m)
#pragma unroll
                for (int n = 0; n < 2; ++n) acc[a][b][m][n] = (f32x4){0.f, 0.f, 0.f, 0.f};
    bf16x8 At[4][2], B0[2][2], B1[2][2];
    const char* cA = (const char*)g.A + (size_t)cur.pm * tstepA; const char* cB = (const char*)g.Bt + (size_t)cur.pn * tstepB;
    PG8_STAGE(PG8_SB(0, 0), cB, voffB); PG8_STAGE(PG8_SB(0, 1), cB + hstepB, voffB); PG8_STAGE_A0(PG8_SA(0, 0), cA); PG8_STAGE_A1(PG8_SA(0, 1), cA);
    if (wr == 1) PG8_BAR;
    PG8_WAIT_V(2); PG8_BAR;
    PG8_STAGE(PG8_SB(1, 0), cB + kstep, voffB); PG8_STAGE_A0(PG8_SA(1, 0), cA + kstep); PG8_STAGE(PG8_SB(1, 1), cB + hstepB + kstep, voffB);
    PG8_WAIT_V(6); PG8_BAR;
    for (;;) {
        const bool has_next = S.next(ui + 1, nxt);
        const char* nA = has_next ? (const char*)g.A + (size_t)nxt.pm * tstepA : cA; const char* nB = has_next ? (const char*)g.Bt + (size_t)nxt.pn * tstepB : cB;
        for (int t = 0; t < nt; t += 2) {
            if constexpr (HOOK) { if (t == nt / 2) { E.hook(acc, cur, wr, wc, fr, fq); PG8_SCHED; } }
            const bool last = (t == nt - 2);
            const char* a1 = cA + (size_t)(t + 1) * kstep;
            const char* a2 = last ? nA : cA + (size_t)(t + 2) * kstep; const char* b2 = last ? nB : cB + (size_t)(t + 2) * kstep;
            const char* a3 = a2 + kstep; const char* b3 = b2 + kstep;
            PG8_LDB(B0, 0, 0); PG8_LDB(B1, 0, 1); PG8_SCHED; PG8_LDA(At, 0, 0); PG8_STAGE_A1(PG8_SA(1, 1), a1);
            PG8_WAIT_V(8); PG8_WAIT_L(0); PG8_BAR; PG8_MMA(0, 0, At, B0); PG8_MMA(0, 1, At, B1); PG8_BAR; PG8_SCHED;
            PG8_LDA(At, 0, 1); PG8_STAGE(PG8_SB(0, 0), b2, voffB); PG8_STAGE(PG8_SB(0, 1), b2 + hstepB, voffB); PG8_STAGE_A0(PG8_SA(0, 0), a2);
            PG8_WAIT_V(8); PG8_WAIT_L(0); PG8_BAR; PG8_MMA(1, 0, At, B0); PG8_MMA(1, 1, At, B1); PG8_BAR; PG8_SCHED;
            PG8_LDB(B0, 1, 0); PG8_LDB(B1, 1, 1); PG8_SCHED; PG8_LDA(At, 1, 0); PG8_STAGE_A1(PG8_SA(0, 1), a2);
            PG8_WAIT_V(8); PG8_WAIT_L(0); PG8_BAR; PG8_MMA(0, 0, At, B0); PG8_MMA(0, 1, At, B1); PG8_BAR; PG8_SCHED;
            PG8_LDA(At, 1, 1); PG8_STAGE(PG8_SB(1, 0), b3, voffB); PG8_STAGE(PG8_SB(1, 1), b3 + hstepB, voffB); PG8_STAGE_A0(PG8_SA(1, 0), a3);
            PG8_WAIT_V(8); PG8_WAIT_L(0); PG8_BAR; PG8_MMA(1, 0, At, B0); PG8_MMA(1, 1, At, B1); PG8_BAR; PG8_SCHED;
        }
        if (wr == 0) PG8_BAR;
        E(acc, cur, wr, wc, fr, fq);
        if (!has_next) break;
#pragma unroll
        for (int a = 0; a < 2; ++a)
#pragma unroll
            for (int b = 0; b < 2; ++b)
#pragma unroll
                for (int m = 0; m < 4; ++m)
#pragma unroll
                    for (int n = 0; n < 2; ++n) acc[a][b][m][n] = (f32x4){0.f, 0.f, 0.f, 0.f};
        cur = nxt; cA = nA; cB = nB; ++ui;
        if (wr == 1) PG8_BAR;
    }
    PG8_WAIT_V(0);
    PG8_BAR;
#undef PG8_SA
#undef PG8_SB
#undef PG8_STAGE
#undef PG8_STAGE_A0
#undef PG8_STAGE_A1
#undef PG8_LDA
#undef PG8_LDB
#undef PG8_MMA
#undef PG8_WAIT_V
#undef PG8_WAIT_L
#undef PG8_BAR
#undef PG8_SCHED
}

__device__ __forceinline__ void store16_wt(void* p, u32x4 v) { asm volatile("global_store_dwordx4 %0, %1, off sc1\n\ts_nop 1" :: "v"(p), "v"(v) : "memory"); }
__device__ __forceinline__ u32x4 pack8(f32x4 a, f32x4 b) { u32x4 w; w.x = cvt_pk_bf16(a[0], a[1]); w.y = cvt_pk_bf16(a[2], a[3]); w.z = cvt_pk_bf16(b[0], b[1]); w.w = cvt_pk_bf16(b[2], b[3]); return w; }
__device__ __forceinline__ f32x4 sigmoid4(f32x4 v) { f32x4 r;
#pragma unroll
    for (int i = 0; i < 4; ++i) r[i] = __builtin_amdgcn_rcpf(1.f + __builtin_amdgcn_exp2f(-1.4426950408889634f * v[i])); return r; }

struct EpiInProj {
    bf16_t* QKV; bf16_t* G; const float* rope; float* NP;
    __device__ __forceinline__ void operator()(const Acc& acc, const Unit& u, int wr, int wc, int fr, int fq) const {
        const int row0 = u.pm * BM + wr * 64 + fr;
        if (u.pn < 8) {
            const int g4 = 4 * (4 * wc + fq);
#pragma unroll
            for (int ai = 0; ai < 2; ++ai)
#pragma unroll
                for (int m = 0; m < 4; ++m) { const int r = row0 + ai * HALF + m * 16;
                    const f32x4 cs = *(const f32x4*)(rope + (size_t)r * 128 + g4), sn = *(const f32x4*)(rope + (size_t)r * 128 + 64 + g4);
#pragma unroll
                    for (int bj = 0; bj < 2; ++bj) { const f32x4 t1 = acc[ai][bj][m][0], t2 = acc[ai][bj][m][1];
                        const f32x4 o1 = t1 * cs - t2 * sn, o2 = t1 * sn + t2 * cs;
                        bf16_t* dst = QKV + (size_t)(2 * u.pn + bj) * QUS + (size_t)r * 128;
                        u32x2 w1, w2; w1.x = cvt_pk_bf16(o1[0], o1[1]); w1.y = cvt_pk_bf16(o1[2], o1[3]); w2.x = cvt_pk_bf16(o2[0], o2[1]); w2.y = cvt_pk_bf16(o2[2], o2[3]);
                        *(u32x2*)(dst + g4) = w1; *(u32x2*)(dst + 64 + g4) = w2; } }
        } else if (u.pn < 24) {
#pragma unroll
            for (int ai = 0; ai < 2; ++ai)
#pragma unroll
                for (int m = 0; m < 4; ++m) { const int r = row0 + ai * HALF + m * 16;
#pragma unroll
                    for (int bj = 0; bj < 2; ++bj) *(u32x4*)(QKV + (size_t)(2 * u.pn + bj) * QUS + (size_t)r * 128 + wc * 32 + 8 * fq) = pack8(acc[ai][bj][m][0], acc[ai][bj][m][1]); }
            if (u.pn >= 12 && u.pn < 20) {
#pragma unroll
                for (int ai = 0; ai < 2; ++ai)
#pragma unroll
                    for (int bj = 0; bj < 2; ++bj) { float mx = 0.f;
#pragma unroll
                        for (int m = 0; m < 4; ++m) { const f32x4 a = acc[ai][bj][m][0], b = acc[ai][bj][m][1];
                            float ss = (a[0] * a[0] + a[1] * a[1]) + (a[2] * a[2] + a[3] * a[3]) + (b[0] * b[0] + b[1] * b[1]) + (b[2] * b[2] + b[3] * b[3]);
                            ss += __shfl_xor(ss, 16); ss += __shfl_xor(ss, 32); mx = fmaxf(mx, ss); }
                        mx = fmaxf(mx, __shfl_xor(mx, 1)); mx = fmaxf(mx, __shfl_xor(mx, 2)); mx = fmaxf(mx, __shfl_xor(mx, 4)); mx = fmaxf(mx, __shfl_xor(mx, 8));
                        if (fr == 0 && fq == 0) NP[((size_t)(2 * u.pn + bj - 24) * 128 + 4 * u.pm + 2 * ai + wr) * 4 + wc] = mx; }
            }
        } else {
            const int col0 = (u.pn - 24) * BM + wc * 32 + 8 * fq;
#pragma unroll
            for (int ai = 0; ai < 2; ++ai)
#pragma unroll
                for (int m = 0; m < 4; ++m) { const int r = row0 + ai * HALF + m * 16;
#pragma unroll
                    for (int bj = 0; bj < 2; ++bj) *(u32x4*)(G + (size_t)r * 4096 + col0 + bj * HALF) = pack8(sigmoid4(acc[ai][bj][m][0]), sigmoid4(acc[ai][bj][m][1])); }
        }
    }
};
struct EpiGateT {
    float* T; const bf16_t* G;
    __device__ __forceinline__ void operator()(const Acc& acc, const Unit& u, int wr, int wc, int fr, int fq) const {
        const int row0 = u.pm * BM + wr * 64 + fr, col0 = u.pn * BM + wc * 32 + 8 * fq;
#pragma unroll
        for (int ai = 0; ai < 2; ++ai)
#pragma unroll
            for (int m = 0; m < 4; ++m) { const int r = row0 + ai * HALF + m * 16;
#pragma unroll
                for (int bj = 0; bj < 2; ++bj) { const int c = col0 + bj * HALF; const u32x4 gw = *(const u32x4*)(G + (size_t)r * 4096 + c);
                    const f32x4 g0 = {bf_lo(gw.x), bf_hi(gw.x), bf_lo(gw.y), bf_hi(gw.y)}, g1 = {bf_lo(gw.z), bf_hi(gw.z), bf_lo(gw.w), bf_hi(gw.w)};
                    *(f32x4*)(T + (size_t)r * DM + c) = acc[ai][bj][m][0] * g0; *(f32x4*)(T + (size_t)r * DM + c + 4) = acc[ai][bj][m][1] * g1; } }
    }
};
struct EpiGateM {
    const float* T; const bf16_t* G; bf16_t* MB;
    __device__ __forceinline__ void operator()(const Acc& acc, const Unit& u, int wr, int wc, int fr, int fq) const {
        const int row0 = u.pm * BM + wr * 64 + fr, col0 = u.pn * BM + wc * 32 + 8 * fq;
#pragma unroll
        for (int ai = 0; ai < 2; ++ai)
#pragma unroll
            for (int m = 0; m < 4; ++m) { const int r = row0 + ai * HALF + m * 16;
#pragma unroll
                for (int bj = 0; bj < 2; ++bj) { const int c = col0 + bj * HALF; const u32x4 gw = *(const u32x4*)(G + (size_t)r * 4096 + 2048 + c);
                    const f32x4 g0 = {bf_lo(gw.x), bf_hi(gw.x), bf_lo(gw.y), bf_hi(gw.y)}, g1 = {bf_lo(gw.z), bf_hi(gw.z), bf_lo(gw.w), bf_hi(gw.w)};
                    const f32x4 t0 = *(const f32x4*)(T + (size_t)r * DM + c), t1 = *(const f32x4*)(T + (size_t)r * DM + c + 4);
                    *(u32x4*)(MB + (size_t)r * DM + c) = pack8(t0 + acc[ai][bj][m][0] * g0, t1 + acc[ai][bj][m][1] * g1); } }
    }
};
struct EpiGateHook {
    const bf16_t* G; bf16_t* MB;
    __device__ __forceinline__ void hook(Acc& acc, const Unit& u, int wr, int wc, int fr, int fq) const {
        int row0 = u.pm * BM + wr * 64 + fr, col0 = u.pn * BM + wc * 32 + 8 * fq;
        asm volatile("" : "+v"(row0), "+v"(col0));
#pragma unroll
        for (int ai = 0; ai < 2; ++ai)
#pragma unroll
            for (int m = 0; m < 4; ++m) { int r = row0 + ai * HALF + m * 16; asm volatile("" : "+v"(r));
#pragma unroll
                for (int bj = 0; bj < 2; ++bj) { const int c = col0 + bj * HALF; const u32x4 gd = *(const u32x4*)(G + (size_t)r * 4096 + c), gf = *(const u32x4*)(G + (size_t)r * 4096 + 2048 + c);
                    const f32x4 d0 = {bf_lo(gd.x), bf_hi(gd.x), bf_lo(gd.y), bf_hi(gd.y)}, d1 = {bf_lo(gd.z), bf_hi(gd.z), bf_lo(gd.w), bf_hi(gd.w)};
                    f32x4 f0 = {bf_lo(gf.x), bf_hi(gf.x), bf_lo(gf.y), bf_hi(gf.y)}, f1 = {bf_lo(gf.z), bf_hi(gf.z), bf_lo(gf.w), bf_hi(gf.w)};
#pragma unroll
                    for (int i = 0; i < 4; ++i) { f0[i] = __builtin_amdgcn_rcpf(fmaxf(f0[i], 1e-30f)); f1[i] = __builtin_amdgcn_rcpf(fmaxf(f1[i], 1e-30f)); }
                    acc[ai][bj][m][0] = acc[ai][bj][m][0] * (d0 * f0); acc[ai][bj][m][1] = acc[ai][bj][m][1] * (d1 * f1); }
                asm volatile("" ::: "memory"); }
    }
    __device__ __forceinline__ void operator()(const Acc& acc, const Unit& u, int wr, int wc, int fr, int fq) const {
        const int row0 = u.pm * BM + wr * 64 + fr, col0 = u.pn * BM + wc * 32 + 8 * fq;
#pragma unroll
        for (int ai = 0; ai < 2; ++ai)
#pragma unroll
            for (int m = 0; m < 4; ++m) { const int r = row0 + ai * HALF + m * 16;
#pragma unroll
                for (int bj = 0; bj < 2; ++bj) { const int c = col0 + bj * HALF; const u32x4 gw = *(const u32x4*)(G + (size_t)r * 4096 + 2048 + c);
                    const f32x4 g0 = {bf_lo(gw.x), bf_hi(gw.x), bf_lo(gw.y), bf_hi(gw.y)}, g1 = {bf_lo(gw.z), bf_hi(gw.z), bf_lo(gw.w), bf_hi(gw.w)};
                    *(u32x4*)(MB + (size_t)r * DM + c) = pack8(acc[ai][bj][m][0] * g0, acc[ai][bj][m][1] * g1); } }
    }
};
struct EpiZ {
    bf16_t* YO;
    __device__ __forceinline__ void operator()(const Acc& acc, const Unit& u, int wr, int wc, int fr, int fq) const {
        const int row0 = u.pm * BM + wr * 64 + fr, col0 = u.pn * BM + wc * 32 + 8 * fq;
#pragma unroll
        for (int ai = 0; ai < 2; ++ai)
#pragma unroll
            for (int m = 0; m < 4; ++m) { const int r = row0 + ai * HALF + m * 16;
#pragma unroll
                for (int bj = 0; bj < 2; ++bj) *(u32x4*)(YO + (size_t)r * DM + col0 + bj * HALF) = pack8(acc[ai][bj][m][0], acc[ai][bj][m][1]); }
    }
};
struct EpiSwiGLU {
    bf16_t* H;
    __device__ __forceinline__ void operator()(const Acc& acc, const Unit& u, int wr, int wc, int fr, int fq) const {
        const int row0 = u.pm * BM + wr * 64 + fr, col0 = u.pn * HALF + wc * 32 + 8 * fq;
#pragma unroll
        for (int ai = 0; ai < 2; ++ai)
#pragma unroll
            for (int m = 0; m < 4; ++m) { const int r = row0 + ai * HALF + m * 16; f32x4 h[2];
#pragma unroll
                for (int n = 0; n < 2; ++n) { const f32x4 gt = acc[ai][0][m][n], up = acc[ai][1][m][n]; h[n] = gt * sigmoid4(gt) * up; }
                store16_wt(H + (size_t)r * FF + col0, pack8(h[0], h[1])); }
    }
};
struct EpiY {
    bf16_t* Y;
    __device__ __forceinline__ void operator()(const Acc& acc, const Unit& u, int wr, int wc, int fr, int fq) const {
        const int row0 = u.pm * BM + wr * 64 + fr, col0 = (u.pn & 7) * BM + wc * 32 + 8 * fq;
#pragma unroll
        for (int ai = 0; ai < 2; ++ai)
#pragma unroll
            for (int m = 0; m < 4; ++m) { unsigned bo = (unsigned)((row0 + ai * HALF + m * 16) * DM + col0) * 2u; asm volatile("" : "+v"(bo));
#pragma unroll
                for (int bj = 0; bj < 2; ++bj) *(u32x4*)((char*)Y + bo + bj * HALF * 2) = pack8(acc[ai][bj][m][0], acc[ai][bj][m][1]); }
    }
};
}

namespace att {
using bf16 = __hip_bfloat16;
constexpr int D = 128, NW = 8, QBLK = 32, KVBLK = 64, QB = NW * QBLK;
constexpr int SHM_V = KVBLK * D * 2, SHM_K = KVBLK * D * 2;
constexpr int LDS_WS_OFF = 2 * SHM_V + 2 * SHM_K, LDS_BIAS_OFF = LDS_WS_OFF + NW * 64 * 4, LDS_BYTES = LDS_BIAS_OFF + 512;
constexpr float SCALE = 0.08838834764831845f;
constexpr float THR = 8.f;
#define KSWZ(row, colB) ((row) * 256 + ((colB) ^ (((row) & 7) << 4)))
#define SBAR() __builtin_amdgcn_sched_barrier(0)
__device__ __forceinline__ int v_st(int k, int c) { const int kk = (k & ~0xC) | ((k & 4) << 1) | ((k & 8) >> 1); return ((kk >> 3) * 4 + (c >> 5)) * 512 + ((kk & 7) * 32 + (c & 31)) * 2; }
__device__ __forceinline__ int v_rd_base(int lane) { return ((lane & 3) << 3) | (((lane >> 2) & 3) << 6) | (((lane >> 4) & 1) << 5) | (((lane >> 5) & 1) << 8); }
constexpr int v_rd_off(int d0, int ks, int half) { return d0 * 512 + ks * 4096 + half * 2048; }
__device__ __forceinline__ int crow(int r, int hi) { return (r & 3) + 8 * (r >> 2) + 4 * hi; }
__device__ __forceinline__ unsigned cvtpk(float lo, float hi) { unsigned r; asm volatile("v_cvt_pk_bf16_f32 %0, %1, %2" : "=v"(r) : "v"(lo), "v"(hi)); return r; }
__device__ __forceinline__ bf16x8 load8(const bf16* p) { return *reinterpret_cast<const bf16x8*>(p); }
__device__ __forceinline__ void mask_tile(f32x16& p0, f32x16& p1, int dq) {
    const float NEG = -__builtin_inff();
#pragma unroll
    for (int r = 0; r < 16; ++r) { const int c = (r & 3) + 8 * (r >> 2); if (dq - c < 0) p0[r] = NEG; if (dq - c - 32 < 0) p1[r] = NEG; }
}
__device__ __forceinline__ void partialSM(f32x16& p0, f32x16& p1, float& m_reg, float& mn, float& alpha) {
    float pmax = p0[0];
#pragma unroll
    for (int r = 1; r < 16; ++r) pmax = fmaxf(pmax, p0[r]);
#pragma unroll
    for (int r = 0; r < 16; ++r) pmax = fmaxf(pmax, p1[r]);
    { auto rr = __builtin_amdgcn_permlane32_swap(__float_as_uint(pmax), __float_as_uint(pmax), false, false); pmax = fmaxf(__uint_as_float(rr[0]), __uint_as_float(rr[1])); }
    constexpr float C2 = 1.4426950408889634f * SCALE;
    if (__builtin_expect(__all((pmax - m_reg) * SCALE <= THR), 1)) { mn = m_reg; alpha = 1.f; }
    else { mn = fmaxf(m_reg, pmax); alpha = __builtin_amdgcn_exp2f((m_reg - mn) * C2); m_reg = mn; }
    const float mnL = -mn * C2;
#pragma unroll
    for (int r = 0; r < 16; ++r) p0[r] = fmaf(p0[r], C2, mnL);
#pragma unroll
    for (int r = 0; r < 16; ++r) p1[r] = fmaf(p1[r], C2, mnL);
#pragma unroll
    for (int r = 0; r < 16; ++r) p0[r] = __builtin_amdgcn_exp2f(p0[r]);
}
__device__ __forceinline__ void finishSM(f32x16& p0, f32x16& p1, float alpha, float& l_reg, bf16x8& pa0, bf16x8& pa1, bf16x8& pa2, bf16x8& pa3) {
#pragma unroll
    for (int r = 0; r < 16; ++r) p1[r] = __builtin_amdgcn_exp2f(p1[r]);
    float ps = 0;
#pragma unroll
    for (int r = 0; r < 16; ++r) ps += p0[r];
#pragma unroll
    for (int r = 0; r < 16; ++r) ps += p1[r];
    { auto rr = __builtin_amdgcn_permlane32_swap(__float_as_uint(ps), __float_as_uint(ps), false, false); ps = __uint_as_float(rr[0]) + __uint_as_float(rr[1]); }
    l_reg = l_reg * alpha + ps;
#define PK4(P, B_, OUT) do { unsigned a0 = cvtpk(P[B_+0], P[B_+1]), a1 = cvtpk(P[B_+2], P[B_+3]);                          \
        unsigned b0 = cvtpk(P[B_+4], P[B_+5]), b1 = cvtpk(P[B_+6], P[B_+7]);                                             \
        auto r0 = __builtin_amdgcn_permlane32_swap(a0, b0, false, false); auto r1 = __builtin_amdgcn_permlane32_swap(a1, b1, false, false); \
        u32x4 w = {r0[0], r1[0], r0[1], r1[1]}; OUT = *reinterpret_cast<bf16x8*>(&w); } while (0)
    PK4(p0, 0, pa0); PK4(p0, 8, pa1); PK4(p1, 0, pa2); PK4(p1, 8, pa3);
#undef PK4
}
template <int KB>
__device__ __forceinline__ void qkt(f32x16& p0, f32x16& p1, const char* K_lds, const char* B_lds, int r32, int hi, const bf16x8* qr) {
    const float* bl = (const float*)(B_lds + KB * 256) + 4 * hi;
#pragma unroll
    for (int g = 0; g < 4; ++g) { const f32x4 b0 = *(const f32x4*)(bl + 8 * g), b1 = *(const f32x4*)(bl + 32 + 8 * g);
#pragma unroll
        for (int i = 0; i < 4; ++i) { p0[4 * g + i] = b0[i]; p1[4 * g + i] = b1[i]; } }
    const char* kb[4];
#pragma unroll
    for (int dd = 0; dd < 4; ++dd) kb[dd] = K_lds + KB * SHM_K + KSWZ(r32, (dd * 16 + hi * 8) * 2);
#pragma unroll
    for (int d0 = 0; d0 < 8; ++d0) { const char* a = kb[d0 & 3] + (d0 >> 2) * 128;
        bf16x8 b0 = *reinterpret_cast<const bf16x8*>(a);
        bf16x8 b1 = *reinterpret_cast<const bf16x8*>(a + 32 * 256);
        p0 = __builtin_amdgcn_mfma_f32_32x32x16_bf16(b0, qr[d0], p0, 0, 0, 0);
        p1 = __builtin_amdgcn_mfma_f32_32x32x16_bf16(b1, qr[d0], p1, 0, 0, 0); }
}
template <int VB>
__device__ __forceinline__ void pv_tile(f32x16* o, int vb0, bf16x8 pa0, bf16x8 pa1, bf16x8 pa2, bf16x8 pa3) {
#define TRRD(dst, off) asm volatile("ds_read_b64_tr_b16 %0, %1 offset:%2" : "=&v"(dst) : "v"(vb0), "i"(off) : "memory")
#define PV_D0(d0) do { s16x4 l0, l1, l2, l3, h0, h1, h2, h3; constexpr int b_ = VB * SHM_V + v_rd_off(d0, 0, 0); \
        TRRD(l0, b_); TRRD(h0, b_ + 2048); TRRD(l1, b_ + 4096); TRRD(h1, b_ + 6144); TRRD(l2, b_ + 8192); TRRD(h2, b_ + 10240); TRRD(l3, b_ + 12288); TRRD(h3, b_ + 14336); \
        asm volatile("s_waitcnt lgkmcnt(0)" ::: "memory"); SBAR();   \
        o[d0] = __builtin_amdgcn_mfma_f32_32x32x16_bf16(pa0, (bf16x8){l0[0], l0[1], l0[2], l0[3], h0[0], h0[1], h0[2], h0[3]}, o[d0], 0, 0, 0);   \
        o[d0] = __builtin_amdgcn_mfma_f32_32x32x16_bf16(pa1, (bf16x8){l1[0], l1[1], l1[2], l1[3], h1[0], h1[1], h1[2], h1[3]}, o[d0], 0, 0, 0);   \
        o[d0] = __builtin_amdgcn_mfma_f32_32x32x16_bf16(pa2, (bf16x8){l2[0], l2[1], l2[2], l2[3], h2[0], h2[1], h2[2], h2[3]}, o[d0], 0, 0, 0);   \
        o[d0] = __builtin_amdgcn_mfma_f32_32x32x16_bf16(pa3, (bf16x8){l3[0], l3[1], l3[2], l3[3], h3[0], h3[1], h3[2], h3[3]}, o[d0], 0, 0, 0); } while (0)
    PV_D0(0); PV_D0(1); PV_D0(2); PV_D0(3);
#undef PV_D0
#undef TRRD
}
struct BlockRef { const bf16* Q; const bf16* K; const bf16* V; const float* B; bf16* O; int ostride; int P0; int jlo; };
struct Seam { bf16x8 qr[8]; bf16x8 st_v0, st_v1, st_k0, st_k1; };
#define ROW(p, k0, rr) ((p) + (size_t)((k0) + (rr)) * D + sc)
#define VMW() asm volatile("s_waitcnt vmcnt(0)" ::: "memory")
#define VMWN(n) asm volatile("s_waitcnt vmcnt(%0)" :: "i"(n) : "memory")
#define SLOAD_H(Kp, Vp, k0) do { S.st_v0 = load8(ROW(Vp, k0, sr)); S.st_v1 = load8(ROW(Vp, k0, 32 + sr));              \
                         S.st_k0 = load8(ROW(Kp, k0, sr)); S.st_k1 = load8(ROW(Kp, k0, 32 + sr)); } while (0)
#define BLOAD(Bp, k0, bf) do { if (wid == 0) __builtin_amdgcn_global_load_lds((const unsigned*)((Bp) + (k0) + lane), (LAS unsigned*)(lds3 + LDS_BIAS_OFF + (bf) * 256), 4, 0, 0); } while (0)
#define SWRITE_HK(bf) do { *(bf16x8*)(K_lds + (bf) * SHM_K + kws) = S.st_k0; *(bf16x8*)(K_lds + (bf) * SHM_K + kws + 32 * 256) = S.st_k1; } while (0)
#define SWRITE_HV(bf) do { *(bf16x8*)(V_lds + (bf) * SHM_V + vst0) = S.st_v0; *(bf16x8*)(V_lds + (bf) * SHM_V + vst1) = S.st_v1; } while (0)
#define SWRITE_H(bf) do { SWRITE_HV(bf); SWRITE_HK(bf); } while (0)
__device__ __forceinline__ void attn_prime(const BlockRef& cur, char* lds, LAS unsigned char* lds3, Seam& S) {
    int tid = threadIdx.x; asm volatile("" : "+v"(tid)); const int wid = __builtin_amdgcn_readfirstlane(tid >> 6), lane = tid & 63, r32 = lane & 31, hi = lane >> 5;
    const int sr = tid >> 4, sc = (tid & 15) * 8, kws = KSWZ(sr, sc * 2); char* K_lds = lds + 2 * SHM_V;
#pragma unroll
    for (int d0 = 0; d0 < 8; ++d0) S.qr[d0] = load8(cur.Q + (size_t)(wid * QBLK + r32) * D + d0 * 16 + hi * 8);
    SLOAD_H(cur.K, cur.V, 0); BLOAD(cur.B, 0, 0); VMW(); SWRITE_HK(0);
    __syncthreads();
}
__device__ __forceinline__ void attn_block(const BlockRef& cur, const BlockRef& nxt, char* lds, LAS unsigned char* lds3, Seam& S) {
    int tid = threadIdx.x; asm volatile("" : "+v"(tid)); const int wid = __builtin_amdgcn_readfirstlane(tid >> 6), lane = tid & 63, r32 = lane & 31, hi = lane >> 5;
    const int NT = (cur.P0 + QB) / KVBLK - cur.jlo;
    const int qlo = cur.P0 + wid * QBLK, qm = qlo + r32 - 4 * hi;
    char* V_lds = lds; char* K_lds = lds + 2 * SHM_V; const char* B_lds = lds + LDS_BIAS_OFF;
    float* ws = (float*)(lds + LDS_WS_OFF) + wid * 64; float* li_l = ws, * al_l = ws + 32;
    float m_reg = -1e30f, l_reg = 0; f32x16 o[4] = {};
    const int sr = tid >> 4, sc = (tid & 15) * 8, vst0 = v_st(sr, sc), vst1 = v_st(32 + sr, sc), kws = KSWZ(sr, sc * 2);
    const int vb0 = (int)(uintptr_t)V_lds + v_rd_base(lane);
    const bf16* Kh = cur.K; const bf16* Vh = cur.V; const float* Bh = cur.B;
#define RESC(a) do { if (__any((a) < 1.f)) { if (hi == 0) al_l[r32] = (a); asm volatile("s_waitcnt lgkmcnt(0)" ::: "memory");              \
                     _Pragma("unroll") for (int d_ = 0; d_ < 4; ++d_) _Pragma("unroll") for (int r = 0; r < 16; ++r) o[d_][r] *= al_l[crow(r, hi)]; } } while (0)
#define KBASE(t) ((t) * KVBLK)
#define MASKT(P0_, P1_, t) do { const int kb_ = KBASE((t) + cur.jlo); if (kb_ + KVBLK - 1 > qlo) mask_tile(P0_, P1_, qm - kb_); } while (0)
    f32x16 pA0, pA1, pB0, pB1; float mnA, mnB, alA, alB; bf16x8 pa0, pa1, pa2, pa3;
    SWRITE_HV(0); SBAR();
    SLOAD_H(Kh, Vh, KBASE(1)); BLOAD(Bh, KBASE(1), 1);
    SBAR(); qkt<0>(pA0, pA1, K_lds, B_lds, r32, hi, S.qr);
    MASKT(pA0, pA1, 0); partialSM(pA0, pA1, m_reg, mnA, alA);
    VMW(); SWRITE_H(1);
    __syncthreads();
#define HALF_STEP(PX0, PX1, mnX, alX, PY0, PY1, alY, t, KB, VB, SB) do {                                                      \
        SBAR(); qkt<KB>(PX0, PX1, K_lds, B_lds, r32, hi, S.qr);                                                               \
        finishSM(PY0, PY1, alY, l_reg, pa0, pa1, pa2, pa3); SBAR();                                                           \
        if ((t) + 1 < NT) { SLOAD_H(Kh, Vh, KBASE((t) + 1)); BLOAD(Bh, KBASE((t) + 1), SB); SBAR(); }                        \
        pv_tile<VB>(o, vb0, pa0, pa1, pa2, pa3); MASKT(PX0, PX1, (t)); partialSM(PX0, PX1, m_reg, mnX, alX);                  \
        __syncthreads();                                                                                                      \
        if ((t) + 1 < NT) { VMW(); SWRITE_H(SB); }                                                                            \
        RESC(alX); __syncthreads(); } while (0)
    for (int t = 1; t + 1 < NT; t += 2) {
        HALF_STEP(pB0, pB1, mnB, alB, pA0, pA1, alA, t, 1, 0, 0);
        HALF_STEP(pA0, pA1, mnA, alA, pB0, pB1, alB, t + 1, 0, 1, 1);
    }
    SBAR(); qkt<1>(pB0, pB1, K_lds, B_lds, r32, hi, S.qr); SBAR();
    SLOAD_H(nxt.K, nxt.V, 0); BLOAD(nxt.B, 0, 0); SBAR();
#pragma unroll
    for (int d0 = 0; d0 < 8; ++d0) S.qr[d0] = load8(nxt.Q + (size_t)(wid * QBLK + r32) * D + d0 * 16 + hi * 8);
    SBAR();
    finishSM(pA0, pA1, alA, l_reg, pa0, pa1, pa2, pa3); SBAR();
    pv_tile<0>(o, vb0, pa0, pa1, pa2, pa3);
    MASKT(pB0, pB1, NT - 1); partialSM(pB0, pB1, m_reg, mnB, alB); __syncthreads(); RESC(alB);
    finishSM(pB0, pB1, alB, l_reg, pa0, pa1, pa2, pa3); SBAR(); pv_tile<1>(o, vb0, pa0, pa1, pa2, pa3);
    SBAR(); VMWN(8); SWRITE_HK(0); SBAR();
    if (hi == 0) li_l[r32] = l_reg; asm volatile("s_waitcnt lgkmcnt(0)" ::: "memory");
    float rli[16];
#pragma unroll
    for (int r = 0; r < 16; ++r) rli[r] = __builtin_amdgcn_rcpf(li_l[crow(r, hi)]);
    bf16* Ow = cur.O + (size_t)(wid * QBLK) * cur.ostride;
#pragma unroll
    for (int r = 0; r < 16; ++r) { const int orow = crow(r, hi);
#pragma unroll
        for (int d0 = 0; d0 < 4; ++d0) { const float v = o[d0][r] * rli[r];
            const float vn = __shfl_xor(v, 1);
            if ((r32 & 1) == 0) *(unsigned*)(Ow + (size_t)orow * cur.ostride + d0 * 32 + r32) = cvtpk(v, vn); } }
    __syncthreads();
#undef RESC
#undef KBASE
#undef MASKT
#undef HALF_STEP
}

constexpr int DV1_OFF = 32768, DK_OFF = 65536, DP_OFF = 98304, DWS_OFF = 131072, DATT_LDS_END = DWS_OFF + 2048;
struct DRef { const bf16* Q; const bf16* K; const bf16* V0; const bf16* V1; bf16* O0; bf16* O1; int P0; };
template <int KB>
__device__ __forceinline__ void qkt0(f32x16& p0, f32x16& p1, const char* K_lds, int r32, int hi, const bf16x8* qr) {
    p0 = f32x16{}; p1 = f32x16{};
    const char* kb[4];
#pragma unroll
    for (int dd = 0; dd < 4; ++dd) kb[dd] = K_lds + KB * SHM_K + KSWZ(r32, (dd * 16 + hi * 8) * 2);
#pragma unroll
    for (int d0 = 0; d0 < 8; ++d0) { const char* a = kb[d0 & 3] + (d0 >> 2) * 128;
        bf16x8 b0 = *reinterpret_cast<const bf16x8*>(a);
        bf16x8 b1 = *reinterpret_cast<const bf16x8*>(a + 32 * 256);
        p0 = __builtin_amdgcn_mfma_f32_32x32x16_bf16(b0, qr[d0], p0, 0, 0, 0);
        p1 = __builtin_amdgcn_mfma_f32_32x32x16_bf16(b1, qr[d0], p1, 0, 0, 0); }
}
#define D_KLOAD(Kp, k0) do { _Pragma("unroll") for (int j_ = 0; j_ < 4; ++j_) kst[j_] = load8((Kp) + (size_t)((k0) + sr + 16 * j_) * D + sc); } while (0)
#define D_KWRITE(bf) do { _Pragma("unroll") for (int j_ = 0; j_ < 4; ++j_) *(bf16x8*)(K_lds + (bf) * SHM_K + kws + j_ * 4096) = kst[j_]; } while (0)
#define D_VLOAD(V0p, V1p, k0) do { unsigned vo_ = (unsigned)(sr * D + sc) * 2u; asm volatile("" : "+v"(vo_));   \
        _Pragma("unroll") for (int j_ = 0; j_ < 4; ++j_) { vs[j_] = load8((const bf16*)((const char*)((V0p) + (size_t)((k0) + 16 * j_) * D) + vo_)); vs[4 + j_] = load8((const bf16*)((const char*)((V1p) + (size_t)((k0) + 16 * j_) * D) + vo_)); } } while (0)
#define D_VWRITE(sl_) do { int sr_ = sr; asm volatile("" : "+v"(sr_)); _Pragma("unroll") for (int j_ = 0; j_ < 4; ++j_) { const int vs_ = v_st(sr_ + 16 * j_, sc); *(bf16x8*)(V_lds + (sl_) * SHM_V + vs_) = vs[j_]; *(bf16x8*)(V1_lds + (sl_) * SHM_V + vs_) = vs[4 + j_]; } } while (0)
#define D_PEXPORT(pb_) do { bf16x8* pp_ = (bf16x8*)(P_lds + (pb_) * 16384) + lane; pp_[0] = pa0; pp_[64] = pa1; pp_[128] = pa2; pp_[192] = pa3; } while (0)
#define D_PIMPORT(pb_) do { const bf16x8* pp_ = (const bf16x8*)(P_lds + (pb_) * 16384) + lane; pa0 = pp_[0]; pa1 = pp_[64]; pa2 = pp_[128]; pa3 = pp_[192]; } while (0)
#define D_AEXPORT(par, a) do { if (hi == 0) al_l[(par) * 32 + r32] = (a); } while (0)
#define D_RESC(par) do { const float* ap_ = al_l + (par) * 32; const float a_ = ap_[r32]; if (__any(a_ < 1.f)) { _Pragma("unroll") for (int d_ = 0; d_ < 4; ++d_) _Pragma("unroll") for (int r = 0; r < 16; ++r) { const float f_ = ap_[crow(r, hi)]; o0[d_][r] *= f_; o1[d_][r] *= f_; } } } while (0)
#define D_OSTORE(Op, oo) do { int rq_ = r32, hq_ = hi; asm volatile("" : "+v"(rq_), "+v"(hq_));   bf16* Ow = (Op) + (size_t)((wid & 3) * QBLK) * D + rq_; \
        _Pragma("unroll") for (int r = 0; r < 16; ++r) { const int orow = crow(r, hq_); \
            const float rl_ = __builtin_amdgcn_rcpf(li_l[orow]); \
            _Pragma("unroll") for (int d0 = 0; d0 < 4; ++d0) { const float v = oo[d0][r] * rl_; const float vn = __shfl_xor(v, 1); \
                if ((r32 & 1) == 0) *(unsigned*)(Ow + (size_t)orow * D + d0 * 32) = cvtpk(v, vn); } } } while (0)
__device__ __forceinline__ void pv_both(f32x16* o0, f32x16* o1, int vb0s, int vb1s, bf16x8 pa0, bf16x8 pa1, bf16x8 pa2, bf16x8 pa3) {
#define TRRD(dst, base, off) asm volatile("ds_read_b64_tr_b16 %0, %1 offset:%2" : "=&v"(dst) : "v"(base), "i"(off) : "memory")
#define TR8(P, base, d0) do { constexpr int b_ = v_rd_off(d0, 0, 0); TRRD(P##l0, base, b_); TRRD(P##h0, base, b_ + 2048); TRRD(P##l1, base, b_ + 4096); TRRD(P##h1, base, b_ + 6144); \
        TRRD(P##l2, base, b_ + 8192); TRRD(P##h2, base, b_ + 10240); TRRD(P##l3, base, b_ + 12288); TRRD(P##h3, base, b_ + 14336); } while (0)
#define MM4(P, acc) do { \
        acc = __builtin_amdgcn_mfma_f32_32x32x16_bf16(pa0, (bf16x8){P##l0[0], P##l0[1], P##l0[2], P##l0[3], P##h0[0], P##h0[1], P##h0[2], P##h0[3]}, acc, 0, 0, 0); \
        acc = __builtin_amdgcn_mfma_f32_32x32x16_bf16(pa1, (bf16x8){P##l1[0], P##l1[1], P##l1[2], P##l1[3], P##h1[0], P##h1[1], P##h1[2], P##h1[3]}, acc, 0, 0, 0); \
        acc = __builtin_amdgcn_mfma_f32_32x32x16_bf16(pa2, (bf16x8){P##l2[0], P##l2[1], P##l2[2], P##l2[3], P##h2[0], P##h2[1], P##h2[2], P##h2[3]}, acc, 0, 0, 0); \
        acc = __builtin_amdgcn_mfma_f32_32x32x16_bf16(pa3, (bf16x8){P##l3[0], P##l3[1], P##l3[2], P##l3[3], P##h3[0], P##h3[1], P##h3[2], P##h3[3]}, acc, 0, 0, 0); } while (0)
#define WAIT8() do { asm volatile("s_waitcnt lgkmcnt(8)" ::: "memory"); SBAR(); } while (0)
#define WAIT0() do { asm volatile("s_waitcnt lgkmcnt(0)" ::: "memory"); SBAR(); } while (0)
    s16x4 Al0, Al1, Al2, Al3, Ah0, Ah1, Ah2, Ah3, Bl0, Bl1, Bl2, Bl3, Bh0, Bh1, Bh2, Bh3;
    TR8(A, vb0s, 0);
    TR8(B, vb1s, 0); WAIT8(); MM4(A, o0[0]);
    TR8(A, vb0s, 1); WAIT8(); MM4(B, o1[0]);
    TR8(B, vb1s, 1); WAIT8(); MM4(A, o0[1]);
    TR8(A, vb0s, 2); WAIT8(); MM4(B, o1[1]);
    TR8(B, vb1s, 2); WAIT8(); MM4(A, o0[2]);
    TR8(A, vb0s, 3); WAIT8(); MM4(B, o1[2]);
    TR8(B, vb1s, 3); WAIT8(); MM4(A, o0[3]);
    WAIT0(); MM4(B, o1[3]);
#undef TRRD
#undef TR8
#undef MM4
#undef WAIT8
#undef WAIT0
}
__device__ __forceinline__ void pv_one(f32x16* o, int vbs, bf16x8 pa0, bf16x8 pa1, bf16x8 pa2, bf16x8 pa3) {
#define TRRD(dst, base, off) asm volatile("ds_read_b64_tr_b16 %0, %1 offset:%2" : "=&v"(dst) : "v"(base), "i"(off) : "memory")
#define TR8(P, base, d0) do { constexpr int b_ = v_rd_off(d0, 0, 0); TRRD(P##l0, base, b_); TRRD(P##h0, base, b_ + 2048); TRRD(P##l1, base, b_ + 4096); TRRD(P##h1, base, b_ + 6144); \
        TRRD(P##l2, base, b_ + 8192); TRRD(P##h2, base, b_ + 10240); TRRD(P##l3, base, b_ + 12288); TRRD(P##h3, base, b_ + 14336); } while (0)
#define MM4(P, acc) do { \
        acc = __builtin_amdgcn_mfma_f32_32x32x16_bf16(pa0, (bf16x8){P##l0[0], P##l0[1], P##l0[2], P##l0[3], P##h0[0], P##h0[1], P##h0[2], P##h0[3]}, acc, 0, 0, 0); \
        acc = __builtin_amdgcn_mfma_f32_32x32x16_bf16(pa1, (bf16x8){P##l1[0], P##l1[1], P##l1[2], P##l1[3], P##h1[0], P##h1[1], P##h1[2], P##h1[3]}, acc, 0, 0, 0); \
        acc = __builtin_amdgcn_mfma_f32_32x32x16_bf16(pa2, (bf16x8){P##l2[0], P##l2[1], P##l2[2], P##l2[3], P##h2[0], P##h2[1], P##h2[2], P##h2[3]}, acc, 0, 0, 0); \
        acc = __builtin_amdgcn_mfma_f32_32x32x16_bf16(pa3, (bf16x8){P##l3[0], P##l3[1], P##l3[2], P##l3[3], P##h3[0], P##h3[1], P##h3[2], P##h3[3]}, acc, 0, 0, 0); } while (0)
    s16x4 Al0, Al1, Al2, Al3, Ah0, Ah1, Ah2, Ah3, Bl0, Bl1, Bl2, Bl3, Bh0, Bh1, Bh2, Bh3;
    TR8(A, vbs, 0);
    TR8(B, vbs, 1); asm volatile("s_waitcnt lgkmcnt(8)" ::: "memory"); SBAR(); MM4(A, o[0]);
    TR8(A, vbs, 2); asm volatile("s_waitcnt lgkmcnt(8)" ::: "memory"); SBAR(); MM4(B, o[1]);
    TR8(B, vbs, 3); asm volatile("s_waitcnt lgkmcnt(8)" ::: "memory"); SBAR(); MM4(A, o[2]);
    asm volatile("s_waitcnt lgkmcnt(0)" ::: "memory"); SBAR(); MM4(B, o[3]);
#undef TRRD
#undef TR8
#undef MM4
}
struct DQueue { unsigned* ctr; volatile LAS unsigned* slot; const bf16* QKV; bf16* OD; int xcd; unsigned long long* stp; int half; };
constexpr int DS_ = 8192, DNITEM = 512;
__device__ __forceinline__ int dfetch(const DQueue& q, int& par, int tid) {
    if (tid == 0) { unsigned it_ = (unsigned)DNITEM;
        for (int k_ = 0; k_ < 8; ++k_) { const unsigned x_ = (unsigned)(q.xcd + k_) & 7u; const unsigned v_ = __hip_atomic_fetch_add(q.ctr + 64 * x_, 1u, __ATOMIC_RELAXED, __HIP_MEMORY_SCOPE_AGENT); if (v_ < 32u) { it_ = ((unsigned)q.half * 32u + v_) * 8u + x_; break; } }
        q.slot[par] = it_; }
    __syncthreads(); const int v = __builtin_amdgcn_readfirstlane((int)q.slot[par]); par ^= 1; return v;
}
__device__ __forceinline__ DRef dref_of(const DQueue& q, int item) {
    DRef r; const int m = item & 7, qb = 63 - (item >> 3);
    r.Q = q.QKV + (size_t)m * QUS + (size_t)(qb * 128) * 128; r.K = q.QKV + (size_t)(8 + m) * QUS;
    r.V0 = q.QKV + (size_t)(16 + (m >> 1) * 2) * QUS; r.V1 = r.V0 + QUS;
    r.O0 = q.OD + ((size_t)(2 * m) * DS_ + qb * 128) * 128; r.O1 = q.OD + ((size_t)(2 * m + 1) * DS_ + qb * 128) * 128; r.P0 = qb * 128; return r;
}
#define KBASE(t) ((t) * KVBLK)
__device__ __forceinline__ void dattn_S(char* lds, const DQueue& Q_) {
    int tid = threadIdx.x; asm volatile("" : "+v"(tid)); const int wid = __builtin_amdgcn_readfirstlane(tid >> 6), lane = tid & 63, r32 = lane & 31, hi = lane >> 5;
    const int t8 = tid & 255, sr = t8 >> 4, sc = (t8 & 15) * 8, kws = KSWZ(sr, sc * 2);
    char* K_lds = lds + DK_OFF; char* P_lds = lds + DP_OFF + (wid & 3) * 4096;
    float* ws = (float*)(lds + DWS_OFF) + (wid & 3) * 128; float* li_l = ws, * al_l = ws + 32;
    int par = 0; int item = dfetch(Q_, par, tid); if (item >= DNITEM) return;
    DRef cur = dref_of(Q_, item);
    bf16x8 qr[8], kst[4], pa0, pa1, pa2, pa3;
#pragma unroll
    for (int d0 = 0; d0 < 8; ++d0) qr[d0] = load8(cur.Q + (size_t)(wid * QBLK + r32) * D + d0 * 16 + hi * 8);
    D_KLOAD(cur.K, 0); VMW(); D_KWRITE(0); D_KLOAD(cur.K, KBASE(1));
    __syncthreads();
    for (;;) {
        bool more = false; DRef nxt = cur;
#define LATE_FETCH() do { const int nitem_ = dfetch(Q_, par, tid); more = nitem_ < DNITEM; if (more) nxt = dref_of(Q_, nitem_); } while (0)
        const int NT = (cur.P0 + 128) / KVBLK;
        const int qlo = cur.P0 + wid * QBLK, qm = qlo + r32 - 4 * hi;
        float m_reg = -1e30f, l_reg = 0; const bf16* Kh = cur.K;
        f32x16 pA0, pA1, pB0, pB1; float mnA, mnB, alA = 1.f, alB = 1.f;
#define MASKT(P0_, P1_, t) do { const int kb_ = KBASE(t); if (kb_ + KVBLK - 1 > qlo) mask_tile(P0_, P1_, qm - kb_); } while (0)
#define SSTEP(PX0, PX1, mnX, alX, PY0, PY1, mnY, alY, t, KB, FS) do {                                                              \
        VMW(); D_KWRITE((KB) ^ 1); SBAR();                                       \
        if ((t) + 2 < NT) { D_KLOAD(Kh, KBASE((t) + 2)); } else if ((t) + 2 == NT) { D_KLOAD(nxt.K, 0); }                     \
        SBAR(); qkt0<KB>(PX0, PX1, K_lds, r32, hi, qr);                                                                       \
        if (FS) { MASKT(PY0, PY1, (t) - 1); partialSM(PY0, PY1, m_reg, mnY, alY);          \
                  finishSM(PY0, PY1, alY, l_reg, pa0, pa1, pa2, pa3); D_PEXPORT((KB) ^ 1); D_AEXPORT((KB) ^ 1, alY); } SBAR(); \
        __syncthreads();                                                                                             \
        } while (0)
        if (NT == 2) LATE_FETCH();
        SSTEP(pA0, pA1, mnA, alA, pB0, pB1, mnB, alB, 0, 0, false);
        for (int t = 1; t < NT; t += 2) {
            SSTEP(pB0, pB1, mnB, alB, pA0, pA1, mnA, alA, t, 1, true);
            if (t + 1 < NT) { if (t + 1 == NT - 2) LATE_FETCH(); SSTEP(pA0, pA1, mnA, alA, pB0, pB1, mnB, alB, t + 1, 0, true); }
        }
        MASKT(pB0, pB1, NT - 1); partialSM(pB0, pB1, m_reg, mnB, alB);
        finishSM(pB0, pB1, alB, l_reg, pa0, pa1, pa2, pa3); D_PEXPORT(1); D_AEXPORT(1, alB); if (hi == 0) li_l[r32] = l_reg;
#pragma unroll
        for (int d0 = 0; d0 < 8; ++d0) qr[d0] = load8(nxt.Q + (size_t)(wid * QBLK + r32) * D + d0 * 16 + hi * 8);
        __syncthreads();
        D_KLOAD(nxt.K, KBASE(1));
        __syncthreads();
#undef MASKT
#undef SSTEP
#undef LATE_FETCH
        if (PROBE_SEL >= 0 && tid == 0) { if (Q_.stp[24] == 0ull) { Q_.stp[24] = __builtin_amdgcn_s_memrealtime(); Q_.stp[25] = (unsigned long long)(NT + 2); } else if (Q_.stp[26] == 0ull) { Q_.stp[26] = __builtin_amdgcn_s_memrealtime(); Q_.stp[27] = (unsigned long long)(NT + 2); } }
        if (!more) break;
        cur = nxt;
    }
    VMW();
}
__device__ __forceinline__ void dattn_V(char* lds, const DQueue& Q_) {
    int tid = threadIdx.x; asm volatile("" : "+v"(tid)); const int wid = __builtin_amdgcn_readfirstlane(tid >> 6), lane = tid & 63, r32 = lane & 31, hi = lane >> 5;
    const int t8 = tid & 255, sr = t8 >> 4, sc = (t8 & 15) * 8;
    char* V_lds = lds; char* V1_lds = lds + DV1_OFF; char* P_lds = lds + DP_OFF + (wid & 3) * 4096;
    float* ws = (float*)(lds + DWS_OFF) + (wid & 3) * 128; float* li_l = ws, * al_l = ws + 32;
    const int vb0 = (int)(uintptr_t)V_lds + v_rd_base(lane), vb1 = (int)(uintptr_t)V1_lds + v_rd_base(lane);
    int par = 0; int item = dfetch(Q_, par, tid); if (item >= DNITEM) return;
    DRef cur = dref_of(Q_, item);
    bf16x8 vs[8], pa0, pa1, pa2, pa3;
    __syncthreads();
    for (;;) {
        bool more = false; DRef nxt = cur;
        const int NT = (cur.P0 + 128) / KVBLK;
        f32x16 o0[4] = {}, o1[4] = {};
        int t = 0;
        do {
            if (t == NT - 2) { const int nitem_ = dfetch(Q_, par, tid); more = nitem_ < DNITEM; if (more) nxt = dref_of(Q_, nitem_); }
            if (t >= 1 && t <= NT) { VMW(); D_VWRITE((t - 1) & 1); }
            if (t < NT) D_VLOAD(cur.V0, cur.V1, KBASE(t));
            if (t >= 2) { const int pb = t & 1; D_RESC(pb); D_PIMPORT(pb); asm volatile("s_waitcnt lgkmcnt(0)" ::: "memory");
                pv_both(o0, o1, vb0 + pb * SHM_V, vb1 + pb * SHM_V, pa0, pa1, pa2, pa3); }
            if (t == NT + 1) { D_OSTORE(cur.O0, o0); D_OSTORE(cur.O1, o1); }
            __syncthreads();
        } while (++t < NT + 2);
        if (!more) break;
        cur = nxt;
    }
}
#undef KBASE
#undef D_KLOAD
#undef D_KWRITE
#undef D_VLOAD
#undef D_VWRITE
#undef D_PEXPORT
#undef D_PIMPORT
#undef D_AEXPORT
#undef D_RESC
#undef D_OSTORE
#undef ROW
#undef VMW
#undef VMWN
#undef SLOAD_H
#undef BLOAD
#undef SWRITE_HK
#undef SWRITE_HV
#undef SWRITE_H
#undef KSWZ
#undef SBAR
}

constexpr size_t MiB = 1u << 20, KiB = 1u << 10;
constexpr size_t WS_CTL = 0, CTL_ZERO_BYTES = 1 * MiB;
constexpr size_t WS_FLOG = 1 * MiB, WS_FBIAS = WS_FLOG + 256 * KiB, WS_ZEROB = WS_FBIAS + 256 * KiB, WS_WRT = WS_ZEROB + 64 * KiB;
constexpr size_t WS_NP = 1920 * KiB;
constexpr size_t WS_TOKINFO = 2 * MiB, WS_LIST = 3 * MiB;
constexpr size_t WS_ROPE = 4 * MiB;
constexpr size_t WS_WPC = 8 * MiB, WS_WOUT = 16 * MiB, WS_WIN = 24 * MiB, WS_WGU = 64 * MiB, WS_WD = 192 * MiB;
constexpr size_t WS_QKV = 256 * MiB, WS_G = 356 * MiB, WS_XB = 420 * MiB, WS_OD = 24 * MiB, WS_ACAT = 452 * MiB;
constexpr size_t WS_LOCAL = 56 * MiB, WS_CNTT = 58 * MiB;
constexpr size_t WS_MB = 256 * MiB, WS_Z = 288 * MiB, WS_X1B = 352 * MiB, WS_H = 384 * MiB, WS_Y = 408 * MiB, WS_END = 504 * MiB;
constexpr int CW_TMO = 0, CW_BAR = 4096, CW_ATTQ = 8192, CW_ECNT = 12288, CW_QN = 16384, CW_KN = 17408, CW_DQ = 18560, CW_TD = 20480, CW_CD = 20736, CW_BG = 21504, CW_GD = 21632, CW_AD = 21760, CW_MQ8 = 22528, CW_MQ9 = 23552;
constexpr int HROWS = 24576;

constexpr int RING_OFF = 0, RING_BYTES = 131072;
constexpr int SM_OFF = 135168;
constexpr int PFX_OFF = 137216;
constexpr int LDSCTL_OFF = 155648, MISC_OFF = LDSCTL_OFF + 320;
constexpr int LDS_BYTES = 163840;
static_assert(att::DATT_LDS_END <= LDSCTL_OFF, "attention LDS map");

#define RLX_AGENT __ATOMIC_RELAXED, __HIP_MEMORY_SCOPE_AGENT
#define LDS_WAIT() asm volatile("s_waitcnt lgkmcnt(0)" ::: "memory")
#define VM_WAIT() asm volatile("s_waitcnt vmcnt(0)" ::: "memory")

#define XB_TMO      128
#define XB_XCNT(j)  (256  + 64 * (j))
#define XB_XSUB(j)  (1280 + 64 * (j))
#define XB_XGEN(j)  (2304 + 64 * (j))
#define XB_TOP      3328
#define XB_TOPGEN   3392
#define XCD_BAR_WORDS 3456
#define XB_SPIN_CAP (1u << 18)
__device__ __forceinline__ unsigned xb_ld(unsigned* p)              { return __hip_atomic_load(p, __ATOMIC_RELAXED, __HIP_MEMORY_SCOPE_AGENT); }
__device__ __forceinline__ unsigned xb_add(unsigned* p, unsigned v) { return __hip_atomic_fetch_add(p, v, __ATOMIC_RELAXED, __HIP_MEMORY_SCOPE_AGENT); }
__device__ __forceinline__ unsigned xb_xcc_id() { return (unsigned)__builtin_amdgcn_s_getreg((3 << 11) | 20) & 0xFu; }
#define XB_SPIN(cond, bar) do { unsigned _sp = 0; while (cond) { __builtin_amdgcn_s_sleep(1); \
    if ((++_sp & 255u) == 0u) { if (xb_ld(&(bar)[XB_TMO])) break; if (_sp > XB_SPIN_CAP) { atomicAdd(&(bar)[XB_TMO], 1u); break; } } } } while (0)
struct XcdBarrier { unsigned* bar; unsigned x; volatile LAS unsigned* st; };
__device__ __forceinline__ XcdBarrier xcd_barrier_post(unsigned* bar, volatile LAS unsigned* st) {
    XcdBarrier b; b.bar = bar; b.x = xb_xcc_id(); b.st = st;
    if (threadIdx.x == 0) (void)xb_add(&bar[XB_XCNT(b.x)], 1u);
    return b;
}
__device__ __forceinline__ void xcd_barrier_complete(unsigned* bar, unsigned x, unsigned& nloc, unsigned& nx) {
    const unsigned G = gridDim.x * gridDim.y * gridDim.z;
    unsigned sum, cnt, mine, sp = 0u;
    for (;;) {
        sum = 0u; cnt = 0u; mine = 0u;
#pragma unroll
        for (unsigned j = 0; j < 16; ++j) { const unsigned c = xb_ld(&bar[XB_XCNT(j)]); sum += c; cnt += (c > 0u) ? 1u : 0u; mine = (j == x) ? c : mine; }
        if (sum == G) break;
        __builtin_amdgcn_s_sleep(1);
        if ((++sp & 255u) == 0u) { if (xb_ld(&bar[XB_TMO])) break; if (sp > XB_SPIN_CAP) { atomicAdd(&bar[XB_TMO], 1u); break; } }
    }
    nloc = mine > 0u ? mine : 1u; nx = cnt > 0u ? cnt : 1u;
}
__device__ __forceinline__ void xcd_barrier(const XcdBarrier& b) {
    asm volatile("s_waitcnt vmcnt(0)" ::: "memory");
    __syncthreads();
    if (threadIdx.x == 0) {
        unsigned* bar = b.bar;
        __builtin_amdgcn_s_waitcnt(0);
        unsigned nloc = b.st[0], nx = b.st[1];
        if (nloc == 0u) { xcd_barrier_complete(bar, b.x, nloc, nx); b.st[0] = nloc; b.st[1] = nx; }
        const unsigned old = xb_add(&bar[XB_XSUB(b.x)], 1u);
        const unsigned gen = old / nloc;
        if (old + 1u == (gen + 1u) * nloc) {
            __builtin_amdgcn_fence(__ATOMIC_RELEASE, "agent");
            asm volatile("s_waitcnt vmcnt(0)" ::: "memory");
            const unsigned og = xb_add(&bar[XB_TOP], 1u);
            const unsigned tg = og / nx;
            if (og + 1u == (tg + 1u) * nx) xb_add(&bar[XB_TOPGEN], 1u);
            else XB_SPIN(xb_ld(&bar[XB_TOPGEN]) == tg, bar);
            __builtin_amdgcn_fence(__ATOMIC_ACQUIRE, "agent");
            xb_add(&bar[XB_XGEN(b.x)], 1u);
            asm volatile("s_waitcnt vmcnt(0)" ::: "memory");
        } else {
            XB_SPIN(xb_ld(&bar[XB_XGEN(b.x)]) == gen, bar);
            __builtin_amdgcn_fence(__ATOMIC_ACQUIRE, "agent");
            asm volatile("s_waitcnt vmcnt(0)" ::: "memory");
        }
    }
    __syncthreads();
}

constexpr int NWAVES = 8, NPHASE = 11;
struct Args { const float* in[22]; float* out; unsigned char* ws; int ph_lo, ph_hi; };
struct Frame {
    LAS unsigned char* lds; volatile LAS unsigned* MISC; unsigned* ctl;
    int tid, lane, wave, vcu, G;
};

template <class RM, bool WTHROUGH = false>
__device__ __forceinline__ void tr_item(const float* W, int N, int k0, int nsrc0, bf16_t* WT, int ldw, int kdst, const RM& rowmap, LAS float* scr, int lane) {
    const int lr = lane >> 4, lc = (lane & 15) * 4;
#pragma unroll 4
    for (int i = 0; i < 16; ++i) { const int kk = 4 * i + lr; const f32x4 v = *(const f32x4*)(W + (size_t)(k0 + kk) * N + nsrc0 + lc);
        scr[kk * 65 + lc] = v[0]; scr[kk * 65 + lc + 1] = v[1]; scr[kk * 65 + lc + 2] = v[2]; scr[kk * 65 + lc + 3] = v[3]; }
    LDS_WAIT(); asm volatile("" ::: "memory");
    const int c = lane & 7;
#pragma unroll
    for (int j = 0; j < 8; ++j) { const int n = (lane >> 3) + 8 * j; const LAS float* s = scr + (8 * c) * 65 + n;
        u32x4 o; o.x = cvt_pk_bf16(s[0 * 65], s[1 * 65]); o.y = cvt_pk_bf16(s[2 * 65], s[3 * 65]); o.z = cvt_pk_bf16(s[4 * 65], s[5 * 65]); o.w = cvt_pk_bf16(s[6 * 65], s[7 * 65]);
        if (WTHROUGH) pg8::store16_wt(WT + (size_t)rowmap(nsrc0 + n) * ldw + kdst + k0 + 8 * c, o); else *(u32x4*)(WT + (size_t)rowmap(nsrc0 + n) * ldw + kdst + k0 + 8 * c) = o; }
    LDS_WAIT(); asm volatile("" ::: "memory");
}
struct RmId { __device__ __forceinline__ int operator()(int c) const { return c; } };
struct RmIn { __device__ __forceinline__ int operator()(int c) const {
        if (c < 2048) { const int jj = c & 127, j6 = jj & 63; return (c & ~127) + 8 * (j6 >> 2) + (jj >= 64 ? 4 : 0) + (j6 & 3); }
        return c < 6144 ? c : c - 8; } };
struct RmGate { int up; __device__ __forceinline__ int operator()(int c) const { return 256 * (c >> 7) + 128 * up + (c & 127); } };

__device__ __forceinline__ att::BlockRef mk_ref(int item, int jlo, const bf16_t* QKV, bf16_t* OD, bf16_t* ACAT, const float* FBIAS, const float* ZEROB) {
    att::BlockRef r; const int qb = 31 - item / 24, u = item % 24; int hq, hk, hv;
    if (u < 16) { const int m = u >> 1, c = u & 1; hq = m; hk = 8 + m; hv = 16 + (m >> 1) * 2 + c; r.B = ZEROB; r.O = (att::bf16*)OD + ((size_t)u * S + qb * 256) * 128; r.ostride = 128; }
    else { const int h = u - 16; hq = 24 + h; hk = 32 + h; hv = 40 + h; r.B = FBIAS + (size_t)h * S; r.O = (att::bf16*)ACAT + (size_t)(qb * 256) * DM + 1024 + h * 128; r.ostride = DM; }
    r.Q = (const att::bf16*)QKV + (size_t)hq * QUS + (size_t)(qb * 256) * 128; r.K = (const att::bf16*)QKV + (size_t)hk * QUS + (size_t)(jlo * 64) * 128; r.V = (const att::bf16*)QKV + (size_t)hv * QUS + (size_t)(jlo * 64) * 128; r.B += jlo * 64; r.P0 = qb * 256; r.jlo = jlo; return r;
}
__global__ void __launch_bounds__(NWAVES * 64, 2) mk_fwd(Args args) {
    extern __shared__ __attribute__((aligned(16))) unsigned char lds[];
    Frame F;
    F.lds = (LAS unsigned char*)lds;
    F.MISC = (volatile LAS unsigned*)(F.lds + MISC_OFF);
    F.tid = threadIdx.x; F.lane = F.tid & 63; F.wave = __builtin_amdgcn_readfirstlane(F.tid >> 6);
    F.G = gridDim.x; { const int bx = blockIdx.x; F.vcu = (F.G % 8 == 0) ? (bx % 8) * (F.G / 8) + bx / 8 : bx; }
    unsigned char* ws = args.ws;
    F.ctl = (unsigned*)(ws + WS_CTL);
    const float* x = args.in[0]; const float* w_in = args.in[1]; const float* b_forget = args.in[2];
    const float* lq1 = args.in[3]; const float* lk1 = args.in[4]; const float* lq2 = args.in[5]; const float* lk2 = args.in[6];
    const float* dng = args.in[7]; const float* wpd = args.in[8]; const float* wpf = args.in[9]; const float* wout = args.in[10];
    const float* ln1g = args.in[11]; const float* ln1b = args.in[12]; const float* wrg = args.in[13]; const float* brg = args.in[14];
    const float* wre = args.in[15]; const float* bre = args.in[16]; const float* wgate = args.in[17]; const float* wup = args.in[18];
    const float* wdown = args.in[19]; const float* ln2g = args.in[20]; const float* ln2b = args.in[21];
    float* FLOG = (float*)(ws + WS_FLOG); float* FBIAS = (float*)(ws + WS_FBIAS); float* ZEROB = (float*)(ws + WS_ZEROB); float* WRT = (float*)(ws + WS_WRT);
    float* NPB = (float*)(ws + WS_NP);
    int* TOKINFO = (int*)(ws + WS_TOKINFO); int* LIST = (int*)(ws + WS_LIST); float* ROPE = (float*)(ws + WS_ROPE);
    bf16_t* WPC = (bf16_t*)(ws + WS_WPC); bf16_t* WOUT = (bf16_t*)(ws + WS_WOUT); bf16_t* WIN = (bf16_t*)(ws + WS_WIN); bf16_t* WGU = (bf16_t*)(ws + WS_WGU); bf16_t* WD = (bf16_t*)(ws + WS_WD);
    bf16_t* QKV = (bf16_t*)(ws + WS_QKV); bf16_t* GB = (bf16_t*)(ws + WS_G); bf16_t* XB = (bf16_t*)(ws + WS_XB); bf16_t* OD = (bf16_t*)(ws + WS_OD); bf16_t* ACAT = (bf16_t*)(ws + WS_ACAT);
    bf16_t* MB = (bf16_t*)(ws + WS_MB); float* Z = (float*)(ws + WS_Z); bf16_t* X1B = (bf16_t*)(ws + WS_X1B); bf16_t* HB = (bf16_t*)(ws + WS_H); bf16_t* YB = (bf16_t*)(ws + WS_Y);

    for (int u = F.tid; u < (LDS_BYTES - LDSCTL_OFF) / 4; u += NWAVES * 64) ((LAS unsigned*)(F.lds + LDSCTL_OFF))[u] = 0u;
    __syncthreads();
    XcdBarrier bar; bar.bar = F.ctl + CW_BAR; bar.x = 0; bar.st = nullptr;
    if (MK_N_LAUNCHES == 1) bar = xcd_barrier_post(F.ctl + CW_BAR, F.MISC + 8);
    const int lo = args.ph_lo, hi = args.ph_hi; constexpr int rep = 0;
#define FRESH() do { int t_ = threadIdx.x; asm volatile("" : "+v"(t_)); F.tid = t_; F.lane = t_ & 63; F.wave = __builtin_amdgcn_readfirstlane(t_ >> 6); } while (0)
#define IN(k) ((((PH_MASK) >> (k)) & 1) && lo <= (k) && (k) < hi)
#if PROBE_SEL >= 0
    unsigned long long* stamps = (unsigned long long*)(ws + WS_CTL + 512 * KiB) + (size_t)blockIdx.x * 32;
#define STAMP(i) do { if (threadIdx.x == 0) stamps[i] = __builtin_amdgcn_s_memrealtime(); } while (0)
#else
#define STAMP(i) do { } while (0)
#endif
#define SEAM(k) do { STAMP(2 * (k) + 1); if (IN(k) && IN((k) + 1)) xcd_barrier(bar); STAMP(2 * (k) + 2); } while (0)
#define gw (F.vcu * NWAVES + F.wave)
#define BG_BATCH(b_) do { const int r_ = (int)(b_) * 8 + F.wave, e_ = r_ >> 9, up_ = (r_ >> 8) & 1, q_ = r_ & 255;                                               \
        tr_item<RmGate, true>((up_ ? wup : wgate) + (size_t)e_ * DM * FF, FF, 64 * (q_ >> 3), 64 * (q_ & 7), WGU + (size_t)e_ * 1024 * DM, DM, 0, RmGate{up_}, (LAS float*)(F.lds + F.wave * 16640), F.lane); \
        VM_WAIT(); __syncthreads();                                                                                                                                  \
        if (F.tid == 0) (void)__hip_atomic_fetch_add(F.ctl + CW_GD + e_, 1u, RLX_AGENT); } while (0)
    const int NGW = F.G * NWAVES;
    LAS int* sm_rowidx = (LAS int*)(F.lds + SM_OFF); LAS int* sm_pre = sm_rowidx + 256; LAS int* sm_cnt = sm_pre + 40;

    STAMP(0);
    if (IN(0)) {
        FRESH();
        LAS float* scr = (LAS float*)(F.lds + F.wave * 16640);
        constexpr int I_IN = 32 * 160, I_P = 16 * 32, I_O = 32 * 32, I_E = 32 * 256, NITEMS = I_IN + 2 * I_P + I_O;
        for (int it = gw; it < NITEMS; it += NGW) {
            int r = it;
            if (r < I_IN) { const int kb = r / 160, nb = r % 160; tr_item(w_in, INC, 64 * kb, 64 * nb + (nb >= 96 ? 8 : 0), WIN, DM, 0, RmIn{}, scr, F.lane); continue; } r -= I_IN;
            if (r < I_P) { tr_item(wpd, DM, 64 * (r / 32), 64 * (r % 32), WPC, DM, 0, RmId{}, scr, F.lane); continue; } r -= I_P;
            if (r < I_P) { tr_item(wpf, DM, 64 * (r / 32), 64 * (r % 32), WPC, DM, 1024, RmId{}, scr, F.lane); continue; } r -= I_P;
            if (r < I_O) { tr_item(wout, DM, 64 * (r / 32), 64 * (r % 32), WOUT, DM, 0, RmId{}, scr, F.lane); continue; } r -= I_O;
        }
        const int gt = F.vcu * (NWAVES * 64) + F.tid, NGT = F.G * NWAVES * 64;
        for (int i = gt; i < S * 64; i += NGT) { const int pos = i >> 6, j = i & 63; const double ang = (double)pos * pow(10000.0, -(double)j / 64.0);
            ROPE[(size_t)pos * 128 + j] = (float)cos(ang); ROPE[(size_t)pos * 128 + 64 + j] = (float)sin(ang); }
        for (int i = gt; i < 36 * DM; i += NGT) { const int c = i / DM, k = i % DM; WRT[i] = c < 4 ? wrg[k * 4 + c] : wre[((size_t)((c - 4) >> 3) * DM + k) * 8 + ((c - 4) & 7)]; }
        for (int i = gt; i < S; i += NGT) ZEROB[i] = 0.f;
        __syncthreads();
        { LAS float* Wf = (LAS float*)F.lds;
          for (int i = F.tid; i < DM * 2; i += NWAVES * 64) { const int k = i >> 1, h4 = (i & 1) * 4; const f32x4 v = *(const f32x4*)(w_in + (size_t)k * INC + 6144 + h4);
              Wf[(h4 + 0) * DM + k] = v[0]; Wf[(h4 + 1) * DM + k] = v[1]; Wf[(h4 + 2) * DM + k] = v[2]; Wf[(h4 + 3) * DM + k] = v[3]; }
          __syncthreads();
          for (int m = gw; m < S; m += NGW) {
              const f32x4* xr = (const f32x4*)(x + (size_t)m * DM) + F.lane; f32x4 v[8];
#pragma unroll
              for (int j = 0; j < 8; ++j) v[j] = xr[64 * j];
              u32x2* o8 = (u32x2*)(XB + (size_t)m * DM) + F.lane;
#pragma unroll
              for (int j = 0; j < 8; ++j) { u32x2 w; w.x = cvt_pk_bf16(v[j][0], v[j][1]); w.y = cvt_pk_bf16(v[j][2], v[j][3]); o8[64 * j] = w; }
              float fl[8];
#pragma unroll
              for (int c = 0; c < 8; ++c) { float a = 0.f;
#pragma unroll
                  for (int j = 0; j < 8; ++j) { const f32x4 w = *(const LAS f32x4*)(Wf + c * DM + 256 * j + 4 * F.lane); a = fmaf(v[j][0], w[0], fmaf(v[j][1], w[1], fmaf(v[j][2], w[2], fmaf(v[j][3], w[3], a)))); }
                  asm volatile("" ::: "memory");
                  fl[c] = wave_sum(a); asm volatile("" : "+v"(fl[c])); }
              if (F.lane == 0) { *(f32x4*)(FLOG + (size_t)m * 8) = (f32x4){fl[0], fl[1], fl[2], fl[3]}; *(f32x4*)(FLOG + (size_t)m * 8 + 4) = (f32x4){fl[4], fl[5], fl[6], fl[7]}; }
          }
          __syncthreads();
        }
    }
    SEAM(0);

    if (IN(1)) {
        FRESH();
        if (F.vcu < 8) {
            const int h = F.vcu; LAS double* part = (LAS double*)F.lds; const double b = (double)b_forget[h];
            double ls[16]; double run = 0.0;
#pragma unroll
            for (int i = 0; i < 16; ++i) { const double z = (double)FLOG[(size_t)(F.tid * 16 + i) * 8 + h] + b; run += (z < 0.0 ? z : 0.0) - log1p(exp(-fabs(z))); ls[i] = run; }
            part[F.tid] = run; __syncthreads();
            if (F.tid == 0) { double a = 0.0; for (int i = 0; i < NWAVES * 64; ++i) { const double t = part[i]; part[i] = a; a += t; } }
            __syncthreads();
            const double off = part[F.tid];
#pragma unroll
            for (int i = 0; i < 16; ++i) FBIAS[(size_t)h * S + F.tid * 16 + i] = (float)(-(off + ls[i]) * (double)INV_SCALE);
            __syncthreads();
        }
        pg8::Gemm g{XB, WIN, DM, DM, DM, nullptr}; pg8::StaticOrder So; So.init(S, NIN, F.G, (int)blockIdx.x);
        pg8::EpiInProj E{QKV, GB, ROPE, NPB};
        pg8::gemm_phase<pg8::EpiInProj, pg8::StaticOrder, false>(F.lds + RING_OFF, g, So, E);
    }
    SEAM(1);

    if (IN(2)) {
        FRESH();
        constexpr int NITEM = 24 * 32;
#pragma nounroll
        for (int pass = 0; pass < 2; ++pass) {
        { att::DQueue dq{F.ctl + CW_ATTQ + 64 * (8 + 8 * pass), F.MISC + 22, (const att::bf16*)QKV, (att::bf16*)OD, (int)bar.x, PROBE_SEL >= 0 ? (unsigned long long*)(ws + WS_CTL + 512 * KiB) + (size_t)blockIdx.x * 32 : nullptr, pass};
          if (F.wave < 4) att::dattn_S((char*)lds, dq); else att::dattn_V((char*)lds, dq);
          VM_WAIT(); __syncthreads();
        }
        if (pass == 0) {
        STAMP(22);
        #define ref(item, jl) mk_ref((item), (jl), QKV, OD, ACAT, FBIAS, ZEROB)
        int slot = 0;
#define FETCH(dst, dstj) do { if (F.wave == 0) { unsigned v_ = 0; if (F.lane == 0) { const unsigned i_ = __hip_atomic_fetch_add(F.ctl + CW_ATTQ + 64 * rep, 1u, RLX_AGENT); v_ = i_ < 256u ? (i_ & 31u) * 24u + 16u + F.MISC[24 + ((i_ >> 5) & 7u)] : (unsigned)NITEM; } const int it_ = (int)__builtin_amdgcn_readfirstlane(v_); int jl_ = 0; \
        if (it_ < NITEM && (it_ % 24) >= 16) { const int h_ = it_ % 24 - 16, qb_ = 31 - it_ / 24, nt_ = 4 * qb_ + 4; const float* Bh_ = FBIAS + (size_t)h_ * S; \
            float qn_ = 0.f, kd_ = 0.f; \
            for (int d_ = 0; d_ < 4; ++d_) { const f32x4 a_ = *(const f32x4*)(NPB + ((size_t)h_ * 128 + 4 * qb_ + d_) * 4), b_ = *(const f32x4*)(NPB + ((size_t)(8 + h_) * 128 + 4 * qb_ + d_) * 4); \
                qn_ = fmaxf(qn_, (a_[0] + a_[1]) + (a_[2] + a_[3])); kd_ = fmaxf(kd_, (b_[0] + b_[1]) + (b_[2] + b_[3])); } \
            qn_ = sqrtf(qn_) * 1.005f; kd_ = sqrtf(kd_) * 1.005f; \
            const float lowm_ = -qn_ * kd_ * 1.0001f + Bh_[qb_ * 256]; int first_ = nt_; \
            for (int c_ = 0; c_ < 2; ++c_) { const int t_ = c_ * 64 + F.lane; bool keep_ = true; \
                if (t_ < nt_) { const f32x4 b_ = *(const f32x4*)(NPB + ((size_t)(8 + h_) * 128 + t_) * 4); const float kn_ = sqrtf((b_[0] + b_[1]) + (b_[2] + b_[3])) * 1.005f; keep_ = !(qn_ * kn_ * 1.0001f + Bh_[64 * t_ + 63] - lowm_ < -FOX_THR_RAW); } else keep_ = (t_ == nt_); \
                const unsigned long long bm_ = __ballot(keep_ && t_ <= nt_); if (bm_ && first_ == nt_) first_ = c_ * 64 + (int)__builtin_ctzll(bm_); } \
            jl_ = first_ & ~1; if (jl_ > nt_ - 4) jl_ = nt_ - 4; if (jl_ < 0) jl_ = 0; } \
        if (F.lane == 0) { F.MISC[16 + slot] = (unsigned)it_; F.MISC[18 + slot] = (unsigned)jl_; } } \
        __syncthreads(); dst = __builtin_amdgcn_readfirstlane((int)F.MISC[16 + slot]); dstj = __builtin_amdgcn_readfirstlane((int)F.MISC[18 + slot]); slot ^= 1; } while (0)
        if (F.tid < 8) { const float mine_ = b_forget[F.tid]; int rk_ = 0;
            for (int h2 = 0; h2 < 8; ++h2) { const float o_ = b_forget[h2]; rk_ += (o_ > mine_ || (o_ == mine_ && h2 < F.tid)) ? 1 : 0; }
            F.MISC[24 + rk_] = (unsigned)F.tid; }
        __syncthreads();
        { att::Seam Sm;
          for (;;) {
            int item, jl; FETCH(item, jl);
            if (item >= NITEM) break;
            const att::BlockRef cur = ref(item, jl);
            att::attn_prime(cur, (char*)lds, F.lds, Sm);
            att::attn_block(cur, cur, (char*)lds, F.lds, Sm);
          } }
        VM_WAIT(); __syncthreads();
#undef FETCH
#undef ref
        STAMP(24 + 4);
        }
        }
        { FRESH(); if (F.tid == 0) (void)__hip_atomic_fetch_add(F.ctl + CW_AD, 1u, RLX_AGENT); int sl = 0;
          for (;;) { if (F.tid == 0) { unsigned b = 0xFFFFFFFFu; if (__hip_atomic_load(F.ctl + CW_AD, RLX_AGENT) < (unsigned)F.G) b = __hip_atomic_fetch_add(F.ctl + CW_BG, 1u, RLX_AGENT); F.MISC[20 + sl] = b; }
              __syncthreads(); const unsigned b = F.MISC[20 + sl]; sl ^= 1; if (b >= 2048u) break; BG_BATCH(b); } }
    }
    SEAM(2);

    if (IN(3)) {
        FRESH();
        float a = lq1[F.lane] * lk1[F.lane] + lq1[F.lane + 64] * lk1[F.lane + 64], b = lq2[F.lane] * lk2[F.lane] + lq2[F.lane + 64] * lk2[F.lane + 64];
        const float lam = __expf(wave_sum(a)) - __expf(wave_sum(b)) + LAM_INIT;
        const int c = F.lane >> 5, dd = (F.lane & 31) * 4;
        for (int p = gw; p < S * 4; p += NGW) { const int s = p >> 2, h = p & 3;
            const u32x2 w1 = *(const u32x2*)(OD + ((size_t)(4 * h + c) * S + s) * 128 + dd), w2 = *(const u32x2*)(OD + ((size_t)(4 * h + 2 + c) * S + s) * 128 + dd);
            const f32x4 o1 = {bf_lo(w1.x), bf_hi(w1.x), bf_lo(w1.y), bf_hi(w1.y)}, o2 = {bf_lo(w2.x), bf_hi(w2.x), bf_lo(w2.y), bf_hi(w2.y)};
            const f32x4 v = o1 - o2 * lam;
            const float ss = wave_sum(v[0] * v[0] + v[1] * v[1] + v[2] * v[2] + v[3] * v[3]);
            const float r = rsqrtf(ss * (1.f / 256.f) + LN_EPS) * (1.f - LAM_INIT);
            const f32x4 gg = *(const f32x4*)(dng + h * 256 + 4 * F.lane);
            u32x2 w; w.x = cvt_pk_bf16(v[0] * r * gg[0], v[1] * r * gg[1]); w.y = cvt_pk_bf16(v[2] * r * gg[2], v[3] * r * gg[3]);
            *(u32x2*)(ACAT + (size_t)s * DM + h * 256 + 4 * F.lane) = w; }
    }
    SEAM(3);

    if (IN(4)) {
        pg8::Gemm g{ACAT, WPC, DM, DM, DM, nullptr}; pg8::StaticOrder So; So.init(S, DM, F.G, (int)blockIdx.x);
        pg8::EpiGateHook E{GB, MB};
        pg8::gemm_phase<pg8::EpiGateHook, pg8::StaticOrder, false, true>(F.lds + RING_OFF, g, So, E);
    }
    STAMP(9); if (IN(4) && IN(6)) xcd_barrier(bar); STAMP(10);

    if (IN(6)) {
        pg8::Gemm g{MB, WOUT, DM, DM, DM, nullptr};
        pg8::StaticOrder So; So.init(S, DM, F.G, (int)blockIdx.x);
        pg8::EpiZ E{X1B};
        pg8::gemm_phase<pg8::EpiZ, pg8::StaticOrder, false>(F.lds + RING_OFF, g, So, E);
    }
    SEAM(6);

    if (IN(7)) {
        FRESH();
        unsigned* ecnt = F.ctl + CW_ECNT + rep * 2048; int* LISTr = rep ? (int*)(ws + WS_H) : LIST; int* TOKr = rep ? (int*)(ws + WS_H + 2 * MiB) : TOKINFO; float* Zw = rep ? (float*)(ws + WS_Y) : Z; bf16_t* X1Bw = rep ? (bf16_t*)(ws + WS_Y + 64 * MiB) : X1B;
        LAS float* Wl = (LAS float*)F.lds;
        LAS float* Lw = (LAS float*)(F.lds + 81920) + F.wave * 128;
        LAS unsigned* lcnt = (LAS unsigned*)(F.lds + 90112); int* LOCALL = (int*)(ws + WS_LOCAL) + (size_t)F.vcu * 32 * 64; int* CNTT = (int*)(ws + WS_CNTT);
        if (F.tid < 32) lcnt[F.tid] = 0u;
        __syncthreads();
#pragma unroll 1
        for (int pr = 0; pr < 2; ++pr) {
            const int rowA = gw * 4 + 2 * pr;
            f32x4 xa[8], xb[8];
            {
                const u32x2* za = (const u32x2*)(XB + (size_t)rowA * DM) + F.lane; const u32x2* zb = za + DM / 4;
                const u32x2* ya = (const u32x2*)(X1B + (size_t)rowA * DM) + F.lane; const u32x2* yb = ya + DM / 4;
                float sa = 0.f, sb = 0.f;
#pragma unroll
                for (int j = 0; j < 8; ++j) { const u32x2 wa_ = ya[64 * j], wb_ = yb[64 * j], xa_ = za[64 * j], xb_ = zb[64 * j];
                    xa[j] = (f32x4){bf_lo(xa_.x), bf_hi(xa_.x), bf_lo(xa_.y), bf_hi(xa_.y)} * ALPHA + (f32x4){bf_lo(wa_.x), bf_hi(wa_.x), bf_lo(wa_.y), bf_hi(wa_.y)}; xb[j] = (f32x4){bf_lo(xb_.x), bf_hi(xb_.x), bf_lo(xb_.y), bf_hi(xb_.y)} * ALPHA + (f32x4){bf_lo(wb_.x), bf_hi(wb_.x), bf_lo(wb_.y), bf_hi(wb_.y)}; sa += (xa[j][0] + xa[j][1]) + (xa[j][2] + xa[j][3]); sb += (xb[j][0] + xb[j][1]) + (xb[j][2] + xb[j][3]); }
                const float ma = wave_sum(sa) * (1.f / DM), mb = wave_sum(sb) * (1.f / DM); float qa = 0.f, qb = 0.f;
#pragma unroll
                for (int j = 0; j < 8; ++j) { xa[j] = xa[j] - ma; xb[j] = xb[j] - mb; qa += (xa[j][0] * xa[j][0] + xa[j][1] * xa[j][1]) + (xa[j][2] * xa[j][2] + xa[j][3] * xa[j][3]);
                    qb += (xb[j][0] * xb[j][0] + xb[j][1] * xb[j][1]) + (xb[j][2] * xb[j][2] + xb[j][3] * xb[j][3]); }
                const float ra = rsqrtf(wave_sum(qa) * (1.f / DM) + LN_EPS), rb = rsqrtf(wave_sum(qb) * (1.f / DM) + LN_EPS);
                u32x2* ha = (u32x2*)(X1Bw + (size_t)rowA * DM) + F.lane; u32x2* hb = ha + DM / 4;
#pragma unroll
                for (int j = 0; j < 8; ++j) { const f32x4 gg = *((const f32x4*)ln1g + F.lane + 64 * j), bb = *((const f32x4*)ln1b + F.lane + 64 * j);
                    xa[j] = xa[j] * ra * gg + bb; xb[j] = xb[j] * rb * gg + bb;
                    u32x2 w; w.x = cvt_pk_bf16(xa[j][0], xa[j][1]); w.y = cvt_pk_bf16(xa[j][2], xa[j][3]); ha[64 * j] = w;
                    w.x = cvt_pk_bf16(xb[j][0], xb[j][1]); w.y = cvt_pk_bf16(xb[j][2], xb[j][3]); hb[64 * j] = w; }
            }
            typedef float f32x2p __attribute__((ext_vector_type(2)));
            float la[36], lb[36];
#pragma unroll
            for (int c = 0; c < 36; ++c) { la[c] = 0.f; lb[c] = 0.f; }
#define P7_STAGE(j, b) do { unsigned lo_ = (unsigned)F.lane * 16u; asm volatile("" : "+v"(lo_)); _Pragma("unroll") for (int n_ = 0; n_ < 5; ++n_) { const int c_ = F.wave + 8 * n_; if (c_ < 36) { \
        const char* ub_ = (const char*)(WRT + (size_t)c_ * DM + 256 * (j)); __builtin_amdgcn_global_load_lds((const unsigned*)(ub_ + lo_), (LAS unsigned*)(Wl + (b) * 9216 + c_ * 256), 16, 0, 0); } } } while (0)
#define P7_COMMIT(b) do { VM_WAIT(); } while (0)
            __syncthreads();
            P7_STAGE(0, 0); P7_COMMIT(0); __syncthreads();
#pragma unroll
            for (int j = 0; j < 8; ++j) {
                if (j + 1 < 8) P7_STAGE(j + 1, (j + 1) & 1);
                const LAS float* Wb = Wl + (j & 1) * 9216;
#pragma unroll
                for (int cg = 0; cg < 9; ++cg) { f32x4 w[4];
#pragma unroll
                    for (int q = 0; q < 4; ++q) w[q] = *(const LAS f32x4*)(Wb + (4 * cg + q) * 256 + 4 * F.lane);
                    asm volatile("" ::: "memory");
#pragma unroll
                    for (int q = 0; q < 4; ++q) { const int c = 4 * cg + q; f32x2p acc = {la[c], lb[c]};
#pragma unroll
                        for (int k = 3; k >= 0; --k) acc = __builtin_elementwise_fma((f32x2p){xa[j][k], xb[j][k]}, (f32x2p){w[q][k], w[q][k]}, acc);
                        la[c] = acc[0]; lb[c] = acc[1];
                        asm volatile("" : "+v"(la[c]), "+v"(lb[c])); }
                    asm volatile("" ::: "memory"); __builtin_amdgcn_sched_barrier(0); }
                if (j + 1 < 8) { P7_COMMIT((j + 1) & 1); __syncthreads(); }
                __builtin_amdgcn_sched_barrier(0);
            }
#undef P7_STAGE
#undef P7_COMMIT
#pragma unroll
            for (int c = 0; c < 36; ++c) { la[c] = wave_sum(la[c]); lb[c] = wave_sum(lb[c]); asm volatile("" : "+v"(la[c]), "+v"(lb[c])); }
            if (F.lane == 0) {
#pragma unroll
                for (int c = 0; c < 36; ++c) { const float bias = c < 4 ? brg[c] : bre[c - 4]; Lw[c] = la[c] + bias; Lw[64 + c] = lb[c] + bias; } }
            LDS_WAIT(); asm volatile("" ::: "memory");
            if (F.lane < 2) {
                const LAS float* L = Lw + 64 * F.lane; const int tok = rowA + F.lane;
                const f32x4 gl = *(const LAS f32x4*)L;
                int g = 0; float gm = gl[0];
#pragma unroll
                for (int c = 1; c < 4; ++c) { if (gl[c] > gm) { gm = gl[c]; g = c; } }
                float den = 0.f;
#pragma unroll
                for (int c = 0; c < 4; ++c) den += expf(gl[c] - gm);
                const float top_gp = 1.f / den;
                const f32x4 el0 = *(const LAS f32x4*)(L + 4 + g * 8), el1 = *(const LAS f32x4*)(L + 8 + g * 8);
                const float ev[8] = {el0[0], el0[1], el0[2], el0[3], el1[0], el1[1], el1[2], el1[3]};
                int e1 = 0; float l1 = ev[0];
#pragma unroll
                for (int e = 1; e < 8; ++e) { if (ev[e] > l1) { l1 = ev[e]; e1 = e; } }
                int e2 = 0; float l2 = -INFINITY;
#pragma unroll
                for (int e = 0; e < 8; ++e) { if (e != e1 && ev[e] > l2) { l2 = ev[e]; e2 = e; } }
                const float w1 = 1.f / (1.f + expf(l2 - l1));
                const int ea = g * 8 + e1, eb = g * 8 + e2;
                const int pa = (int)__hip_atomic_fetch_add(lcnt + ea, 1u, __ATOMIC_RELAXED, __HIP_MEMORY_SCOPE_WORKGROUP), pb = (int)__hip_atomic_fetch_add(lcnt + eb, 1u, __ATOMIC_RELAXED, __HIP_MEMORY_SCOPE_WORKGROUP);
                LOCALL[ea * 64 + pa] = tok; LOCALL[eb * 64 + pb] = tok;
                u32x4* ti = (u32x4*)(TOKr + (size_t)tok * 8); ti[0] = (u32x4){(unsigned)ea, (unsigned)pa, __float_as_uint(top_gp * w1), (unsigned)eb}; ti[1] = (u32x4){(unsigned)pb, __float_as_uint(top_gp * (1.f - w1)), 0u, 0u};
            }
            asm volatile("" ::: "memory");
        }
        __syncthreads();
        if (F.tid < 32) CNTT[F.tid * 256 + F.vcu] = (int)lcnt[F.tid];
    }
    SEAM(7);

    if (IN(8) || IN(9) || IN(10)) {
        FRESH();
        { const int* CNTT = (const int*)(ws + WS_CNTT); LAS unsigned short* pfx = (LAS unsigned short*)(F.lds + PFX_OFF); LAS int* part = (LAS int*)F.lds;
          const int e = F.tid >> 4, seg = F.tid & 15; int v[16]; int ssum = 0;
#pragma unroll
          for (int i = 0; i < 16; ++i) { v[i] = CNTT[e * 256 + seg * 16 + i]; ssum += v[i]; }
          part[F.tid] = ssum; __syncthreads();
          int base = 0; for (int q = 0; q < seg; ++q) base += part[e * 16 + q];
#pragma unroll
          for (int i = 0; i < 16; ++i) { pfx[e * 256 + seg * 16 + i] = (unsigned short)base; base += v[i]; }
          if (seg == 15) sm_cnt[e] = base; }
        __syncthreads();
        if (F.tid == 0) { int a = 0; for (int e = 0; e < NEXP; ++e) { sm_pre[e] = a; a += (sm_cnt[e] + 255) >> 8; } sm_pre[32] = a; }
        __syncthreads();
    }
    if (IN(8)) {
        FRESH();
        const int ntile = sm_pre[32], n8 = ntile * 4, n9 = ntile * 8, NB = 1024, total = n8 + NB + n9;
        unsigned* mq = F.ctl + CW_DQ; unsigned* tdone = F.ctl + CW_TD; unsigned* cdone = F.ctl + CW_CD;
        LAS float* scr = (LAS float*)(F.lds + F.wave * 16640); int sl = 0;
        for (;;) {
            if (F.tid == 0) F.MISC[20 + sl] = __hip_atomic_fetch_add(F.ctl + CW_BG, 1u, RLX_AGENT);
            __syncthreads(); const unsigned b = F.MISC[20 + sl]; sl ^= 1; if (b >= 2048u) break; BG_BATCH(b); }
        const int myx = (int)(bar.x & 7u); int stage = 0, sk = 0;
        for (;;) {
            if (F.tid == 0) { unsigned code = 3u << 28;
                for (;;) {
                    if (stage == 1) { const unsigned b = __hip_atomic_fetch_add(mq, 1u, RLX_AGENT); if (b < 1024u) { code = (1u << 28) | b; break; } stage = 2; sk = 0; continue; }
                    if (sk > 7) { if (stage == 0) { stage = 1; continue; } break; }
                    const int y = (myx + sk) & 7, tb = sm_pre[4 * y], nj = (sm_pre[4 * y + 4] - tb) * 4;
                    const int v = (int)__hip_atomic_fetch_add(F.ctl + (stage == 0 ? CW_MQ8 : CW_MQ9) + 64 * y, 1u, RLX_AGENT);
                    if (v < nj) { code = (stage == 0 ? 0u : (2u << 28)) | (unsigned)(tb * 4 + v); break; }
                    ++sk; }
                F.MISC[20 + sl] = code; }
            __syncthreads(); const unsigned code = F.MISC[20 + sl]; sl ^= 1; const int kind = (int)(code >> 28), q = (int)(code & 0xFFFFFFFu);
            if (kind == 3) break;
            if (kind == 0) {
                const int mtile = q >> 2, nt4 = q & 3; int e = 0;
                for (int k = 1; k < NEXP; ++k) if (sm_pre[k] <= mtile) e = k;
                const int mt = mtile - sm_pre[e], cnt = sm_cnt[e];
                if (F.tid < 256) { int r = mt * 256 + F.tid; r = r < cnt ? r : cnt - 1;
                    const LAS unsigned short* pe = (const LAS unsigned short*)(F.lds + PFX_OFF) + e * 256; int c = 0;
#pragma unroll
                    for (int st = 128; st >= 1; st >>= 1) if ((int)pe[c + st] <= r) c += st;
                    sm_rowidx[F.tid] = ((const int*)(ws + WS_LOCAL))[((size_t)c * 32 + e) * 64 + (r - (int)pe[c])]; }
                if (F.tid == 0) { XB_SPIN(__hip_atomic_load(F.ctl + CW_GD + e, RLX_AGENT) < 64u, F.ctl + CW_BAR); __builtin_amdgcn_fence(__ATOMIC_ACQUIRE, "agent"); }
                __syncthreads();
                pg8::Gemm g{X1B, WGU + (size_t)e * 1024 * DM, DM, DM, DM, sm_rowidx}; pg8::SingleUnit Su{{mtile, nt4}};
                pg8::EpiSwiGLU E{HB};
                pg8::gemm_phase<pg8::EpiSwiGLU, pg8::SingleUnit, true>(F.lds + RING_OFF, g, Su, E);
                VM_WAIT(); __syncthreads();
                if (F.tid == 0) (void)__hip_atomic_fetch_add(tdone + mtile, 1u, RLX_AGENT);
            } else if (kind == 1) {
                const int r = q * 8 + F.wave, e = r >> 8, qq = r & 255;
                tr_item<RmId, true>(wdown + (size_t)e * FF * DM, DM, 64 * (qq >> 5), 64 * (qq & 31), WD + (size_t)e * DM * FF, FF, 0, RmId{}, scr, F.lane);
                VM_WAIT(); __syncthreads();
                if (F.tid == 0) (void)__hip_atomic_fetch_add(cdone + e, 1u, RLX_AGENT);
            } else {
                const int u = q, mtile = u >> 2; int e = 0;
                for (int k = 1; k < NEXP; ++k) if (sm_pre[k] <= mtile) e = k;
                if (F.tid == 0) {
                    XB_SPIN(__hip_atomic_load(tdone + mtile, RLX_AGENT) < 4u || __hip_atomic_load(cdone + e, RLX_AGENT) < 32u, F.ctl + CW_BAR);
                    __builtin_amdgcn_fence(__ATOMIC_ACQUIRE, "agent");
                }
                __syncthreads();
                pg8::Gemm g{HB, WD, FF, FF, FF, nullptr}; pg8::UnitRun Su{{mtile, e * 8 + (u & 3) * 2}, 2}; pg8::EpiY E{YB};
                pg8::gemm_phase<pg8::EpiY, pg8::UnitRun, false>(F.lds + RING_OFF, g, Su, E);
            }
        }
    }
    STAMP(17); STAMP(18); STAMP(19);
    if (IN(8) && IN(10)) xcd_barrier(bar);
    STAMP(20);

    if (IN(10)) {
        FRESH();
        float* out = args.out;
        for (int m = gw; m < S; m += NGW) {
            const int* ti = TOKINFO + (size_t)m * 8;
            const LAS unsigned short* pfx = (const LAS unsigned short*)(F.lds + PFX_OFF); const int cw = m >> 5;
            const int ea = ti[0], eb = ti[3], pa = ti[1] + (int)pfx[ea * 256 + cw], pb = ti[4] + (int)pfx[eb * 256 + cw]; float wa = __int_as_float(ti[2]), wb = __int_as_float(ti[5]);
            const size_t ra = (size_t)sm_pre[ea] * 256 + pa, rb = (size_t)sm_pre[eb] * 256 + pb;
            const u32x2* xr = (const u32x2*)(X1B + (size_t)m * DM) + F.lane; const u32x2* ya = (const u32x2*)(YB + ra * DM) + F.lane; const u32x2* yb = (const u32x2*)(YB + rb * DM) + F.lane;
            f32x4 v[8]; float s = 0.f;
#pragma unroll
            for (int j = 0; j < 8; ++j) { const u32x2 xw = xr[64 * j]; const f32x4 xv = {bf_lo(xw.x), bf_hi(xw.x), bf_lo(xw.y), bf_hi(xw.y)}; const u32x2 a = ya[64 * j], b = yb[64 * j];
                const f32x4 fa = {bf_lo(a.x), bf_hi(a.x), bf_lo(a.y), bf_hi(a.y)}, fb = {bf_lo(b.x), bf_hi(b.x), bf_lo(b.y), bf_hi(b.y)};
                v[j] = xv * ALPHA + fa * wa + fb * wb; s += (v[j][0] + v[j][1]) + (v[j][2] + v[j][3]); }
            const float mean = wave_sum(s) * (1.f / DM); float q = 0.f;
#pragma unroll
            for (int j = 0; j < 8; ++j) { v[j] = v[j] - mean; q += (v[j][0] * v[j][0] + v[j][1] * v[j][1]) + (v[j][2] * v[j][2] + v[j][3] * v[j][3]); }
            const float rstd = rsqrtf(wave_sum(q) * (1.f / DM) + LN_EPS);
            f32x4* o = (f32x4*)(out + (size_t)m * DM) + F.lane;
#pragma unroll
            for (int j = 0; j < 8; ++j) { const f32x4 gg = *((const f32x4*)ln2g + F.lane + 64 * j), bb = *((const f32x4*)ln2b + F.lane + 64 * j); o[64 * j] = v[j] * rstd * gg + bb; }
        }
    }
    STAMP(21);
#if PROBE_SEL >= 0
    xcd_barrier(bar);
    if (blockIdx.x == 0) {
        FRESH();
        const unsigned long long* SB = (const unsigned long long*)(ws + WS_CTL + 512 * KiB);
        LAS int* red = (LAS int*)(F.lds + RING_OFF);
        const int c = F.tid & 255;
#define S_of(j) ((j) < 6 ? 2 * (j) : 2 * (j) + 2)
#define E_of(j) ((j) < 5 ? 2 * (j) + 1 : 2 * (j) + 3)
        const unsigned long long t00 = SB[0];
        long long metric = 0;
#define REDUCE(expr, AVG, MAX) do { __syncthreads(); if (F.tid < 256) red[F.tid] = (int)(expr); __syncthreads(); long long a_ = 0; int m_ = -2000000000; for (int i_ = 0; i_ < 256; ++i_) { a_ += red[i_]; m_ = red[i_] > m_ ? red[i_] : m_; } AVG = (int)(a_ / 256); MAX = m_; } while (0)
#define ST(i) ((long long)(SB[(size_t)c * 32 + (i)] - t00))
        int av, mx, av2, mx2;
        if (PROBE_SEL == 1) { for (int j = 0; j < 10; ++j) { REDUCE(ST(E_of(j)), av, mx); metric += mx - av; } }
        else if (PROBE_SEL == 2) { for (int j = 0; j < 9; ++j) { REDUCE(ST(E_of(j)), av, mx); REDUCE(ST(S_of(j + 1)), av2, mx2); metric += av2 - mx; } }
        else if (PROBE_SEL >= 10 && PROBE_SEL < 20) { const int j = PROBE_SEL - 10; REDUCE(ST(E_of(j)) - ST(S_of(j)), av, mx); metric = av; }
        else if (PROBE_SEL >= 30 && PROBE_SEL < 40) { const int j = PROBE_SEL - 30; REDUCE(ST(E_of(j)), av, mx); metric = mx - av; }
        else if (PROBE_SEL == 50) { REDUCE(ST(22) - ST(4), av, mx); metric = av; }
        else if (PROBE_SEL == 51) { REDUCE(ST(5) - ST(22), av, mx); metric = av; }
        else if (PROBE_SEL == 52) { REDUCE(ST(17) - ST(23), av, mx); metric = av; }
        else if (PROBE_SEL == 53) { REDUCE(ST(22), av, mx); metric = mx - av; }
        else if (PROBE_SEL == 54) { REDUCE(-ST(22), av, mx); metric = mx - av; }
        else if (PROBE_SEL == 55) { REDUCE(ST(22), av, mx); const int thr_ = av + 3000; REDUCE(ST(22) > thr_ ? 25600 : 0, av2, mx2); metric = av2; }
        else if (PROBE_SEL == 57) { REDUCE((ST(24) - ST(4)) * 100 / (long long)SB[(size_t)c * 32 + 25], av, mx); metric = av; }
        else if (PROBE_SEL == 58) { REDUCE((ST(24) - ST(4)) * 100 / (long long)SB[(size_t)c * 32 + 25], av, mx); metric = mx; }
        else if (PROBE_SEL == 59) { REDUCE(-((ST(24) - ST(4)) * 100 / (long long)SB[(size_t)c * 32 + 25]), av, mx); metric = -mx; }
        else if (PROBE_SEL == 61) { REDUCE(SB[(size_t)c * 32 + 26] ? (ST(26) - ST(24)) * 100 / (long long)SB[(size_t)c * 32 + 27] : 200, av, mx); metric = av; }
        else if (PROBE_SEL == 62) { REDUCE(SB[(size_t)c * 32 + 26] ? (ST(26) - ST(24)) * 100 / (long long)SB[(size_t)c * 32 + 27] : 200, av, mx); metric = mx; }
        else if (PROBE_SEL == 63) { REDUCE(SB[(size_t)c * 32 + 26] && SB[(size_t)c * 32 + 27] > 40 ? (ST(26) - ST(24)) * 100 / (long long)SB[(size_t)c * 32 + 27] : 0, av, mx); REDUCE(SB[(size_t)c * 32 + 26] && SB[(size_t)c * 32 + 27] > 40 ? 256 : 0, av2, mx2); metric = av2 > 0 ? (long long)av * 256 / av2 : 0; }
        else if (PROBE_SEL == 60) { metric = 10000; }
#undef REDUCE
#undef ST
        if (metric < 0) metric = 0;
        if (F.tid == 0) { const unsigned long long t1 = __builtin_amdgcn_s_memrealtime(); while ((long long)(__builtin_amdgcn_s_memrealtime() - t1) < metric * PROBE_AMP) __builtin_amdgcn_s_sleep(8); }
        __syncthreads();
    }
#endif
#undef IN
#undef SEAM
#undef gw
#undef FRESH
}

extern "C" void kernel_launch(void* const* d_in, const int* in_sizes, int n_in, void* d_out, int out_size, void* d_ws, size_t ws_size, hipStream_t stream) {
    static int grid = 0;
    if (grid == 0) {
        if (n_in != 22 || in_sizes[0] != S * DM || in_sizes[1] != DM * INC || out_size != S * DM || ws_size < WS_END) {
            fprintf(stderr, "kernel_launch: unexpected shapes (n_in %d, in0 %d, out %d, ws %zu); nothing launched\n", n_in, n_in > 0 ? in_sizes[0] : -1, out_size, ws_size); grid = -1; return; }
        int dev = 0, cus = 0, per_cu = 0;
        if (hipGetDevice(&dev) != hipSuccess || hipDeviceGetAttribute(&cus, hipDeviceAttributeMultiprocessorCount, dev) != hipSuccess) { fprintf(stderr, "kernel_launch: device query failed\n"); grid = -1; return; }
        if (hipFuncSetAttribute((const void*)mk_fwd, hipFuncAttributeMaxDynamicSharedMemorySize, LDS_BYTES) != hipSuccess) { fprintf(stderr, "kernel_launch: hipFuncSetAttribute failed\n"); grid = -1; return; }
        if (hipOccupancyMaxActiveBlocksPerMultiprocessor(&per_cu, (const void*)mk_fwd, NWAVES * 64, LDS_BYTES) != hipSuccess || per_cu < 1) fprintf(stderr, "kernel_launch: occupancy query reports %d\n", per_cu);
        (void)hipGetLastError();
        grid = cus;
        if (grid != 256) fprintf(stderr, "kernel_launch: %d CUs; this build assumes 256\n", grid);
    }
    if (grid < 0) return;
    (void)hipMemsetAsync((char*)d_ws + WS_CTL, 0, CTL_ZERO_BYTES, stream);
    Args a{};
    for (int i = 0; i < 22; ++i) a.in[i] = (const float*)d_in[i];
    a.out = (float*)d_out; a.ws = (unsigned char*)d_ws;
    if (MK_N_LAUNCHES == 1) { a.ph_lo = 0; a.ph_hi = NPHASE; hipLaunchKernelGGL(mk_fwd, dim3(grid), dim3(NWAVES * 64), LDS_BYTES, stream, a); }
    else { for (int p = 0; p < NPHASE; ++p) { a.ph_lo = p; a.ph_hi = p + 1; hipLaunchKernelGGL(mk_fwd, dim3(grid), dim3(NWAVES * 64), LDS_BYTES, stream, a); } }
}
```

```cpp
#include <hip/hip_runtime.h>
#ifndef PROBE_SEL
#define PROBE_SEL -1
#endif
#ifndef PROBE_AMP
#define PROBE_AMP 1
#endif
#include <hip/hip_bf16.h>
#include <cstdio>
#include <cstdint>
#include <cmath>

#ifndef PH_MASK
#define PH_MASK 0x7ff
#endif
#ifndef MK_N_LAUNCHES
#define MK_N_LAUNCHES 1
#endif

constexpr int S = 8192, DM = 2048, INC = 10248, NIN = 10240, NEXP = 32, FF = 512;
constexpr size_t QUS = (size_t)S * 128 + 40960;
constexpr float ALPHA = 1.189207115002721f;
constexpr float LN_EPS = 1e-5f;
constexpr float LAM_INIT = 0.2f;
constexpr float INV_SCALE = 11.313708498984761f;
constexpr float FOX_THR_RAW = 36.f * 11.313708498984761f;

#define LAS __attribute__((address_space(3)))
#define GAS __attribute__((address_space(1)))
typedef unsigned short bf16_t;
typedef short bf16x8 __attribute__((ext_vector_type(8)));
typedef short s16x4 __attribute__((ext_vector_type(4)));
typedef float f32x4 __attribute__((ext_vector_type(4)));
typedef float f32x2 __attribute__((ext_vector_type(2)));
typedef float f32x16 __attribute__((ext_vector_type(16)));
typedef unsigned u32x4 __attribute__((ext_vector_type(4)));
typedef unsigned u32x2 __attribute__((ext_vector_type(2)));
typedef GAS unsigned gu32;

typedef __bf16 bf16x2_t __attribute__((ext_vector_type(2)));
__device__ __forceinline__ unsigned cvt_pk_bf16(float lo, float hi) { f32x2 v = {lo, hi}; bf16x2_t b = __builtin_convertvector(v, bf16x2_t); return __builtin_bit_cast(unsigned, b); }
__device__ __forceinline__ float bf_lo(unsigned w) { return __uint_as_float(w << 16); }
__device__ __forceinline__ float bf_hi(unsigned w) { return __uint_as_float(w & 0xffff0000u); }
__device__ __forceinline__ float wave_sum(float v) {
#define WS_DPP(ctrl, rmask) v += __int_as_float(__builtin_amdgcn_update_dpp(0, __float_as_int(v), ctrl, rmask, 0xf, false))
    WS_DPP(0xB1, 0xf);
    WS_DPP(0x4E, 0xf);
    WS_DPP(0x141, 0xf);
    WS_DPP(0x140, 0xf);
    WS_DPP(0x142, 0xa);
    WS_DPP(0x143, 0xc);
#undef WS_DPP
    return __int_as_float(__builtin_amdgcn_readlane(__float_as_int(v), 63));
}

namespace pg8 {
constexpr int BM = 256, BK = 64, HALF = 128, HTB = HALF * BK * 2, STAGE_BYTES = 8 * HTB, NXCD = 8, WGM = 8;
__host__ __device__ __forceinline__ int lds_byte(int r, int c) { const int st = (r >> 4) * 2 + (c >> 5), rr = r & 15, cc = c & 31, ob = rr * 64 + cc * 2; return st * 1024 + (ob ^ (((ob >> 9) & 1) << 5)); }
__host__ __device__ __forceinline__ void stage_rc(int b, int& R, int& C) { const int st = b / 1024, sb = b % 1024, swz = sb ^ (((sb >> 9) & 1) << 5); R = (st >> 1) * 16 + swz / 64; C = (st & 1) * 32 + (swz % 64) / 2; }
__host__ __device__ __forceinline__ int perm32(int rho) { const int n = rho >> 4, i = rho & 15; return 8 * (i >> 2) + 4 * n + (i & 3); }

struct Unit { int pm, pn; };
struct Gemm { const bf16_t* A; const bf16_t* Bt; int K, lda, ldb; const LAS int* rowidx; };

struct StaticOrder {
    int nM, nN, nwg, G, c;
    __device__ void init(int M, int N, int G_, int c_) { nM = M / BM; nN = N / BM; nwg = nM * nN; G = G_; c = c_; }
    __device__ bool next(int i, Unit& u) const {
        const long L = (long)i * G + c; if (L >= nwg) return false;
        int wgid = (int)L; { const int q = nwg / NXCD, r = nwg % NXCD, xcd = wgid % NXCD, off = wgid / NXCD; wgid = (xcd < r ? xcd * (q + 1) : r * (q + 1) + (xcd - r) * q) + off; }
        const int nig = WGM * nN, gid = wgid / nig, fm = gid * WGM, gsz = (nM - fm) < WGM ? (nM - fm) : WGM;
        u.pm = fm + ((wgid % nig) % gsz); u.pn = (wgid % nig) / gsz; return true;
    }
};
struct SingleUnit { Unit u; __device__ bool next(int i, Unit& o) const { if (i) return false; o = u; return true; } };
struct UnitRun { Unit u; int n; __device__ bool next(int i, Unit& o) const { if (i >= n) return false; o.pm = u.pm; o.pn = u.pn + i; return true; } };

typedef f32x4 Acc[2][2][4][2];

template <class Epi, class Sched, bool GATHER, bool HOOK = false>
__device__ __forceinline__ void gemm_phase(LAS unsigned char* lds, const Gemm g, const Sched& S, const Epi& E) {
    int tid = threadIdx.x; asm volatile("" : "+v"(tid));
    const int wid = __builtin_amdgcn_readfirstlane(tid >> 6), lane = tid & 63, wr = wid >> 2, wc = wid & 3, fr = lane & 15, fq = lane >> 4;
    const int K = g.K, nt = K / BK;
    unsigned voffA[2], voffA1[2], voffB[2];
#pragma unroll
    for (int i = 0; i < 2; ++i) { int R, C; stage_rc(tid * 16 + i * 8192, R, C); const int Rb = (R & ~31) + perm32(R & 31);
        if constexpr (GATHER) { voffA[i] = (unsigned)(g.rowidx[R] * g.lda + C) * 2u; voffA1[i] = (unsigned)(g.rowidx[HALF + R] * g.lda + C) * 2u; }
        else { voffA[i] = (unsigned)(R * g.lda + C) * 2u; voffA1[i] = 0u; }
        voffB[i] = (unsigned)(Rb * g.ldb + C) * 2u; }
    const size_t kstep = (size_t)(BK * 2);
    const size_t hstepA = GATHER ? 0 : (size_t)HALF * g.lda * 2, hstepB = (size_t)HALF * g.ldb * 2;
    const size_t tstepA = GATHER ? 0 : 2 * hstepA, tstepB = 2 * hstepB;
    const unsigned ldsw = (unsigned)wid * 1024u;
    const int aoff = lds_byte(wr * 64 + fr, fq * 8), boff = lds_byte(wc * 32 + fr, fq * 8);
#define PG8_SA(b, h) (((b) * 2 + (h)) * HTB)
#define PG8_SB(b, h) ((4 + (b) * 2 + (h)) * HTB)
#define PG8_STAGE(bufoff, gbase, voff) do { _Pragma("unroll") for (int _i = 0; _i < 2; ++_i) \
        __builtin_amdgcn_global_load_lds((const unsigned*)((const char*)(gbase) + (voff)[_i]), (LAS unsigned*)(lds + (bufoff) + ldsw + _i * 8192), 16, 0, 0); } while (0)
#define PG8_STAGE_A0(bufoff, gbase) PG8_STAGE(bufoff, gbase, voffA)
#define PG8_STAGE_A1(bufoff, gbase) do { if constexpr (GATHER) { PG8_STAGE(bufoff, gbase, voffA1); } else { PG8_STAGE(bufoff, (gbase) + hstepA, voffA); } } while (0)
#define PG8_LDA(dst, b, h) do { _Pragma("unroll") for (int m = 0; m < 4; ++m) _Pragma("unroll") for (int k = 0; k < 2; ++k) dst[m][k] = *(const LAS bf16x8*)(lds + PG8_SA(b, h) + aoff + m * 2048 + k * 1024); } while (0)
#define PG8_LDB(dst, b, h) do { _Pragma("unroll") for (int n = 0; n < 2; ++n) _Pragma("unroll") for (int k = 0; k < 2; ++k) dst[n][k] = *(const LAS bf16x8*)(lds + PG8_SB(b, h) + boff + n * 2048 + k * 1024); } while (0)
#define PG8_MMA(ai, bj, At, Bt) do { __builtin_amdgcn_s_setprio(1); _Pragma("unroll") for (int m = 0; m < 4; ++m) _Pragma("unroll") for (int n = 0; n < 2; ++n) _Pragma("unroll") for (int k = 0; k < 2; ++k) \
        acc[ai][bj][m][n] = __builtin_amdgcn_mfma_f32_16x16x32_bf16(Bt[n][k], At[m][k], acc[ai][bj][m][n], 0, 0, 0); __builtin_amdgcn_s_setprio(0); } while (0)
#define PG8_WAIT_V(n) asm volatile("s_waitcnt vmcnt(" #n ")" ::: "memory")
#define PG8_WAIT_L(n) asm volatile("s_waitcnt lgkmcnt(" #n ")" ::: "memory")
#define PG8_BAR __builtin_amdgcn_s_barrier()
#define PG8_SCHED __builtin_amdgcn_sched_barrier(0)
    Unit cur, nxt; int ui = 0;
    if (!S.next(0, cur)) return;
    Acc acc;
#pragma unroll
    for (int a = 0; a < 2; ++a)
#pragma unroll
        for (int b = 0; b < 2; ++b)
#pragma unroll
            for (int m = 0; m < 4; ++m)
#pragma unroll
                for (int n = 0; n < 2; ++n) acc[a][b][m][n] = (f32x4){0.f, 0.f, 0.f, 0.f};
    bf16x8 At[4][2], B0[2][2], B1[2][2];
    const char* cA = (const char*)g.A + (size_t)cur.pm * tstepA; const char* cB = (const char*)g.Bt + (size_t)cur.pn * tstepB;
    PG8_STAGE(PG8_SB(0, 0), cB, voffB); PG8_STAGE(PG8_SB(0, 1), cB + hstepB, voffB); PG8_STAGE_A0(PG8_SA(0, 0), cA); PG8_STAGE_A1(PG8_SA(0, 1), cA);
    if (wr == 1) PG8_BAR;
    PG8_WAIT_V(2); PG8_BAR;
    PG8_STAGE(PG8_SB(1, 0), cB + kstep, voffB); PG8_STAGE_A0(PG8_SA(1, 0), cA + kstep); PG8_STAGE(PG8_SB(1, 1), cB + hstepB + kstep, voffB);
    PG8_WAIT_V(6); PG8_BAR;
    for (;;) {
        const bool has_next = S.next(ui + 1, nxt);
        const char* nA = has_next ? (const char*)g.A + (size_t)nxt.pm * tstepA : cA; const char* nB = has_next ? (const char*)g.Bt + (size_t)nxt.pn * tstepB : cB;
        for (int t = 0; t < nt; t += 2) {
            if constexpr (HOOK) { if (t == nt / 2) { E.hook(acc, cur, wr, wc, fr, fq); PG8_SCHED; } }
            const bool last = (t == nt - 2);
            const char* a1 = cA + (size_t)(t + 1) * kstep;
            const char* a2 = last ? nA : cA + (size_t)(t + 2) * kstep; const char* b2 = last ? nB : cB + (size_t)(t + 2) * kstep;
            const char* a3 = a2 + kstep; const char* b3 = b2 + kstep;
            PG8_LDB(B0, 0, 0); PG8_LDB(B1, 0, 1); PG8_SCHED; PG8_LDA(At, 0, 0); PG8_STAGE_A1(PG8_SA(1, 1), a1);
            PG8_WAIT_V(8); PG8_WAIT_L(0); PG8_BAR; PG8_MMA(0, 0, At, B0); PG8_MMA(0, 1, At, B1); PG8_BAR; PG8_SCHED;
            PG8_LDA(At, 0, 1); PG8_STAGE(PG8_SB(0, 0), b2, voffB); PG8_STAGE(PG8_SB(0, 1), b2 + hstepB, voffB); PG8_STAGE_A0(PG8_SA(0, 0), a2);
            PG8_WAIT_V(8); PG8_WAIT_L(0); PG8_BAR; PG8_MMA(1, 0, At, B0); PG8_MMA(1, 1, At, B1); PG8_BAR; PG8_SCHED;
            PG8_LDB(B0, 1, 0); PG8_LDB(B1, 1, 1); PG8_SCHED; PG8_LDA(At, 1, 0); PG8_STAGE_A1(PG8_SA(0, 1), a2);
            PG8_WAIT_V(8); PG8_WAIT_L(0); PG8_BAR; PG8_MMA(0, 0, At, B0); PG8_MMA(0, 1, At, B1); PG8_BAR; PG8_SCHED;
            PG8_LDA(At, 1, 1); PG8_STAGE(PG8_SB(1, 0), b3, voffB); PG8_STAGE(PG8_SB(1, 1), b3 + hstepB, voffB); PG8_STAGE_A0(PG8_SA(1, 0), a3);
            PG8_WAIT_V(8); PG8_WAIT_L(0); PG8_BAR; PG8_MMA(1, 0, At, B0); PG8_MMA(1, 1, At, B1); PG8_BAR; PG8_SCHED;
        }
        if (wr == 0) PG8_BAR;
        E(acc, cur, wr, wc, fr, fq);
        if (!has_next) break;
#pragma unroll
        for (int a = 0; a < 2; ++a)
#pragma unroll
            for (int b = 0; b < 2; ++b)
#pragma unroll
                for (int m = 0; m < 4; ++m)
#pragma unroll
                    for (int n = 0; n < 2; ++n) acc[a][b][m][n] = (f32x4){0.f, 0.f, 0.f, 0.f};
        cur = nxt; cA = nA; cB = nB; ++ui;
        if (wr == 1) PG8_BAR;
    }
    PG8_WAIT_V(0);
    PG8_BAR;
#undef PG8_SA
#undef PG8_SB
#undef PG8_STAGE
#undef PG8_STAGE_A0
#undef PG8_STAGE_A1
#undef PG8_LDA
#undef PG8_LDB
#undef PG8_MMA
#undef PG8_WAIT_V
#undef PG8_WAIT_L
#undef PG8_BAR
#undef PG8_SCHED
}

__device__ __forceinline__ void store16_wt(void* p, u32x4 v) { asm volatile("global_store_dwordx4 %0, %1, off sc1\n\ts_nop 1" :: "v"(p), "v"(v) : "memory"); }
__device__ __forceinline__ u32x4 pack8(f32x4 a, f32x4 b) { u32x4 w; w.x = cvt_pk_bf16(a[0], a[1]); w.y = cvt_pk_bf16(a[2], a[3]); w.z = cvt_pk_bf16(b[0], b[1]); w.w = cvt_pk_bf16(b[2], b[3]); return w; }
__device__ __forceinline__ f32x4 sigmoid4(f32x4 v) { f32x4 r;
#pragma unroll
    for (int i = 0; i < 4; ++i) r[i] = __builtin_amdgcn_rcpf(1.f + __builtin_amdgcn_exp2f(-1.4426950408889634f * v[i])); return r; }

struct EpiInProj {
    bf16_t* QKV; bf16_t* G; const float* rope; float* NP;
    __device__ __forceinline__ void operator()(const Acc& acc, const Unit& u, int wr, int wc, int fr, int fq) const {
        const int row0 = u.pm * BM + wr * 64 + fr;
        if (u.pn < 8) {
            const int g4 = 4 * (4 * wc + fq);
#pragma unroll
            for (int ai = 0; ai < 2; ++ai)
#pragma unroll
                for (int m = 0; m < 4; ++m) { const int r = row0 + ai * HALF + m * 16;
                    const f32x4 cs = *(const f32x4*)(rope + (size_t)r * 128 + g4), sn = *(const f32x4*)(rope + (size_t)r * 128 + 64 + g4);
#pragma unroll
                    for (int bj = 0; bj < 2; ++bj) { const f32x4 t1 = acc[ai][bj][m][0], t2 = acc[ai][bj][m][1];
                        const f32x4 o1 = t1 * cs - t2 * sn, o2 = t1 * sn + t2 * cs;
                        bf16_t* dst = QKV + (size_t)(2 * u.pn + bj) * QUS + (size_t)r * 128;
                        u32x2 w1, w2; w1.x = cvt_pk_bf16(o1[0], o1[1]); w1.y = cvt_pk_bf16(o1[2], o1[3]); w2.x = cvt_pk_bf16(o2[0], o2[1]); w2.y = cvt_pk_bf16(o2[2], o2[3]);
                        *(u32x2*)(dst + g4) = w1; *(u32x2*)(dst + 64 + g4) = w2; } }
        } else if (u.pn < 24) {
#pragma unroll
            for (int ai = 0; ai < 2; ++ai)
#pragma unroll
                for (int m = 0; m < 4; ++m) { const int r = row0 + ai * HALF + m * 16;
#pragma unroll
                    for (int bj = 0; bj < 2; ++bj) *(u32x4*)(QKV + (size_t)(2 * u.pn + bj) * QUS + (size_t)r * 128 + wc * 32 + 8 * fq) = pack8(acc[ai][bj][m][0], acc[ai][bj][m][1]); }
            if (u.pn >= 12 && u.pn < 20) {
#pragma unroll
                for (int ai = 0; ai < 2; ++ai)
#pragma unroll
                    for (int bj = 0; bj < 2; ++bj) { float mx = 0.f;
#pragma unroll
                        for (int m = 0; m < 4; ++m) { const f32x4 a = acc[ai][bj][m][0], b = acc[ai][bj][m][1];
                            float ss = (a[0] * a[0] + a[1] * a[1]) + (a[2] * a[2] + a[3] * a[3]) + (b[0] * b[0] + b[1] * b[1]) + (b[2] * b[2] + b[3] * b[3]);
                            ss += __shfl_xor(ss, 16); ss += __shfl_xor(ss, 32); mx = fmaxf(mx, ss); }
                        mx = fmaxf(mx, __shfl_xor(mx, 1)); mx = fmaxf(mx, __shfl_xor(mx, 2)); mx = fmaxf(mx, __shfl_xor(mx, 4)); mx = fmaxf(mx, __shfl_xor(mx, 8));
                        if (fr == 0 && fq == 0) NP[((size_t)(2 * u.pn + bj - 24) * 128 + 4 * u.pm + 2 * ai + wr) * 4 + wc] = mx; }
            }
        } else {
            const int col0 = (u.pn - 24) * BM + wc * 32 + 8 * fq;
#pragma unroll
            for (int ai = 0; ai < 2; ++ai)
#pragma unroll
                for (int m = 0; m < 4; ++m) { const int r = row0 + ai * HALF + m * 16;
#pragma unroll
                    for (int bj = 0; bj < 2; ++bj) *(u32x4*)(G + (size_t)r * 4096 + col0 + bj * HALF) = pack8(sigmoid4(acc[ai][bj][m][0]), sigmoid4(acc[ai][bj][m][1])); }
        }
    }
};
struct EpiGateT {
    float* T; const bf16_t* G;
    __device__ __forceinline__ void operator()(const Acc& acc, const Unit& u, int wr, int wc, int fr, int fq) const {
        const int row0 = u.pm * BM + wr * 64 + fr, col0 = u.pn * BM + wc * 32 + 8 * fq;
#pragma unroll
        for (int ai = 0; ai < 2; ++ai)
#pragma unroll
            for (int m = 0; m < 4; ++m) { const int r = row0 + ai * HALF + m * 16;
#pragma unroll
                for (int bj = 0; bj < 2; ++bj) { const int c = col0 + bj * HALF; const u32x4 gw = *(const u32x4*)(G + (size_t)r * 4096 + c);
                    const f32x4 g0 = {bf_lo(gw.x), bf_hi(gw.x), bf_lo(gw.y), bf_hi(gw.y)}, g1 = {bf_lo(gw.z), bf_hi(gw.z), bf_lo(gw.w), bf_hi(gw.w)};
                    *(f32x4*)(T + (size_t)r * DM + c) = acc[ai][bj][m][0] * g0; *(f32x4*)(T + (size_t)r * DM + c + 4) = acc[ai][bj][m][1] * g1; } }
    }
};
struct EpiGateM {
    const float* T; const bf16_t* G; bf16_t* MB;
    __device__ __forceinline__ void operator()(const Acc& acc, const Unit& u, int wr, int wc, int fr, int fq) const {
        const int row0 = u.pm * BM + wr * 64 + fr, col0 = u.pn * BM + wc * 32 + 8 * fq;
#pragma unroll
        for (int ai = 0; ai < 2; ++ai)
#pragma unroll
            for (int m = 0; m < 4; ++m) { const int r = row0 + ai * HALF + m * 16;
#pragma unroll
                for (int bj = 0; bj < 2; ++bj) { const int c = col0 + bj * HALF; const u32x4 gw = *(const u32x4*)(G + (size_t)r * 4096 + 2048 + c);
                    const f32x4 g0 = {bf_lo(gw.x), bf_hi(gw.x), bf_lo(gw.y), bf_hi(gw.y)}, g1 = {bf_lo(gw.z), bf_hi(gw.z), bf_lo(gw.w), bf_hi(gw.w)};
                    const f32x4 t0 = *(const f32x4*)(T + (size_t)r * DM + c), t1 = *(const f32x4*)(T + (size_t)r * DM + c + 4);
                    *(u32x4*)(MB + (size_t)r * DM + c) = pack8(t0 + acc[ai][bj][m][0] * g0, t1 + acc[ai][bj][m][1] * g1); } }
    }
};
struct EpiGateHook {
    const bf16_t* G; bf16_t* MB;
    __device__ __forceinline__ void hook(Acc& acc, const Unit& u, int wr, int wc, int fr, int fq) const {
        int row0 = u.pm * BM + wr * 64 + fr, col0 = u.pn * BM + wc * 32 + 8 * fq;
        asm volatile("" : "+v"(row0), "+v"(col0));
#pragma unroll
        for (int ai = 0; ai < 2; ++ai)
#pragma unroll
            for (int m = 0; m < 4; ++m) { int r = row0 + ai * HALF + m * 16; asm volatile("" : "+v"(r));
#pragma unroll
                for (int bj = 0; bj < 2; ++bj) { const int c = col0 + bj * HALF; const u32x4 gd = *(const u32x4*)(G + (size_t)r * 4096 + c), gf = *(const u32x4*)(G + (size_t)r * 4096 + 2048 + c);
                    const f32x4 d0 = {bf_lo(gd.x), bf_hi(gd.x), bf_lo(gd.y), bf_hi(gd.y)}, d1 = {bf_lo(gd.z), bf_hi(gd.z), bf_lo(gd.w), bf_hi(gd.w)};
                    f32x4 f0 = {bf_lo(gf.x), bf_hi(gf.x), bf_lo(gf.y), bf_hi(gf.y)}, f1 = {bf_lo(gf.z), bf_hi(gf.z), bf_lo(gf.w), bf_hi(gf.w)};
#pragma unroll
                    for (int i = 0; i < 4; ++i) { f0[i] = __builtin_amdgcn_rcpf(fmaxf(f0[i], 1e-30f)); f1[i] = __builtin_amdgcn_rcpf(fmaxf(f1[i], 1e-30f)); }
                    acc[ai][bj][m][0] = acc[ai][bj][m][0] * (d0 * f0); acc[ai][bj][m][1] = acc[ai][bj][m][1] * (d1 * f1); }
                asm volatile("" ::: "memory"); }
    }
    __device__ __forceinline__ void operator()(const Acc& acc, const Unit& u, int wr, int wc, int fr, int fq) const {
        const int row0 = u.pm * BM + wr * 64 + fr, col0 = u.pn * BM + wc * 32 + 8 * fq;
#pragma unroll
        for (int ai = 0; ai < 2; ++ai)
#pragma unroll
            for (int m = 0; m < 4; ++m) { const int r = row0 + ai * HALF + m * 16;
#pragma unroll
                for (int bj = 0; bj < 2; ++bj) { const int c = col0 + bj * HALF; const u32x4 gw = *(const u32x4*)(G + (size_t)r * 4096 + 2048 + c);
                    const f32x4 g0 = {bf_lo(gw.x), bf_hi(gw.x), bf_lo(gw.y), bf_hi(gw.y)}, g1 = {bf_lo(gw.z), bf_hi(gw.z), bf_lo(gw.w), bf_hi(gw.w)};
                    *(u32x4*)(MB + (size_t)r * DM + c) = pack8(acc[ai][bj][m][0] * g0, acc[ai][bj][m][1] * g1); } }
    }
};
struct EpiZ {
    bf16_t* YO;
    __device__ __forceinline__ void operator()(const Acc& acc, const Unit& u, int wr, int wc, int fr, int fq) const {
        const int row0 = u.pm * BM + wr * 64 + fr, col0 = u.pn * BM + wc * 32 + 8 * fq;
#pragma unroll
        for (int ai = 0; ai < 2; ++ai)
#pragma unroll
            for (int m = 0; m < 4; ++m) { const int r = row0 + ai * HALF + m * 16;
#pragma unroll
                for (int bj = 0; bj < 2; ++bj) *(u32x4*)(YO + (size_t)r * DM + col0 + bj * HALF) = pack8(acc[ai][bj][m][0], acc[ai][bj][m][1]); }
    }
};
struct EpiSwiGLU {
    bf16_t* H;
    __device__ __forceinline__ void operator()(const Acc& acc, const Unit& u, int wr, int wc, int fr, int fq) const {
        const int row0 = u.pm * BM + wr * 64 + fr, col0 = u.pn * HALF + wc * 32 + 8 * fq;
#pragma unroll
        for (int ai = 0; ai < 2; ++ai)
#pragma unroll
            for (int m = 0; m < 4; ++m) { const int r = row0 + ai * HALF + m * 16; f32x4 h[2];
#pragma unroll
                for (int n = 0; n < 2; ++n) { const f32x4 gt = acc[ai][0][m][n], up = acc[ai][1][m][n]; h[n] = gt * sigmoid4(gt) * up; }
                store16_wt(H + (size_t)r * FF + col0, pack8(h[0], h[1])); }
    }
};
struct EpiY {
    bf16_t* Y;
    __device__ __forceinline__ void operator()(const Acc& acc, const Unit& u, int wr, int wc, int fr, int fq) const {
        const int row0 = u.pm * BM + wr * 64 + fr, col0 = (u.pn & 7) * BM + wc * 32 + 8 * fq;
#pragma unroll
        for (int ai = 0; ai < 2; ++ai)
#pragma unroll
            for (int m = 0; m < 4; ++m) { unsigned bo = (unsigned)((row0 + ai * HALF + m * 16) * DM + col0) * 2u; asm volatile("" : "+v"(bo));
#pragma unroll
                for (int bj = 0; bj < 2; ++bj) *(u32x4*)((char*)Y + bo + bj * HALF * 2) = pack8(acc[ai][bj][m][0], acc[ai][bj][m][1]); }
    }
};
}

namespace att {
using bf16 = __hip_bfloat16;
constexpr int D = 128, NW = 8, QBLK = 32, KVBLK = 64, QB = NW * QBLK;
constexpr int SHM_V = KVBLK * D * 2, SHM_K = KVBLK * D * 2;
constexpr int LDS_WS_OFF = 2 * SHM_V + 2 * SHM_K, LDS_BIAS_OFF = LDS_WS_OFF + NW * 64 * 4, LDS_BYTES = LDS_BIAS_OFF + 512;
constexpr float SCALE = 0.08838834764831845f;
constexpr float THR = 8.f;
#define KSWZ(row, colB) ((row) * 256 + ((colB) ^ (((row) & 7) << 4)))
#define SBAR() __builtin_amdgcn_sched_barrier(0)
__device__ __forceinline__ int v_st(int k, int c) { const int kk = (k & ~0xC) | ((k & 4) << 1) | ((k & 8) >> 1); return ((kk >> 3) * 4 + (c >> 5)) * 512 + ((kk & 7) * 32 + (c & 31)) * 2; }
__device__ __forceinline__ int v_rd_base(int lane) { return ((lane & 3) << 3) | (((lane >> 2) & 3) << 6) | (((lane >> 4) & 1) << 5) | (((lane >> 5) & 1) << 8); }
constexpr int v_rd_off(int d0, int ks, int half) { return d0 * 512 + ks * 4096 + half * 2048; }
__device__ __forceinline__ int crow(int r, int hi) { return (r & 3) + 8 * (r >> 2) + 4 * hi; }
__device__ __forceinline__ unsigned cvtpk(float lo, float hi) { unsigned r; asm volatile("v_cvt_pk_bf16_f32 %0, %1, %2" : "=v"(r) : "v"(lo), "v"(hi)); return r; }
__device__ __forceinline__ bf16x8 load8(const bf16* p) { return *reinterpret_cast<const bf16x8*>(p); }
__device__ __forceinline__ void mask_tile(f32x16& p0, f32x16& p1, int dq) {
    const float NEG = -__builtin_inff();
#pragma unroll
    for (int r = 0; r < 16; ++r) { const int c = (r & 3) + 8 * (r >> 2); if (dq - c < 0) p0[r] = NEG; if (dq - c - 32 < 0) p1[r] = NEG; }
}
__device__ __forceinline__ void partialSM(f32x16& p0, f32x16& p1, float& m_reg, float& mn, float& alpha) {
    float pmax = p0[0];
#pragma unroll
    for (int r = 1; r < 16; ++r) pmax = fmaxf(pmax, p0[r]);
#pragma unroll
    for (int r = 0; r < 16; ++r) pmax = fmaxf(pmax, p1[r]);
    { auto rr = __builtin_amdgcn_permlane32_swap(__float_as_uint(pmax), __float_as_uint(pmax), false, false); pmax = fmaxf(__uint_as_float(rr[0]), __uint_as_float(rr[1])); }
    constexpr float C2 = 1.4426950408889634f * SCALE;
    if (__builtin_expect(__all((pmax - m_reg) * SCALE <= THR), 1)) { mn = m_reg; alpha = 1.f; }
    else { mn = fmaxf(m_reg, pmax); alpha = __builtin_amdgcn_exp2f((m_reg - mn) * C2); m_reg = mn; }
    const float mnL = -mn * C2;
#pragma unroll
    for (int r = 0; r < 16; ++r) p0[r] = fmaf(p0[r], C2, mnL);
#pragma unroll
    for (int r = 0; r < 16; ++r) p1[r] = fmaf(p1[r], C2, mnL);
#pragma unroll
    for (int r = 0; r < 16; ++r) p0[r] = __builtin_amdgcn_exp2f(p0[r]);
}
__device__ __forceinline__ void finishSM(f32x16& p0, f32x16& p1, float alpha, float& l_reg, bf16x8& pa0, bf16x8& pa1, bf16x8& pa2, bf16x8& pa3) {
#pragma unroll
    for (int r = 0; r < 16; ++r) p1[r] = __builtin_amdgcn_exp2f(p1[r]);
    float ps = 0;
#pragma unroll
    for (int r = 0; r < 16; ++r) ps += p0[r];
#pragma unroll
    for (int r = 0; r < 16; ++r) ps += p1[r];
    { auto rr = __builtin_amdgcn_permlane32_swap(__float_as_uint(ps), __float_as_uint(ps), false, false); ps = __uint_as_float(rr[0]) + __uint_as_float(rr[1]); }
    l_reg = l_reg * alpha + ps;
#define PK4(P, B_, OUT) do { unsigned a0 = cvtpk(P[B_+0], P[B_+1]), a1 = cvtpk(P[B_+2], P[B_+3]);                          \
        unsigned b0 = cvtpk(P[B_+4], P[B_+5]), b1 = cvtpk(P[B_+6], P[B_+7]);                                             \
        auto r0 = __builtin_amdgcn_permlane32_swap(a0, b0, false, false); auto r1 = __builtin_amdgcn_permlane32_swap(a1, b1, false, false); \
        u32x4 w = {r0[0], r1[0], r0[1], r1[1]}; OUT = *reinterpret_cast<bf16x8*>(&w); } while (0)
    PK4(p0, 0, pa0); PK4(p0, 8, pa1); PK4(p1, 0, pa2); PK4(p1, 8, pa3);
#undef PK4
}
template <int KB>
__device__ __forceinline__ void qkt(f32x16& p0, f32x16& p1, const char* K_lds, const char* B_lds, int r32, int hi, const bf16x8* qr) {
    const float* bl = (const float*)(B_lds + KB * 256) + 4 * hi;
#pragma unroll
    for (int g = 0; g < 4; ++g) { const f32x4 b0 = *(const f32x4*)(bl + 8 * g), b1 = *(const f32x4*)(bl + 32 + 8 * g);
#pragma unroll
        for (int i = 0; i < 4; ++i) { p0[4 * g + i] = b0[i]; p1[4 * g + i] = b1[i]; } }
    const char* kb[4];
#pragma unroll
    for (int dd = 0; dd < 4; ++dd) kb[dd] = K_lds + KB * SHM_K + KSWZ(r32, (dd * 16 + hi * 8) * 2);
#pragma unroll
    for (int d0 = 0; d0 < 8; ++d0) { const char* a = kb[d0 & 3] + (d0 >> 2) * 128;
        bf16x8 b0 = *reinterpret_cast<const bf16x8*>(a);
        bf16x8 b1 = *reinterpret_cast<const bf16x8*>(a + 32 * 256);
        p0 = __builtin_amdgcn_mfma_f32_32x32x16_bf16(b0, qr[d0], p0, 0, 0, 0);
        p1 = __builtin_amdgcn_mfma_f32_32x32x16_bf16(b1, qr[d0], p1, 0, 0, 0); }
}
template <int VB>
__device__ __forceinline__ void pv_tile(f32x16* o, int vb0, bf16x8 pa0, bf16x8 pa1, bf16x8 pa2, bf16x8 pa3) {
#define TRRD(dst, off) asm volatile("ds_read_b64_tr_b16 %0, %1 offset:%2" : "=&v"(dst) : "v"(vb0), "i"(off) : "memory")
#define PV_D0(d0) do { s16x4 l0, l1, l2, l3, h0, h1, h2, h3; constexpr int b_ = VB * SHM_V + v_rd_off(d0, 0, 0); \
        TRRD(l0, b_); TRRD(h0, b_ + 2048); TRRD(l1, b_ + 4096); TRRD(h1, b_ + 6144); TRRD(l2, b_ + 8192); TRRD(h2, b_ + 10240); TRRD(l3, b_ + 12288); TRRD(h3, b_ + 14336); \
        asm volatile("s_waitcnt lgkmcnt(0)" ::: "memory"); SBAR();   \
        o[d0] = __builtin_amdgcn_mfma_f32_32x32x16_bf16(pa0, (bf16x8){l0[0], l0[1], l0[2], l0[3], h0[0], h0[1], h0[2], h0[3]}, o[d0], 0, 0, 0);   \
        o[d0] = __builtin_amdgcn_mfma_f32_32x32x16_bf16(pa1, (bf16x8){l1[0], l1[1], l1[2], l1[3], h1[0], h1[1], h1[2], h1[3]}, o[d0], 0, 0, 0);   \
        o[d0] = __builtin_amdgcn_mfma_f32_32x32x16_bf16(pa2, (bf16x8){l2[0], l2[1], l2[2], l2[3], h2[0], h2[1], h2[2], h2[3]}, o[d0], 0, 0, 0);   \
        o[d0] = __builtin_amdgcn_mfma_f32_32x32x16_bf16(pa3, (bf16x8){l3[0], l3[1], l3[2], l3[3], h3[0], h3[1], h3[2], h3[3]}, o[d0], 0, 0, 0); } while (0)
    PV_D0(0); PV_D0(1); PV_D0(2); PV_D0(3);
#undef PV_D0
#undef TRRD
}
struct BlockRef { const bf16* Q; const bf16* K; const bf16* V; const float* B; bf16* O; int ostride; int P0; int jlo; };
struct Seam { bf16x8 qr[8]; bf16x8 st_v0, st_v1, st_k0, st_k1; };
#define ROW(p, k0, rr) ((p) + (size_t)((k0) + (rr)) * D + sc)
#define VMW() asm volatile("s_waitcnt vmcnt(0)" ::: "memory")
#define VMWN(n) asm volatile("s_waitcnt vmcnt(%0)" :: "i"(n) : "memory")
#define SLOAD_H(Kp, Vp, k0) do { S.st_v0 = load8(ROW(Vp, k0, sr)); S.st_v1 = load8(ROW(Vp, k0, 32 + sr));              \
                         S.st_k0 = load8(ROW(Kp, k0, sr)); S.st_k1 = load8(ROW(Kp, k0, 32 + sr)); } while (0)
#define BLOAD(Bp, k0, bf) do { if (wid == 0) __builtin_amdgcn_global_load_lds((const unsigned*)((Bp) + (k0) + lane), (LAS unsigned*)(lds3 + LDS_BIAS_OFF + (bf) * 256), 4, 0, 0); } while (0)
#define SWRITE_HK(bf) do { *(bf16x8*)(K_lds + (bf) * SHM_K + kws) = S.st_k0; *(bf16x8*)(K_lds + (bf) * SHM_K + kws + 32 * 256) = S.st_k1; } while (0)
#define SWRITE_HV(bf) do { *(bf16x8*)(V_lds + (bf) * SHM_V + vst0) = S.st_v0; *(bf16x8*)(V_lds + (bf) * SHM_V + vst1) = S.st_v1; } while (0)
#define SWRITE_H(bf) do { SWRITE_HV(bf); SWRITE_HK(bf); } while (0)
__device__ __forceinline__ void attn_prime(const BlockRef& cur, char* lds, LAS unsigned char* lds3, Seam& S) {
    int tid = threadIdx.x; asm volatile("" : "+v"(tid)); const int wid = __builtin_amdgcn_readfirstlane(tid >> 6), lane = tid & 63, r32 = lane & 31, hi = lane >> 5;
    const int sr = tid >> 4, sc = (tid & 15) * 8, kws = KSWZ(sr, sc * 2); char* K_lds = lds + 2 * SHM_V;
#pragma unroll
    for (int d0 = 0; d0 < 8; ++d0) S.qr[d0] = load8(cur.Q + (size_t)(wid * QBLK + r32) * D + d0 * 16 + hi * 8);
    SLOAD_H(cur.K, cur.V, 0); BLOAD(cur.B, 0, 0); VMW(); SWRITE_HK(0);
    __syncthreads();
}
__device__ __forceinline__ void attn_block(const BlockRef& cur, const BlockRef& nxt, char* lds, LAS unsigned char* lds3, Seam& S) {
    int tid = threadIdx.x; asm volatile("" : "+v"(tid)); const int wid = __builtin_amdgcn_readfirstlane(tid >> 6), lane = tid & 63, r32 = lane & 31, hi = lane >> 5;
    const int NT = (cur.P0 + QB) / KVBLK - cur.jlo;
    const int qlo = cur.P0 + wid * QBLK, qm = qlo + r32 - 4 * hi;
    char* V_lds = lds; char* K_lds = lds + 2 * SHM_V; const char* B_lds = lds + LDS_BIAS_OFF;
    float* ws = (float*)(lds + LDS_WS_OFF) + wid * 64; float* li_l = ws, * al_l = ws + 32;
    float m_reg = -1e30f, l_reg = 0; f32x16 o[4] = {};
    const int sr = tid >> 4, sc = (tid & 15) * 8, vst0 = v_st(sr, sc), vst1 = v_st(32 + sr, sc), kws = KSWZ(sr, sc * 2);
    const int vb0 = (int)(uintptr_t)V_lds + v_rd_base(lane);
    const bf16* Kh = cur.K; const bf16* Vh = cur.V; const float* Bh = cur.B;
#define RESC(a) do { if (__any((a) < 1.f)) { if (hi == 0) al_l[r32] = (a); asm volatile("s_waitcnt lgkmcnt(0)" ::: "memory");              \
                     _Pragma("unroll") for (int d_ = 0; d_ < 4; ++d_) _Pragma("unroll") for (int r = 0; r < 16; ++r) o[d_][r] *= al_l[crow(r, hi)]; } } while (0)
#define KBASE(t) ((t) * KVBLK)
#define MASKT(P0_, P1_, t) do { const int kb_ = KBASE((t) + cur.jlo); if (kb_ + KVBLK - 1 > qlo) mask_tile(P0_, P1_, qm - kb_); } while (0)
    f32x16 pA0, pA1, pB0, pB1; float mnA, mnB, alA, alB; bf16x8 pa0, pa1, pa2, pa3;
    SWRITE_HV(0); SBAR();
    SLOAD_H(Kh, Vh, KBASE(1)); BLOAD(Bh, KBASE(1), 1);
    SBAR(); qkt<0>(pA0, pA1, K_lds, B_lds, r32, hi, S.qr);
    MASKT(pA0, pA1, 0); partialSM(pA0, pA1, m_reg, mnA, alA);
    VMW(); SWRITE_H(1);
    __syncthreads();
#define HALF_STEP(PX0, PX1, mnX, alX, PY0, PY1, alY, t, KB, VB, SB) do {                                                      \
        SBAR(); qkt<KB>(PX0, PX1, K_lds, B_lds, r32, hi, S.qr);                                                               \
        finishSM(PY0, PY1, alY, l_reg, pa0, pa1, pa2, pa3); SBAR();                                                           \
        if ((t) + 1 < NT) { SLOAD_H(Kh, Vh, KBASE((t) + 1)); BLOAD(Bh, KBASE((t) + 1), SB); SBAR(); }                        \
        pv_tile<VB>(o, vb0, pa0, pa1, pa2, pa3); MASKT(PX0, PX1, (t)); partialSM(PX0, PX1, m_reg, mnX, alX);                  \
        __syncthreads();                                                                                                      \
        if ((t) + 1 < NT) { VMW(); SWRITE_H(SB); }                                                                            \
        RESC(alX); __syncthreads(); } while (0)
    for (int t = 1; t + 1 < NT; t += 2) {
        HALF_STEP(pB0, pB1, mnB, alB, pA0, pA1, alA, t, 1, 0, 0);
        HALF_STEP(pA0, pA1, mnA, alA, pB0, pB1, alB, t + 1, 0, 1, 1);
    }
    SBAR(); qkt<1>(pB0, pB1, K_lds, B_lds, r32, hi, S.qr); SBAR();
    SLOAD_H(nxt.K, nxt.V, 0); BLOAD(nxt.B, 0, 0); SBAR();
#pragma unroll
    for (int d0 = 0; d0 < 8; ++d0) S.qr[d0] = load8(nxt.Q + (size_t)(wid * QBLK + r32) * D + d0 * 16 + hi * 8);
    SBAR();
    finishSM(pA0, pA1, alA, l_reg, pa0, pa1, pa2, pa3); SBAR();
    pv_tile<0>(o, vb0, pa0, pa1, pa2, pa3);
    MASKT(pB0, pB1, NT - 1); partialSM(pB0, pB1, m_reg, mnB, alB); __syncthreads(); RESC(alB);
    finishSM(pB0, pB1, alB, l_reg, pa0, pa1, pa2, pa3); SBAR(); pv_tile<1>(o, vb0, pa0, pa1, pa2, pa3);
    SBAR(); VMWN(8); SWRITE_HK(0); SBAR();
    if (hi == 0) li_l[r32] = l_reg; asm volatile("s_waitcnt lgkmcnt(0)" ::: "memory");
    float rli[16];
#pragma unroll
    for (int r = 0; r < 16; ++r) rli[r] = __builtin_amdgcn_rcpf(li_l[crow(r, hi)]);
    bf16* Ow = cur.O + (size_t)(wid * QBLK) * cur.ostride;
#pragma unroll
    for (int r = 0; r < 16; ++r) { const int orow = crow(r, hi);
#pragma unroll
        for (int d0 = 0; d0 < 4; ++d0) { const float v = o[d0][r] * rli[r];
            const float vn = __shfl_xor(v, 1);
            if ((r32 & 1) == 0) *(unsigned*)(Ow + (size_t)orow * cur.ostride + d0 * 32 + r32) = cvtpk(v, vn); } }
    __syncthreads();
#undef RESC
#undef KBASE
#undef MASKT
#undef HALF_STEP
}

constexpr int DV1_OFF = 32768, DK_OFF = 65536, DP_OFF = 98304, DWS_OFF = 131072, DATT_LDS_END = DWS_OFF + 2048;
struct DRef { const bf16* Q; const bf16* K; const bf16* V0; const bf16* V1; bf16* O0; bf16* O1; int P0; };
template <int KB>
__device__ __forceinline__ void qkt0(f32x16& p0, f32x16& p1, const char* K_lds, int r32, int hi, const bf16x8* qr) {
    p0 = f32x16{}; p1 = f32x16{};
    const char* kb[4];
#pragma unroll
    for (int dd = 0; dd < 4; ++dd) kb[dd] = K_lds + KB * SHM_K + KSWZ(r32, (dd * 16 + hi * 8) * 2);
#pragma unroll
    for (int d0 = 0; d0 < 8; ++d0) { const char* a = kb[d0 & 3] + (d0 >> 2) * 128;
        bf16x8 b0 = *reinterpret_cast<const bf16x8*>(a);
        bf16x8 b1 = *reinterpret_cast<const bf16x8*>(a + 32 * 256);
        p0 = __builtin_amdgcn_mfma_f32_32x32x16_bf16(b0, qr[d0], p0, 0, 0, 0);
        p1 = __builtin_amdgcn_mfma_f32_32x32x16_bf16(b1, qr[d0], p1, 0, 0, 0); }
}
#define D_KLOAD(Kp, k0) do { _Pragma("unroll") for (int j_ = 0; j_ < 4; ++j_) kst[j_] = load8((Kp) + (size_t)((k0) + sr + 16 * j_) * D + sc); } while (0)
#define D_KWRITE(bf) do { _Pragma("unroll") for (int j_ = 0; j_ < 4; ++j_) *(bf16x8*)(K_lds + (bf) * SHM_K + kws + j_ * 4096) = kst[j_]; } while (0)
#define D_VLOAD(V0p, V1p, k0) do { unsigned vo_ = (unsigned)(sr * D + sc) * 2u; asm volatile("" : "+v"(vo_));   \
        _Pragma("unroll") for (int j_ = 0; j_ < 4; ++j_) { vs[j_] = load8((const bf16*)((const char*)((V0p) + (size_t)((k0) + 16 * j_) * D) + vo_)); vs[4 + j_] = load8((const bf16*)((const char*)((V1p) + (size_t)((k0) + 16 * j_) * D) + vo_)); } } while (0)
#define D_VWRITE(sl_) do { int sr_ = sr; asm volatile("" : "+v"(sr_)); _Pragma("unroll") for (int j_ = 0; j_ < 4; ++j_) { const int vs_ = v_st(sr_ + 16 * j_, sc); *(bf16x8*)(V_lds + (sl_) * SHM_V + vs_) = vs[j_]; *(bf16x8*)(V1_lds + (sl_) * SHM_V + vs_) = vs[4 + j_]; } } while (0)
#define D_PEXPORT(pb_) do { bf16x8* pp_ = (bf16x8*)(P_lds + (pb_) * 16384) + lane; pp_[0] = pa0; pp_[64] = pa1; pp_[128] = pa2; pp_[192] = pa3; } while (0)
#define D_PIMPORT(pb_) do { const bf16x8* pp_ = (const bf16x8*)(P_lds + (pb_) * 16384) + lane; pa0 = pp_[0]; pa1 = pp_[64]; pa2 = pp_[128]; pa3 = pp_[192]; } while (0)
#define D_AEXPORT(par, a) do { if (hi == 0) al_l[(par) * 32 + r32] = (a); } while (0)
#define D_RESC(par) do { const float* ap_ = al_l + (par) * 32; const float a_ = ap_[r32]; if (__any(a_ < 1.f)) { _Pragma("unroll") for (int d_ = 0; d_ < 4; ++d_) _Pragma("unroll") for (int r = 0; r < 16; ++r) { const float f_ = ap_[crow(r, hi)]; o0[d_][r] *= f_; o1[d_][r] *= f_; } } } while (0)
#define D_OSTORE(Op, oo) do { int rq_ = r32, hq_ = hi; asm volatile("" : "+v"(rq_), "+v"(hq_));   bf16* Ow = (Op) + (size_t)((wid & 3) * QBLK) * D + rq_; \
        _Pragma("unroll") for (int r = 0; r < 16; ++r) { const int orow = crow(r, hq_); \
            const float rl_ = __builtin_amdgcn_rcpf(li_l[orow]); \
            _Pragma("unroll") for (int d0 = 0; d0 < 4; ++d0) { const float v = oo[d0][r] * rl_; const float vn = __shfl_xor(v, 1); \
                if ((r32 & 1) == 0) *(unsigned*)(Ow + (size_t)orow * D + d0 * 32) = cvtpk(v, vn); } } } while (0)
__device__ __forceinline__ void pv_both(f32x16* o0, f32x16* o1, int vb0s, int vb1s, bf16x8 pa0, bf16x8 pa1, bf16x8 pa2, bf16x8 pa3) {
#define TRRD(dst, base, off) asm volatile("ds_read_b64_tr_b16 %0, %1 offset:%2" : "=&v"(dst) : "v"(base), "i"(off) : "memory")
#define TR8(P, base, d0) do { constexpr int b_ = v_rd_off(d0, 0, 0); TRRD(P##l0, base, b_); TRRD(P##h0, base, b_ + 2048); TRRD(P##l1, base, b_ + 4096); TRRD(P##h1, base, b_ + 6144); \
        TRRD(P##l2, base, b_ + 8192); TRRD(P##h2, base, b_ + 10240); TRRD(P##l3, base, b_ + 12288); TRRD(P##h3, base, b_ + 14336); } while (0)
#define MM4(P, acc) do { \
        acc = __builtin_amdgcn_mfma_f32_32x32x16_bf16(pa0, (bf16x8){P##l0[0], P##l0[1], P##l0[2], P##l0[3], P##h0[0], P##h0[1], P##h0[2], P##h0[3]}, acc, 0, 0, 0); \
        acc = __builtin_amdgcn_mfma_f32_32x32x16_bf16(pa1, (bf16x8){P##l1[0], P##l1[1], P##l1[2], P##l1[3], P##h1[0], P##h1[1], P##h1[2], P##h1[3]}, acc, 0, 0, 0); \
        acc = __builtin_amdgcn_mfma_f32_32x32x16_bf16(pa2, (bf16x8){P##l2[0], P##l2[1], P##l2[2], P##l2[3], P##h2[0], P##h2[1], P##h2[2], P##h2[3]}, acc, 0, 0, 0); \
        acc = __builtin_amdgcn_mfma_f32_32x32x16_bf16(pa3, (bf16x8){P##l3[0], P##l3[1], P##l3[2], P##l3[3], P##h3[0], P##h3[1], P##h3[2], P##h3[3]}, acc, 0, 0, 0); } while (0)
#define WAIT8() do { asm volatile("s_waitcnt lgkmcnt(8)" ::: "memory"); SBAR(); } while (0)
#define WAIT0() do { asm volatile("s_waitcnt lgkmcnt(0)" ::: "memory"); SBAR(); } while (0)
    s16x4 Al0, Al1, Al2, Al3, Ah0, Ah1, Ah2, Ah3, Bl0, Bl1, Bl2, Bl3, Bh0, Bh1, Bh2, Bh3;
    TR8(A, vb0s, 0);
    TR8(B, vb1s, 0); WAIT8(); MM4(A, o0[0]);
    TR8(A, vb0s, 1); WAIT8(); MM4(B, o1[0]);
    TR8(B, vb1s, 1); WAIT8(); MM4(A, o0[1]);
    TR8(A, vb0s, 2); WAIT8(); MM4(B, o1[1]);
    TR8(B, vb1s, 2); WAIT8(); MM4(A, o0[2]);
    TR8(A, vb0s, 3); WAIT8(); MM4(B, o1[2]);
    TR8(B, vb1s, 3); WAIT8(); MM4(A, o0[3]);
    WAIT0(); MM4(B, o1[3]);
#undef TRRD
#undef TR8
#undef MM4
#undef WAIT8
#undef WAIT0
}
__device__ __forceinline__ void pv_one(f32x16* o, int vbs, bf16x8 pa0, bf16x8 pa1, bf16x8 pa2, bf16x8 pa3) {
#define TRRD(dst, base, off) asm volatile("ds_read_b64_tr_b16 %0, %1 offset:%2" : "=&v"(dst) : "v"(base), "i"(off) : "memory")
#define TR8(P, base, d0) do { constexpr int b_ = v_rd_off(d0, 0, 0); TRRD(P##l0, base, b_); TRRD(P##h0, base, b_ + 2048); TRRD(P##l1, base, b_ + 4096); TRRD(P##h1, base, b_ + 6144); \
        TRRD(P##l2, base, b_ + 8192); TRRD(P##h2, base, b_ + 10240); TRRD(P##l3, base, b_ + 12288); TRRD(P##h3, base, b_ + 14336); } while (0)
#define MM4(P, acc) do { \
        acc = __builtin_amdgcn_mfma_f32_32x32x16_bf16(pa0, (bf16x8){P##l0[0], P##l0[1], P##l0[2], P##l0[3], P##h0[0], P##h0[1], P##h0[2], P##h0[3]}, acc, 0, 0, 0); \
        acc = __builtin_amdgcn_mfma_f32_32x32x16_bf16(pa1, (bf16x8){P##l1[0], P##l1[1], P##l1[2], P##l1[3], P##h1[0], P##h1[1], P##h1[2], P##h1[3]}, acc, 0, 0, 0); \
        acc = __builtin_amdgcn_mfma_f32_32x32x16_bf16(pa2, (bf16x8){P##l2[0], P##l2[1], P##l2[2], P##l2[3], P##h2[0], P##h2[1], P##h2[2], P##h2[3]}, acc, 0, 0, 0); \
        acc = __builtin_amdgcn_mfma_f32_32x32x16_bf16(pa3, (bf16x8){P##l3[0], P##l3[1], P##l3[2], P##l3[3], P##h3[0], P##h3[1], P##h3[2], P##h3[3]}, acc, 0, 0, 0); } while (0)
    s16x4 Al0, Al1, Al2, Al3, Ah0, Ah1, Ah2, Ah3, Bl0, Bl1, Bl2, Bl3, Bh0, Bh1, Bh2, Bh3;
    TR8(A, vbs, 0);
    TR8(B, vbs, 1); asm volatile("s_waitcnt lgkmcnt(8)" ::: "memory"); SBAR(); MM4(A, o[0]);
    TR8(A, vbs, 2); asm volatile("s_waitcnt lgkmcnt(8)" ::: "memory"); SBAR(); MM4(B, o[1]);
    TR8(B, vbs, 3); asm volatile("s_waitcnt lgkmcnt(8)" ::: "memory"); SBAR(); MM4(A, o[2]);
    asm volatile("s_waitcnt lgkmcnt(0)" ::: "memory"); SBAR(); MM4(B, o[3]);
#undef TRRD
#undef TR8
#undef MM4
}
struct DQueue { unsigned* ctr; volatile LAS unsigned* slot; const bf16* QKV; bf16* OD; int xcd; unsigned long long* stp; int half; };
constexpr int DS_ = 8192, DNITEM = 512;
__device__ __forceinline__ int dfetch(const DQueue& q, int& par, int tid) {
    if (tid == 0) { unsigned it_ = (unsigned)DNITEM;
        for (int k_ = 0; k_ < 8; ++k_) { const unsigned x_ = (unsigned)(q.xcd + k_) & 7u; const unsigned v_ = __hip_atomic_fetch_add(q.ctr + 64 * x_, 1u, __ATOMIC_RELAXED, __HIP_MEMORY_SCOPE_AGENT); if (v_ < 32u) { it_ = ((unsigned)q.half * 32u + v_) * 8u + x_; break; } }
        q.slot[par] = it_; }
    __syncthreads(); const int v = __builtin_amdgcn_readfirstlane((int)q.slot[par]); par ^= 1; return v;
}
__device__ __forceinline__ DRef dref_of(const DQueue& q, int item) {
    DRef r; const int m = item & 7, qb = 63 - (item >> 3);
    r.Q = q.QKV + (size_t)m * QUS + (size_t)(qb * 128) * 128; r.K = q.QKV + (size_t)(8 + m) * QUS;
    r.V0 = q.QKV + (size_t)(16 + (m >> 1) * 2) * QUS; r.V1 = r.V0 + QUS;
    r.O0 = q.OD + ((size_t)(2 * m) * DS_ + qb * 128) * 128; r.O1 = q.OD + ((size_t)(2 * m + 1) * DS_ + qb * 128) * 128; r.P0 = qb * 128; return r;
}
#define KBASE(t) ((t) * KVBLK)
__device__ __forceinline__ void dattn_S(char* lds, const DQueue& Q_) {
    int tid = threadIdx.x; asm volatile("" : "+v"(tid)); const int wid = __builtin_amdgcn_readfirstlane(tid >> 6), lane = tid & 63, r32 = lane & 31, hi = lane >> 5;
    const int t8 = tid & 255, sr = t8 >> 4, sc = (t8 & 15) * 8, kws = KSWZ(sr, sc * 2);
    char* K_lds = lds + DK_OFF; char* P_lds = lds + DP_OFF + (wid & 3) * 4096;
    float* ws = (float*)(lds + DWS_OFF) + (wid & 3) * 128; float* li_l = ws, * al_l = ws + 32;
    int par = 0; int item = dfetch(Q_, par, tid); if (item >= DNITEM) return;
    DRef cur = dref_of(Q_, item);
    bf16x8 qr[8], kst[4], pa0, pa1, pa2, pa3;
#pragma unroll
    for (int d0 = 0; d0 < 8; ++d0) qr[d0] = load8(cur.Q + (size_t)(wid * QBLK + r32) * D + d0 * 16 + hi * 8);
    D_KLOAD(cur.K, 0); VMW(); D_KWRITE(0); D_KLOAD(cur.K, KBASE(1));
    __syncthreads();
    for (;;) {
        bool more = false; DRef nxt = cur;
#define LATE_FETCH() do { const int nitem_ = dfetch(Q_, par, tid); more = nitem_ < DNITEM; if (more) nxt = dref_of(Q_, nitem_); } while (0)
        const int NT = (cur.P0 + 128) / KVBLK;
        const int qlo = cur.P0 + wid * QBLK, qm = qlo + r32 - 4 * hi;
        float m_reg = -1e30f, l_reg = 0; const bf16* Kh = cur.K;
        f32x16 pA0, pA1, pB0, pB1; float mnA, mnB, alA = 1.f, alB = 1.f;
#define MASKT(P0_, P1_, t) do { const int kb_ = KBASE(t); if (kb_ + KVBLK - 1 > qlo) mask_tile(P0_, P1_, qm - kb_); } while (0)
#define SSTEP(PX0, PX1, mnX, alX, PY0, PY1, mnY, alY, t, KB, FS) do {                                                              \
        VMW(); D_KWRITE((KB) ^ 1); SBAR();                                       \
        if ((t) + 2 < NT) { D_KLOAD(Kh, KBASE((t) + 2)); } else if ((t) + 2 == NT) { D_KLOAD(nxt.K, 0); }                     \
        SBAR(); qkt0<KB>(PX0, PX1, K_lds, r32, hi, qr);                                                                       \
        if (FS) { MASKT(PY0, PY1, (t) - 1); partialSM(PY0, PY1, m_reg, mnY, alY);          \
                  finishSM(PY0, PY1, alY, l_reg, pa0, pa1, pa2, pa3); D_PEXPORT((KB) ^ 1); D_AEXPORT((KB) ^ 1, alY); } SBAR(); \
        __syncthreads();                                                                                             \
        } while (0)
        if (NT == 2) LATE_FETCH();
        SSTEP(pA0, pA1, mnA, alA, pB0, pB1, mnB, alB, 0, 0, false);
        for (int t = 1; t < NT; t += 2) {
            SSTEP(pB0, pB1, mnB, alB, pA0, pA1, mnA, alA, t, 1, true);
            if (t + 1 < NT) { if (t + 1 == NT - 2) LATE_FETCH(); SSTEP(pA0, pA1, mnA, alA, pB0, pB1, mnB, alB, t + 1, 0, true); }
        }
        MASKT(pB0, pB1, NT - 1); partialSM(pB0, pB1, m_reg, mnB, alB);
        finishSM(pB0, pB1, alB, l_reg, pa0, pa1, pa2, pa3); D_PEXPORT(1); D_AEXPORT(1, alB); if (hi == 0) li_l[r32] = l_reg;
#pragma unroll
        for (int d0 = 0; d0 < 8; ++d0) qr[d0] = load8(nxt.Q + (size_t)(wid * QBLK + r32) * D + d0 * 16 + hi * 8);
        __syncthreads();
        D_KLOAD(nxt.K, KBASE(1));
        __syncthreads();
#undef MASKT
#undef SSTEP
#undef LATE_FETCH
        if (PROBE_SEL >= 0 && tid == 0) { if (Q_.stp[24] == 0ull) { Q_.stp[24] = __builtin_amdgcn_s_memrealtime(); Q_.stp[25] = (unsigned long long)(NT + 2); } else if (Q_.stp[26] == 0ull) { Q_.stp[26] = __builtin_amdgcn_s_memrealtime(); Q_.stp[27] = (unsigned long long)(NT + 2); } }
        if (!more) break;
        cur = nxt;
    }
    VMW();
}
__device__ __forceinline__ void dattn_V(char* lds, const DQueue& Q_) {
    int tid = threadIdx.x; asm volatile("" : "+v"(tid)); const int wid = __builtin_amdgcn_readfirstlane(tid >> 6), lane = tid & 63, r32 = lane & 31, hi = lane >> 5;
    const int t8 = tid & 255, sr = t8 >> 4, sc = (t8 & 15) * 8;
    char* V_lds = lds; char* V1_lds = lds + DV1_OFF; char* P_lds = lds + DP_OFF + (wid & 3) * 4096;
    float* ws = (float*)(lds + DWS_OFF) + (wid & 3) * 128; float* li_l = ws, * al_l = ws + 32;
    const int vb0 = (int)(uintptr_t)V_lds + v_rd_base(lane), vb1 = (int)(uintptr_t)V1_lds + v_rd_base(lane);
    int par = 0; int item = dfetch(Q_, par, tid); if (item >= DNITEM) return;
    DRef cur = dref_of(Q_, item);
    bf16x8 vs[8], pa0, pa1, pa2, pa3;
    __syncthreads();
    for (;;) {
        bool more = false; DRef nxt = cur;
        const int NT = (cur.P0 + 128) / KVBLK;
        f32x16 o0[4] = {}, o1[4] = {};
        int t = 0;
        do {
            if (t == NT - 2) { const int nitem_ = dfetch(Q_, par, tid); more = nitem_ < DNITEM; if (more) nxt = dref_of(Q_, nitem_); }
            if (t >= 1 && t <= NT) { VMW(); D_VWRITE((t - 1) & 1); }
            if (t < NT) D_VLOAD(cur.V0, cur.V1, KBASE(t));
            if (t >= 2) { const int pb = t & 1; D_RESC(pb); D_PIMPORT(pb); asm volatile("s_waitcnt lgkmcnt(0)" ::: "memory");
                pv_both(o0, o1, vb0 + pb * SHM_V, vb1 + pb * SHM_V, pa0, pa1, pa2, pa3); }
            if (t == NT + 1) { D_OSTORE(cur.O0, o0); D_OSTORE(cur.O1, o1); }
            __syncthreads();
        } while (++t < NT + 2);
        if (!more) break;
        cur = nxt;
    }
}
#undef KBASE
#undef D_KLOAD
#undef D_KWRITE
#undef D_VLOAD
#undef D_VWRITE
#undef D_PEXPORT
#undef D_PIMPORT
#undef D_AEXPORT
#undef D_RESC
#undef D_OSTORE
#undef ROW
#undef VMW
#undef VMWN
#undef SLOAD_H
#undef BLOAD
#undef SWRITE_HK
#undef SWRITE_HV
#undef SWRITE_H
#undef KSWZ
#undef SBAR
}

constexpr size_t MiB = 1u << 20, KiB = 1u << 10;
constexpr size_t WS_CTL = 0, CTL_ZERO_BYTES = 1 * MiB;
constexpr size_t WS_FLOG = 1 * MiB, WS_FBIAS = WS_FLOG + 256 * KiB, WS_ZEROB = WS_FBIAS + 256 * KiB, WS_WRT = WS_ZEROB + 64 * KiB;
constexpr size_t WS_NP = 1920 * KiB;
constexpr size_t WS_TOKINFO = 2 * MiB, WS_LIST = 3 * MiB;
constexpr size_t WS_ROPE = 4 * MiB;
constexpr size_t WS_WPC = 8 * MiB, WS_WOUT = 16 * MiB, WS_WIN = 24 * MiB, WS_WGU = 64 * MiB, WS_WD = 192 * MiB;
constexpr size_t WS_QKV = 256 * MiB, WS_G = 356 * MiB, WS_XB = 420 * MiB, WS_OD = 24 * MiB, WS_ACAT = 452 * MiB;
constexpr size_t WS_LOCAL = 56 * MiB, WS_CNTT = 58 * MiB;
constexpr size_t WS_MB = 256 * MiB, WS_Z = 288 * MiB, WS_X1B = 352 * MiB, WS_H = 384 * MiB, WS_Y = 408 * MiB, WS_END = 504 * MiB;
constexpr int CW_TMO = 0, CW_BAR = 4096, CW_ATTQ = 8192, CW_ECNT = 12288, CW_QN = 16384, CW_KN = 17408, CW_DQ = 18560, CW_TD = 20480, CW_CD = 20736, CW_BG = 21504, CW_GD = 21632, CW_AD = 21760, CW_MQ8 = 22528, CW_MQ9 = 23552;
constexpr int HROWS = 24576;

constexpr int RING_OFF = 0, RING_BYTES = 131072;
constexpr int SM_OFF = 135168;
constexpr int PFX_OFF = 137216;
constexpr int LDSCTL_OFF = 155648, MISC_OFF = LDSCTL_OFF + 320;
constexpr int LDS_BYTES = 163840;
static_assert(att::DATT_LDS_END <= LDSCTL_OFF, "attention LDS map");

#define RLX_AGENT __ATOMIC_RELAXED, __HIP_MEMORY_SCOPE_AGENT
#define LDS_WAIT() asm volatile("s_waitcnt lgkmcnt(0)" ::: "memory")
#define VM_WAIT() asm volatile("s_waitcnt vmcnt(0)" ::: "memory")

#define XB_TMO      128
#define XB_XCNT(j)  (256  + 64 * (j))
#define XB_XSUB(j)  (1280 + 64 * (j))
#define XB_XGEN(j)  (2304 + 64 * (j))
#define XB_TOP      3328
#define XB_TOPGEN   3392
#define XCD_BAR_WORDS 3456
#define XB_SPIN_CAP (1u << 18)
__device__ __forceinline__ unsigned xb_ld(unsigned* p)              { return __hip_atomic_load(p, __ATOMIC_RELAXED, __HIP_MEMORY_SCOPE_AGENT); }
__device__ __forceinline__ unsigned xb_add(unsigned* p, unsigned v) { return __hip_atomic_fetch_add(p, v, __ATOMIC_RELAXED, __HIP_MEMORY_SCOPE_AGENT); }
__device__ __forceinline__ unsigned xb_xcc_id() { return (unsigned)__builtin_amdgcn_s_getreg((3 << 11) | 20) & 0xFu; }
#define XB_SPIN(cond, bar) do { unsigned _sp = 0; while (cond) { __builtin_amdgcn_s_sleep(1); \
    if ((++_sp & 255u) == 0u) { if (xb_ld(&(bar)[XB_TMO])) break; if (_sp > XB_SPIN_CAP) { atomicAdd(&(bar)[XB_TMO], 1u); break; } } } } while (0)
struct XcdBarrier { unsigned* bar; unsigned x; volatile LAS unsigned* st; };
__device__ __forceinline__ XcdBarrier xcd_barrier_post(unsigned* bar, volatile LAS unsigned* st) {
    XcdBarrier b; b.bar = bar; b.x = xb_xcc_id(); b.st = st;
    if (threadIdx.x == 0) (void)xb_add(&bar[XB_XCNT(b.x)], 1u);
    return b;
}
__device__ __forceinline__ void xcd_barrier_complete(unsigned* bar, unsigned x, unsigned& nloc, unsigned& nx) {
    const unsigned G = gridDim.x * gridDim.y * gridDim.z;
    unsigned sum, cnt, mine, sp = 0u;
    for (;;) {
        sum = 0u; cnt = 0u; mine = 0u;
#pragma unroll
        for (unsigned j = 0; j < 16; ++j) { const unsigned c = xb_ld(&bar[XB_XCNT(j)]); sum += c; cnt += (c > 0u) ? 1u : 0u; mine = (j == x) ? c : mine; }
        if (sum == G) break;
        __builtin_amdgcn_s_sleep(1);
        if ((++sp & 255u) == 0u) { if (xb_ld(&bar[XB_TMO])) break; if (sp > XB_SPIN_CAP) { atomicAdd(&bar[XB_TMO], 1u); break; } }
    }
    nloc = mine > 0u ? mine : 1u; nx = cnt > 0u ? cnt : 1u;
}
__device__ __forceinline__ void xcd_barrier(const XcdBarrier& b) {
    asm volatile("s_waitcnt vmcnt(0)" ::: "memory");
    __syncthreads();
    if (threadIdx.x == 0) {
        unsigned* bar = b.bar;
        __builtin_amdgcn_s_waitcnt(0);
        unsigned nloc = b.st[0], nx = b.st[1];
        if (nloc == 0u) { xcd_barrier_complete(bar, b.x, nloc, nx); b.st[0] = nloc; b.st[1] = nx; }
        const unsigned old = xb_add(&bar[XB_XSUB(b.x)], 1u);
        const unsigned gen = old / nloc;
        if (old + 1u == (gen + 1u) * nloc) {
            __builtin_amdgcn_fence(__ATOMIC_RELEASE, "agent");
            asm volatile("s_waitcnt vmcnt(0)" ::: "memory");
            const unsigned og = xb_add(&bar[XB_TOP], 1u);
            const unsigned tg = og / nx;
            if (og + 1u == (tg + 1u) * nx) xb_add(&bar[XB_TOPGEN], 1u);
            else XB_SPIN(xb_ld(&bar[XB_TOPGEN]) == tg, bar);
            __builtin_amdgcn_fence(__ATOMIC_ACQUIRE, "agent");
            xb_add(&bar[XB_XGEN(b.x)], 1u);
            asm volatile("s_waitcnt vmcnt(0)" ::: "memory");
        } else {
            XB_SPIN(xb_ld(&bar[XB_XGEN(b.x)]) == gen, bar);
            __builtin_amdgcn_fence(__ATOMIC_ACQUIRE, "agent");
            asm volatile("s_waitcnt vmcnt(0)" ::: "memory");
        }
    }
    __syncthreads();
}

constexpr int NWAVES = 8, NPHASE = 11;
struct Args { const float* in[22]; float* out; unsigned char* ws; int ph_lo, ph_hi; };
struct Frame {
    LAS unsigned char* lds; volatile LAS unsigned* MISC; unsigned* ctl;
    int tid, lane, wave, vcu, G;
};

template <class RM, bool WTHROUGH = false>
__device__ __forceinline__ void tr_item(const float* W, int N, int k0, int nsrc0, bf16_t* WT, int ldw, int kdst, const RM& rowmap, LAS float* scr, int lane) {
    const int lr = lane >> 4, lc = (lane & 15) * 4;
#pragma unroll 4
    for (int i = 0; i < 16; ++i) { const int kk = 4 * i + lr; const f32x4 v = *(const f32x4*)(W + (size_t)(k0 + kk) * N + nsrc0 + lc);
        scr[kk * 65 + lc] = v[0]; scr[kk * 65 + lc + 1] = v[1]; scr[kk * 65 + lc + 2] = v[2]; scr[kk * 65 + lc + 3] = v[3]; }
    LDS_WAIT(); asm volatile("" ::: "memory");
    const int c = lane & 7;
#pragma unroll
    for (int j = 0; j < 8; ++j) { const int n = (lane >> 3) + 8 * j; const LAS float* s = scr + (8 * c) * 65 + n;
        u32x4 o; o.x = cvt_pk_bf16(s[0 * 65], s[1 * 65]); o.y = cvt_pk_bf16(s[2 * 65], s[3 * 65]); o.z = cvt_pk_bf16(s[4 * 65], s[5 * 65]); o.w = cvt_pk_bf16(s[6 * 65], s[7 * 65]);
        if (WTHROUGH) pg8::store16_wt(WT + (size_t)rowmap(nsrc0 + n) * ldw + kdst + k0 + 8 * c, o); else *(u32x4*)(WT + (size_t)rowmap(nsrc0 + n) * ldw + kdst + k0 + 8 * c) = o; }
    LDS_WAIT(); asm volatile("" ::: "memory");
}
struct RmId { __device__ __forceinline__ int operator()(int c) const { return c; } };
struct RmIn { __device__ __forceinline__ int operator()(int c) const {
        if (c < 2048) { const int jj = c & 127, j6 = jj & 63; return (c & ~127) + 8 * (j6 >> 2) + (jj >= 64 ? 4 : 0) + (j6 & 3); }
        return c < 6144 ? c : c - 8; } };
struct RmGate { int up; __device__ __forceinline__ int operator()(int c) const { return 256 * (c >> 7) + 128 * up + (c & 127); } };

__device__ __forceinline__ att::BlockRef mk_ref(int item, int jlo, const bf16_t* QKV, bf16_t* OD, bf16_t* ACAT, const float* FBIAS, const float* ZEROB) {
    att::BlockRef r; const int qb = 31 - item / 24, u = item % 24; int hq, hk, hv;
    if (u < 16) { const int m = u >> 1, c = u & 1; hq = m; hk = 8 + m; hv = 16 + (m >> 1) * 2 + c; r.B = ZEROB; r.O = (att::bf16*)OD + ((size_t)u * S + qb * 256) * 128; r.ostride = 128; }
    else { const int h = u - 16; hq = 24 + h; hk = 32 + h; hv = 40 + h; r.B = FBIAS + (size_t)h * S; r.O = (att::bf16*)ACAT + (size_t)(qb * 256) * DM + 1024 + h * 128; r.ostride = DM; }
    r.Q = (const att::bf16*)QKV + (size_t)hq * QUS + (size_t)(qb * 256) * 128; r.K = (const att::bf16*)QKV + (size_t)hk * QUS + (size_t)(jlo * 64) * 128; r.V = (const att::bf16*)QKV + (size_t)hv * QUS + (size_t)(jlo * 64) * 128; r.B += jlo * 64; r.P0 = qb * 256; r.jlo = jlo; return r;
}
__global__ void __launch_bounds__(NWAVES * 64, 2) mk_fwd(Args args) {
    extern __shared__ __attribute__((aligned(16))) unsigned char lds[];
    Frame F;
    F.lds = (LAS unsigned char*)lds;
    F.MISC = (volatile LAS unsigned*)(F.lds + MISC_OFF);
    F.tid = threadIdx.x; F.lane = F.tid & 63; F.wave = __builtin_amdgcn_readfirstlane(F.tid >> 6);
    F.G = gridDim.x; { const int bx = blockIdx.x; F.vcu = (F.G % 8 == 0) ? (bx % 8) * (F.G / 8) + bx / 8 : bx; }
    unsigned char* ws = args.ws;
    F.ctl = (unsigned*)(ws + WS_CTL);
    const float* x = args.in[0]; const float* w_in = args.in[1]; const float* b_forget = args.in[2];
    const float* lq1 = args.in[3]; const float* lk1 = args.in[4]; const float* lq2 = args.in[5]; const float* lk2 = args.in[6];
    const float* dng = args.in[7]; const float* wpd = args.in[8]; const float* wpf = args.in[9]; const float* wout = args.in[10];
    const float* ln1g = args.in[11]; const float* ln1b = args.in[12]; const float* wrg = args.in[13]; const float* brg = args.in[14];
    const float* wre = args.in[15]; const float* bre = args.in[16]; const float* wgate = args.in[17]; const float* wup = args.in[18];
    const float* wdown = args.in[19]; const float* ln2g = args.in[20]; const float* ln2b = args.in[21];
    float* FLOG = (float*)(ws + WS_FLOG); float* FBIAS = (float*)(ws + WS_FBIAS); float* ZEROB = (float*)(ws + WS_ZEROB); float* WRT = (float*)(ws + WS_WRT);
    float* NPB = (float*)(ws + WS_NP);
    int* TOKINFO = (int*)(ws + WS_TOKINFO); int* LIST = (int*)(ws + WS_LIST); float* ROPE = (float*)(ws + WS_ROPE);
    bf16_t* WPC = (bf16_t*)(ws + WS_WPC); bf16_t* WOUT = (bf16_t*)(ws + WS_WOUT); bf16_t* WIN = (bf16_t*)(ws + WS_WIN); bf16_t* WGU = (bf16_t*)(ws + WS_WGU); bf16_t* WD = (bf16_t*)(ws + WS_WD);
    bf16_t* QKV = (bf16_t*)(ws + WS_QKV); bf16_t* GB = (bf16_t*)(ws + WS_G); bf16_t* XB = (bf16_t*)(ws + WS_XB); bf16_t* OD = (bf16_t*)(ws + WS_OD); bf16_t* ACAT = (bf16_t*)(ws + WS_ACAT);
    bf16_t* MB = (bf16_t*)(ws + WS_MB); float* Z = (float*)(ws + WS_Z); bf16_t* X1B = (bf16_t*)(ws + WS_X1B); bf16_t* HB = (bf16_t*)(ws + WS_H); bf16_t* YB = (bf16_t*)(ws + WS_Y);

    for (int u = F.tid; u < (LDS_BYTES - LDSCTL_OFF) / 4; u += NWAVES * 64) ((LAS unsigned*)(F.lds + LDSCTL_OFF))[u] = 0u;
    __syncthreads();
    XcdBarrier bar; bar.bar = F.ctl + CW_BAR; bar.x = 0; bar.st = nullptr;
    if (MK_N_LAUNCHES == 1) bar = xcd_barrier_post(F.ctl + CW_BAR, F.MISC + 8);
    const int lo = args.ph_lo, hi = args.ph_hi; constexpr int rep = 0;
#define FRESH() do { int t_ = threadIdx.x; asm volatile("" : "+v"(t_)); F.tid = t_; F.lane = t_ & 63; F.wave = __builtin_amdgcn_readfirstlane(t_ >> 6); } while (0)
#define IN(k) ((((PH_MASK) >> (k)) & 1) && lo <= (k) && (k) < hi)
#if PROBE_SEL >= 0
    unsigned long long* stamps = (unsigned long long*)(ws + WS_CTL + 512 * KiB) + (size_t)blockIdx.x * 32;
#define STAMP(i) do { if (threadIdx.x == 0) stamps[i] = __builtin_amdgcn_s_memrealtime(); } while (0)
#else
#define STAMP(i) do { } while (0)
#endif
#define SEAM(k) do { STAMP(2 * (k) + 1); if (IN(k) && IN((k) + 1)) xcd_barrier(bar); STAMP(2 * (k) + 2); } while (0)
#define gw (F.vcu * NWAVES + F.wave)
#define BG_BATCH(b_) do { const int r_ = (int)(b_) * 8 + F.wave, e_ = r_ >> 9, up_ = (r_ >> 8) & 1, q_ = r_ & 255;                                               \
        tr_item<RmGate, true>((up_ ? wup : wgate) + (size_t)e_ * DM * FF, FF, 64 * (q_ >> 3), 64 * (q_ & 7), WGU + (size_t)e_ * 1024 * DM, DM, 0, RmGate{up_}, (LAS float*)(F.lds + F.wave * 16640), F.lane); \
        VM_WAIT(); __syncthreads();                                                                                                                                  \
        if (F.tid == 0) (void)__hip_atomic_fetch_add(F.ctl + CW_GD + e_, 1u, RLX_AGENT); } while (0)
    const int NGW = F.G * NWAVES;
    LAS int* sm_rowidx = (LAS int*)(F.lds + SM_OFF); LAS int* sm_pre = sm_rowidx + 256; LAS int* sm_cnt = sm_pre + 40;

    STAMP(0);
    if (IN(0)) {
        FRESH();
        LAS float* scr = (LAS float*)(F.lds + F.wave * 16640);
        constexpr int I_IN = 32 * 160, I_P = 16 * 32, I_O = 32 * 32, I_E = 32 * 256, NITEMS = I_IN + 2 * I_P + I_O;
        for (int it = gw; it < NITEMS; it += NGW) {
            int r = it;
            if (r < I_IN) { const int kb = r / 160, nb = r % 160; tr_item(w_in, INC, 64 * kb, 64 * nb + (nb >= 96 ? 8 : 0), WIN, DM, 0, RmIn{}, scr, F.lane); continue; } r -= I_IN;
            if (r < I_P) { tr_item(wpd, DM, 64 * (r / 32), 64 * (r % 32), WPC, DM, 0, RmId{}, scr, F.lane); continue; } r -= I_P;
            if (r < I_P) { tr_item(wpf, DM, 64 * (r / 32), 64 * (r % 32), WPC, DM, 1024, RmId{}, scr, F.lane); continue; } r -= I_P;
            if (r < I_O) { tr_item(wout, DM, 64 * (r / 32), 64 * (r % 32), WOUT, DM, 0, RmId{}, scr, F.lane); continue; } r -= I_O;
        }
        const int gt = F.vcu * (NWAVES * 64) + F.tid, NGT = F.G * NWAVES * 64;
        for (int i = gt; i < S * 64; i += NGT) { const int pos = i >> 6, j = i & 63; const double ang = (double)pos * pow(10000.0, -(double)j / 64.0);
            ROPE[(size_t)pos * 128 + j] = (float)cos(ang); ROPE[(size_t)pos * 128 + 64 + j] = (float)sin(ang); }
        for (int i = gt; i < 36 * DM; i += NGT) { const int c = i / DM, k = i % DM; WRT[i] = c < 4 ? wrg[k * 4 + c] : wre[((size_t)((c - 4) >> 3) * DM + k) * 8 + ((c - 4) & 7)]; }
        for (int i = gt; i < S; i += NGT) ZEROB[i] = 0.f;
        __syncthreads();
        { LAS float* Wf = (LAS float*)F.lds;
          for (int i = F.tid; i < DM * 2; i += NWAVES * 64) { const int k = i >> 1, h4 = (i & 1) * 4; const f32x4 v = *(const f32x4*)(w_in + (size_t)k * INC + 6144 + h4);
              Wf[(h4 + 0) * DM + k] = v[0]; Wf[(h4 + 1) * DM + k] = v[1]; Wf[(h4 + 2) * DM + k] = v[2]; Wf[(h4 + 3) * DM + k] = v[3]; }
          __syncthreads();
          for (int m = gw; m < S; m += NGW) {
              const f32x4* xr = (const f32x4*)(x + (size_t)m * DM) + F.lane; f32x4 v[8];
#pragma unroll
              for (int j = 0; j < 8; ++j) v[j] = xr[64 * j];
              u32x2* o8 = (u32x2*)(XB + (size_t)m * DM) + F.lane;
#pragma unroll
              for (int j = 0; j < 8; ++j) { u32x2 w; w.x = cvt_pk_bf16(v[j][0], v[j][1]); w.y = cvt_pk_bf16(v[j][2], v[j][3]); o8[64 * j] = w; }
              float fl[8];
#pragma unroll
              for (int c = 0; c < 8; ++c) { float a = 0.f;
#pragma unroll
                  for (int j = 0; j < 8; ++j) { const f32x4 w = *(const LAS f32x4*)(Wf + c * DM + 256 * j + 4 * F.lane); a = fmaf(v[j][0], w[0], fmaf(v[j][1], w[1], fmaf(v[j][2], w[2], fmaf(v[j][3], w[3], a)))); }
                  asm volatile("" ::: "memory");
                  fl[c] = wave_sum(a); asm volatile("" : "+v"(fl[c])); }
              if (F.lane == 0) { *(f32x4*)(FLOG + (size_t)m * 8) = (f32x4){fl[0], fl[1], fl[2], fl[3]}; *(f32x4*)(FLOG + (size_t)m * 8 + 4) = (f32x4){fl[4], fl[5], fl[6], fl[7]}; }
          }
          __syncthreads();
        }
    }
    SEAM(0);

    if (IN(1)) {
        FRESH();
        if (F.vcu < 8) {
            const int h = F.vcu; LAS double* part = (LAS double*)F.lds; const double b = (double)b_forget[h];
            double ls[16]; double run = 0.0;
#pragma unroll
            for (int i = 0; i < 16; ++i) { const double z = (double)FLOG[(size_t)(F.tid * 16 + i) * 8 + h] + b; run += (z < 0.0 ? z : 0.0) - log1p(exp(-fabs(z))); ls[i] = run; }
            part[F.tid] = run; __syncthreads();
            if (F.tid == 0) { double a = 0.0; for (int i = 0; i < NWAVES * 64; ++i) { const double t = part[i]; part[i] = a; a += t; } }
            __syncthreads();
            const double off = part[F.tid];
#pragma unroll
            for (int i = 0; i < 16; ++i) FBIAS[(size_t)h * S + F.tid * 16 + i] = (float)(-(off + ls[i]) * (double)INV_SCALE);
            __syncthreads();
        }
        pg8::Gemm g{XB, WIN, DM, DM, DM, nullptr}; pg8::StaticOrder So; So.init(S, NIN, F.G, (int)blockIdx.x);
        pg8::EpiInProj E{QKV, GB, ROPE, NPB};
        pg8::gemm_phase<pg8::EpiInProj, pg8::StaticOrder, false>(F.lds + RING_OFF, g, So, E);
    }
    SEAM(1);

    if (IN(2)) {
        FRESH();
        constexpr int NITEM = 24 * 32;
#pragma nounroll
        for (int pass = 0; pass < 2; ++pass) {
        { att::DQueue dq{F.ctl + CW_ATTQ + 64 * (8 + 8 * pass), F.MISC + 22, (const att::bf16*)QKV, (att::bf16*)OD, (int)bar.x, PROBE_SEL >= 0 ? (unsigned long long*)(ws + WS_CTL + 512 * KiB) + (size_t)blockIdx.x * 32 : nullptr, pass};
          if (F.wave < 4) att::dattn_S((char*)lds, dq); else att::dattn_V((char*)lds, dq);
          VM_WAIT(); __syncthreads();
        }
        if (pass == 0) {
        STAMP(22);
        #define ref(item, jl) mk_ref((item), (jl), QKV, OD, ACAT, FBIAS, ZEROB)
        int slot = 0;
#define FETCH(dst, dstj) do { if (F.wave == 0) { unsigned v_ = 0; if (F.lane == 0) { const unsigned i_ = __hip_atomic_fetch_add(F.ctl + CW_ATTQ + 64 * rep, 1u, RLX_AGENT); v_ = i_ < 256u ? (i_ & 31u) * 24u + 16u + F.MISC[24 + ((i_ >> 5) & 7u)] : (unsigned)NITEM; } const int it_ = (int)__builtin_amdgcn_readfirstlane(v_); int jl_ = 0; \
        if (it_ < NITEM && (it_ % 24) >= 16) { const int h_ = it_ % 24 - 16, qb_ = 31 - it_ / 24, nt_ = 4 * qb_ + 4; const float* Bh_ = FBIAS + (size_t)h_ * S; \
            float qn_ = 0.f, kd_ = 0.f; \
            for (int d_ = 0; d_ < 4; ++d_) { const f32x4 a_ = *(const f32x4*)(NPB + ((size_t)h_ * 128 + 4 * qb_ + d_) * 4), b_ = *(const f32x4*)(NPB + ((size_t)(8 + h_) * 128 + 4 * qb_ + d_) * 4); \
                qn_ = fmaxf(qn_, (a_[0] + a_[1]) + (a_[2] + a_[3])); kd_ = fmaxf(kd_, (b_[0] + b_[1]) + (b_[2] + b_[3])); } \
            qn_ = sqrtf(qn_) * 1.005f; kd_ = sqrtf(kd_) * 1.005f; \
            const float lowm_ = -qn_ * kd_ * 1.0001f + Bh_[qb_ * 256]; int first_ = nt_; \
            for (int c_ = 0; c_ < 2; ++c_) { const int t_ = c_ * 64 + F.lane; bool keep_ = true; \
                if (t_ < nt_) { const f32x4 b_ = *(const f32x4*)(NPB + ((size_t)(8 + h_) * 128 + t_) * 4); const float kn_ = sqrtf((b_[0] + b_[1]) + (b_[2] + b_[3])) * 1.005f; keep_ = !(qn_ * kn_ * 1.0001f + Bh_[64 * t_ + 63] - lowm_ < -FOX_THR_RAW); } else keep_ = (t_ == nt_); \
                const unsigned long long bm_ = __ballot(keep_ && t_ <= nt_); if (bm_ && first_ == nt_) first_ = c_ * 64 + (int)__builtin_ctzll(bm_); } \
            jl_ = first_ & ~1; if (jl_ > nt_ - 4) jl_ = nt_ - 4; if (jl_ < 0) jl_ = 0; } \
        if (F.lane == 0) { F.MISC[16 + slot] = (unsigned)it_; F.MISC[18 + slot] = (unsigned)jl_; } } \
        __syncthreads(); dst = __builtin_amdgcn_readfirstlane((int)F.MISC[16 + slot]); dstj = __builtin_amdgcn_readfirstlane((int)F.MISC[18 + slot]); slot ^= 1; } while (0)
        if (F.tid < 8) { const float mine_ = b_forget[F.tid]; int rk_ = 0;
            for (int h2 = 0; h2 < 8; ++h2) { const float o_ = b_forget[h2]; rk_ += (o_ > mine_ || (o_ == mine_ && h2 < F.tid)) ? 1 : 0; }
            F.MISC[24 + rk_] = (unsigned)F.tid; }
        __syncthreads();
        { att::Seam Sm;
          for (;;) {
            int item, jl; FETCH(item, jl);
            if (item >= NITEM) break;
            const att::BlockRef cur = ref(item, jl);
            att::attn_prime(cur, (char*)lds, F.lds, Sm);
            att::attn_block(cur, cur, (char*)lds, F.lds, Sm);
          } }
        VM_WAIT(); __syncthreads();
#undef FETCH
#undef ref
        STAMP(24 + 4);
        }
        }
        { FRESH(); if (F.tid == 0) (void)__hip_atomic_fetch_add(F.ctl + CW_AD, 1u, RLX_AGENT); int sl = 0;
          for (;;) { if (F.tid == 0) { unsigned b = 0xFFFFFFFFu; if (__hip_atomic_load(F.ctl + CW_AD, RLX_AGENT) < (unsigned)F.G) b = __hip_atomic_fetch_add(F.ctl + CW_BG, 1u, RLX_AGENT); F.MISC[20 + sl] = b; }
              __syncthreads(); const unsigned b = F.MISC[20 + sl]; sl ^= 1; if (b >= 2048u) break; BG_BATCH(b); } }
    }
    SEAM(2);

    if (IN(3)) {
        FRESH();
        float a = lq1[F.lane] * lk1[F.lane] + lq1[F.lane + 64] * lk1[F.lane + 64], b = lq2[F.lane] * lk2[F.lane] + lq2[F.lane + 64] * lk2[F.lane + 64];
        const float lam = __expf(wave_sum(a)) - __expf(wave_sum(b)) + LAM_INIT;
        const int c = F.lane >> 5, dd = (F.lane & 31) * 4;
        for (int p0 = gw; p0 < S * 4; p0 += 4 * NGW) {
            u32x2 w1[4], w2[4];
#pragma unroll
            for (int u = 0; u < 4; ++u) { const int p = p0 + u * NGW, s = (p < S * 4 ? p : p0) >> 2, h = p & 3;
                w1[u] = *(const u32x2*)(OD + ((size_t)(4 * h + c) * S + s) * 128 + dd); w2[u] = *(const u32x2*)(OD + ((size_t)(4 * h + 2 + c) * S + s) * 128 + dd); }
#pragma unroll
            for (int u = 0; u < 4; ++u) { const int p = p0 + u * NGW, s = p >> 2, h = p & 3; if (p >= S * 4) break;
                const f32x4 o1 = {bf_lo(w1[u].x), bf_hi(w1[u].x), bf_lo(w1[u].y), bf_hi(w1[u].y)}, o2 = {bf_lo(w2[u].x), bf_hi(w2[u].x), bf_lo(w2[u].y), bf_hi(w2[u].y)};
                const f32x4 v = o1 - o2 * lam;
                const float ss = wave_sum(v[0] * v[0] + v[1] * v[1] + v[2] * v[2] + v[3] * v[3]);
                const float r = rsqrtf(ss * (1.f / 256.f) + LN_EPS) * (1.f - LAM_INIT);
                const f32x4 gg = *(const f32x4*)(dng + h * 256 + 4 * F.lane);
                u32x2 w; w.x = cvt_pk_bf16(v[0] * r * gg[0], v[1] * r * gg[1]); w.y = cvt_pk_bf16(v[2] * r * gg[2], v[3] * r * gg[3]);
                *(u32x2*)(ACAT + (size_t)s * DM + h * 256 + 4 * F.lane) = w; }
        }
    }
    SEAM(3);

    if (IN(4)) {
        pg8::Gemm g{ACAT, WPC, DM, DM, DM, nullptr}; pg8::StaticOrder So; So.init(S, DM, F.G, (int)blockIdx.x);
        pg8::EpiGateHook E{GB, MB};
        pg8::gemm_phase<pg8::EpiGateHook, pg8::StaticOrder, false, true>(F.lds + RING_OFF, g, So, E);
    }
    STAMP(9); if (IN(4) && IN(6)) xcd_barrier(bar); STAMP(10);

    if (IN(6)) {
        pg8::Gemm g{MB, WOUT, DM, DM, DM, nullptr};
        pg8::StaticOrder So; So.init(S, DM, F.G, (int)blockIdx.x);
        pg8::EpiZ E{X1B};
        pg8::gemm_phase<pg8::EpiZ, pg8::StaticOrder, false>(F.lds + RING_OFF, g, So, E);
    }
    SEAM(6);

    if (IN(7)) {
        FRESH();
        unsigned* ecnt = F.ctl + CW_ECNT + rep * 2048; int* LISTr = rep ? (int*)(ws + WS_H) : LIST; int* TOKr = rep ? (int*)(ws + WS_H + 2 * MiB) : TOKINFO; float* Zw = rep ? (float*)(ws + WS_Y) : Z; bf16_t* X1Bw = rep ? (bf16_t*)(ws + WS_Y + 64 * MiB) : X1B;
        LAS float* Wl = (LAS float*)F.lds;
        LAS float* Lw = (LAS float*)(F.lds + 81920) + F.wave * 128;
        LAS unsigned* lcnt = (LAS unsigned*)(F.lds + 90112); int* LOCALL = (int*)(ws + WS_LOCAL) + (size_t)F.vcu * 32 * 64; int* CNTT = (int*)(ws + WS_CNTT);
        if (F.tid < 32) lcnt[F.tid] = 0u;
        __syncthreads();
#pragma unroll 1
        for (int pr = 0; pr < 2; ++pr) {
            const int rowA = gw * 4 + 2 * pr;
            f32x4 xa[8], xb[8];
            {
                const u32x2* za = (const u32x2*)(XB + (size_t)rowA * DM) + F.lane; const u32x2* zb = za + DM / 4;
                const u32x2* ya = (const u32x2*)(X1B + (size_t)rowA * DM) + F.lane; const u32x2* yb = ya + DM / 4;
                float sa = 0.f, sb = 0.f;
#pragma unroll
                for (int j = 0; j < 8; ++j) { const u32x2 wa_ = ya[64 * j], wb_ = yb[64 * j], xa_ = za[64 * j], xb_ = zb[64 * j];
                    xa[j] = (f32x4){bf_lo(xa_.x), bf_hi(xa_.x), bf_lo(xa_.y), bf_hi(xa_.y)} * ALPHA + (f32x4){bf_lo(wa_.x), bf_hi(wa_.x), bf_lo(wa_.y), bf_hi(wa_.y)}; xb[j] = (f32x4){bf_lo(xb_.x), bf_hi(xb_.x), bf_lo(xb_.y), bf_hi(xb_.y)} * ALPHA + (f32x4){bf_lo(wb_.x), bf_hi(wb_.x), bf_lo(wb_.y), bf_hi(wb_.y)}; sa += (xa[j][0] + xa[j][1]) + (xa[j][2] + xa[j][3]); sb += (xb[j][0] + xb[j][1]) + (xb[j][2] + xb[j][3]); }
                const float ma = wave_sum(sa) * (1.f / DM), mb = wave_sum(sb) * (1.f / DM); float qa = 0.f, qb = 0.f;
#pragma unroll
                for (int j = 0; j < 8; ++j) { xa[j] = xa[j] - ma; xb[j] = xb[j] - mb; qa += (xa[j][0] * xa[j][0] + xa[j][1] * xa[j][1]) + (xa[j][2] * xa[j][2] + xa[j][3] * xa[j][3]);
                    qb += (xb[j][0] * xb[j][0] + xb[j][1] * xb[j][1]) + (xb[j][2] * xb[j][2] + xb[j][3] * xb[j][3]); }
                const float ra = rsqrtf(wave_sum(qa) * (1.f / DM) + LN_EPS), rb = rsqrtf(wave_sum(qb) * (1.f / DM) + LN_EPS);
                u32x2* ha = (u32x2*)(X1Bw + (size_t)rowA * DM) + F.lane; u32x2* hb = ha + DM / 4;
#pragma unroll
                for (int j = 0; j < 8; ++j) { const f32x4 gg = *((const f32x4*)ln1g + F.lane + 64 * j), bb = *((const f32x4*)ln1b + F.lane + 64 * j);
                    xa[j] = xa[j] * ra * gg + bb; xb[j] = xb[j] * rb * gg + bb;
                    u32x2 w; w.x = cvt_pk_bf16(xa[j][0], xa[j][1]); w.y = cvt_pk_bf16(xa[j][2], xa[j][3]); ha[64 * j] = w;
                    w.x = cvt_pk_bf16(xb[j][0], xb[j][1]); w.y = cvt_pk_bf16(xb[j][2], xb[j][3]); hb[64 * j] = w; }
            }
            typedef float f32x2p __attribute__((ext_vector_type(2)));
            float la[36], lb[36];
#pragma unroll
            for (int c = 0; c < 36; ++c) { la[c] = 0.f; lb[c] = 0.f; }
#define P7_STAGE(j, b) do { unsigned lo_ = (unsigned)F.lane * 16u; asm volatile("" : "+v"(lo_)); _Pragma("unroll") for (int n_ = 0; n_ < 5; ++n_) { const int c_ = F.wave + 8 * n_; if (c_ < 36) { \
        const char* ub_ = (const char*)(WRT + (size_t)c_ * DM + 256 * (j)); __builtin_amdgcn_global_load_lds((const unsigned*)(ub_ + lo_), (LAS unsigned*)(Wl + (b) * 9216 + c_ * 256), 16, 0, 0); } } } while (0)
#define P7_COMMIT(b) do { VM_WAIT(); } while (0)
            __syncthreads();
            P7_STAGE(0, 0); P7_COMMIT(0); __syncthreads();
#pragma unroll
            for (int j = 0; j < 8; ++j) {
                if (j + 1 < 8) P7_STAGE(j + 1, (j + 1) & 1);
                const LAS float* Wb = Wl + (j & 1) * 9216;
#pragma unroll
                for (int cg = 0; cg < 9; ++cg) { f32x4 w[4];
#pragma unroll
                    for (int q = 0; q < 4; ++q) w[q] = *(const LAS f32x4*)(Wb + (4 * cg + q) * 256 + 4 * F.lane);
                    asm volatile("" ::: "memory");
#pragma unroll
                    for (int q = 0; q < 4; ++q) { const int c = 4 * cg + q; f32x2p acc = {la[c], lb[c]};
#pragma unroll
                        for (int k = 3; k >= 0; --k) acc = __builtin_elementwise_fma((f32x2p){xa[j][k], xb[j][k]}, (f32x2p){w[q][k], w[q][k]}, acc);
                        la[c] = acc[0]; lb[c] = acc[1];
                        asm volatile("" : "+v"(la[c]), "+v"(lb[c])); }
                    asm volatile("" ::: "memory"); __builtin_amdgcn_sched_barrier(0); }
                if (j + 1 < 8) { P7_COMMIT((j + 1) & 1); __syncthreads(); }
                __builtin_amdgcn_sched_barrier(0);
            }
#undef P7_STAGE
#undef P7_COMMIT
#pragma unroll
            for (int c = 0; c < 36; ++c) { la[c] = wave_sum(la[c]); lb[c] = wave_sum(lb[c]); asm volatile("" : "+v"(la[c]), "+v"(lb[c])); }
            if (F.lane == 0) {
#pragma unroll
                for (int c = 0; c < 36; ++c) { const float bias = c < 4 ? brg[c] : bre[c - 4]; Lw[c] = la[c] + bias; Lw[64 + c] = lb[c] + bias; } }
            LDS_WAIT(); asm volatile("" ::: "memory");
            if (F.lane < 2) {
                const LAS float* L = Lw + 64 * F.lane; const int tok = rowA + F.lane;
                const f32x4 gl = *(const LAS f32x4*)L;
                int g = 0; float gm = gl[0];
#pragma unroll
                for (int c = 1; c < 4; ++c) { if (gl[c] > gm) { gm = gl[c]; g = c; } }
                float den = 0.f;
#pragma unroll
                for (int c = 0; c < 4; ++c) den += expf(gl[c] - gm);
                const float top_gp = 1.f / den;
                const f32x4 el0 = *(const LAS f32x4*)(L + 4 + g * 8), el1 = *(const LAS f32x4*)(L + 8 + g * 8);
                const float ev[8] = {el0[0], el0[1], el0[2], el0[3], el1[0], el1[1], el1[2], el1[3]};
                int e1 = 0; float l1 = ev[0];
#pragma unroll
                for (int e = 1; e < 8; ++e) { if (ev[e] > l1) { l1 = ev[e]; e1 = e; } }
                int e2 = 0; float l2 = -INFINITY;
#pragma unroll
                for (int e = 0; e < 8; ++e) { if (e != e1 && ev[e] > l2) { l2 = ev[e]; e2 = e; } }
                const float w1 = 1.f / (1.f + expf(l2 - l1));
                const int ea = g * 8 + e1, eb = g * 8 + e2;
                const int pa = (int)__hip_atomic_fetch_add(lcnt + ea, 1u, __ATOMIC_RELAXED, __HIP_MEMORY_SCOPE_WORKGROUP), pb = (int)__hip_atomic_fetch_add(lcnt + eb, 1u, __ATOMIC_RELAXED, __HIP_MEMORY_SCOPE_WORKGROUP);
                LOCALL[ea * 64 + pa] = tok; LOCALL[eb * 64 + pb] = tok;
                u32x4* ti = (u32x4*)(TOKr + (size_t)tok * 8); ti[0] = (u32x4){(unsigned)ea, (unsigned)pa, __float_as_uint(top_gp * w1), (unsigned)eb}; ti[1] = (u32x4){(unsigned)pb, __float_as_uint(top_gp * (1.f - w1)), 0u, 0u};
            }
            asm volatile("" ::: "memory");
        }
        __syncthreads();
        if (F.tid < 32) CNTT[F.tid * 256 + F.vcu] = (int)lcnt[F.tid];
    }
    SEAM(7);

    if (IN(8) || IN(9) || IN(10)) {
        FRESH();
        { const int* CNTT = (const int*)(ws + WS_CNTT); LAS unsigned short* pfx = (LAS unsigned short*)(F.lds + PFX_OFF); LAS int* part = (LAS int*)F.lds;
          const int e = F.tid >> 4, seg = F.tid & 15; int v[16]; int ssum = 0;
#pragma unroll
          for (int i = 0; i < 16; ++i) { v[i] = CNTT[e * 256 + seg * 16 + i]; ssum += v[i]; }
          part[F.tid] = ssum; __syncthreads();
          int base = 0; for (int q = 0; q < seg; ++q) base += part[e * 16 + q];
#pragma unroll
          for (int i = 0; i < 16; ++i) { pfx[e * 256 + seg * 16 + i] = (unsigned short)base; base += v[i]; }
          if (seg == 15) sm_cnt[e] = base; }
        __syncthreads();
        if (F.tid == 0) { int a = 0; for (int e = 0; e < NEXP; ++e) { sm_pre[e] = a; a += (sm_cnt[e] + 255) >> 8; } sm_pre[32] = a; }
        __syncthreads();
    }
    if (IN(8)) {
        FRESH();
        const int ntile = sm_pre[32], n8 = ntile * 4, n9 = ntile * 8, NB = 1024, total = n8 + NB + n9;
        unsigned* mq = F.ctl + CW_DQ; unsigned* tdone = F.ctl + CW_TD; unsigned* cdone = F.ctl + CW_CD;
        LAS float* scr = (LAS float*)(F.lds + F.wave * 16640); int sl = 0;
        for (;;) {
            if (F.tid == 0) F.MISC[20 + sl] = __hip_atomic_fetch_add(F.ctl + CW_BG, 1u, RLX_AGENT);
            __syncthreads(); const unsigned b = F.MISC[20 + sl]; sl ^= 1; if (b >= 2048u) break; BG_BATCH(b); }
        const int myx = (int)(bar.x & 7u); int stage = 0, sk = 0;
        for (;;) {
            if (F.tid == 0) { unsigned code = 3u << 28;
                for (;;) {
                    if (stage == 1) { const unsigned b = __hip_atomic_fetch_add(mq, 1u, RLX_AGENT); if (b < 1024u) { code = (1u << 28) | b; break; } stage = 2; sk = 0; continue; }
                    if (sk > 7) { if (stage == 0) { stage = 1; continue; } break; }
                    const int y = (myx + sk) & 7, tb = sm_pre[4 * y], nj = (sm_pre[4 * y + 4] - tb) * 4;
                    const int v = (int)__hip_atomic_fetch_add(F.ctl + (stage == 0 ? CW_MQ8 : CW_MQ9) + 64 * y, 1u, RLX_AGENT);
                    if (v < nj) { code = (stage == 0 ? 0u : (2u << 28)) | (unsigned)(tb * 4 + v); break; }
                    ++sk; }
                F.MISC[20 + sl] = code; }
            __syncthreads(); const unsigned code = F.MISC[20 + sl]; sl ^= 1; const int kind = (int)(code >> 28), q = (int)(code & 0xFFFFFFFu);
            if (kind == 3) break;
            if (kind == 0) {
                const int mtile = q >> 2, nt4 = q & 3; int e = 0;
                for (int k = 1; k < NEXP; ++k) if (sm_pre[k] <= mtile) e = k;
                const int mt = mtile - sm_pre[e], cnt = sm_cnt[e];
                if (F.tid < 256) { int r = mt * 256 + F.tid; r = r < cnt ? r : cnt - 1;
                    const LAS unsigned short* pe = (const LAS unsigned short*)(F.lds + PFX_OFF) + e * 256; int c = 0;
#pragma unroll
                    for (int st = 128; st >= 1; st >>= 1) if ((int)pe[c + st] <= r) c += st;
                    sm_rowidx[F.tid] = ((const int*)(ws + WS_LOCAL))[((size_t)c * 32 + e) * 64 + (r - (int)pe[c])]; }
                if (F.tid == 0) { XB_SPIN(__hip_atomic_load(F.ctl + CW_GD + e, RLX_AGENT) < 64u, F.ctl + CW_BAR); __builtin_amdgcn_fence(__ATOMIC_ACQUIRE, "agent"); }
                __syncthreads();
                pg8::Gemm g{X1B, WGU + (size_t)e * 1024 * DM, DM, DM, DM, sm_rowidx}; pg8::SingleUnit Su{{mtile, nt4}};
                pg8::EpiSwiGLU E{HB};
                pg8::gemm_phase<pg8::EpiSwiGLU, pg8::SingleUnit, true>(F.lds + RING_OFF, g, Su, E);
                VM_WAIT(); __syncthreads();
                if (F.tid == 0) (void)__hip_atomic_fetch_add(tdone + mtile, 1u, RLX_AGENT);
            } else if (kind == 1) {
                const int r = q * 8 + F.wave, e = r >> 8, qq = r & 255;
                tr_item<RmId, true>(wdown + (size_t)e * FF * DM, DM, 64 * (qq >> 5), 64 * (qq & 31), WD + (size_t)e * DM * FF, FF, 0, RmId{}, scr, F.lane);
                VM_WAIT(); __syncthreads();
                if (F.tid == 0) (void)__hip_atomic_fetch_add(cdone + e, 1u, RLX_AGENT);
            } else {
                const int u = q, mtile = u >> 2; int e = 0;
                for (int k = 1; k < NEXP; ++k) if (sm_pre[k] <= mtile) e = k;
                if (F.tid == 0) {
                    XB_SPIN(__hip_atomic_load(tdone + mtile, RLX_AGENT) < 4u || __hip_atomic_load(cdone + e, RLX_AGENT) < 32u, F.ctl + CW_BAR);
                    __builtin_amdgcn_fence(__ATOMIC_ACQUIRE, "agent");
                }
                __syncthreads();
                pg8::Gemm g{HB, WD, FF, FF, FF, nullptr}; pg8::UnitRun Su{{mtile, e * 8 + (u & 3) * 2}, 2}; pg8::EpiY E{YB};
                pg8::gemm_phase<pg8::EpiY, pg8::UnitRun, false>(F.lds + RING_OFF, g, Su, E);
            }
        }
    }
    STAMP(17); STAMP(18); STAMP(19);
    if (IN(8) && IN(10)) xcd_barrier(bar);
    STAMP(20);

    if (IN(10)) {
        FRESH();
        float* out = args.out;
        const LAS unsigned short* pfx = (const LAS unsigned short*)(F.lds + PFX_OFF);
        for (int m0 = gw; m0 < S; m0 += 4 * NGW) {
            u32x4 t0[4], t1[4];
#pragma unroll
            for (int u = 0; u < 4; ++u) { const int m = m0 + u * NGW < S ? m0 + u * NGW : m0; const u32x4* ti = (const u32x4*)(TOKINFO + (size_t)m * 8); t0[u] = ti[0]; t1[u] = ti[1]; }
            u32x2 rx[2][8], ry[2][8], rz[2][8];
#define P10_LOAD(bf, u) do { const int m = m0 + (u) * NGW < S ? m0 + (u) * NGW : m0; const int cw = m >> 5;         \
            const int ea = (int)t0[u].x, eb = (int)t0[u].w, pa = (int)t0[u].y + (int)pfx[ea * 256 + cw], pb = (int)t1[u].x + (int)pfx[eb * 256 + cw];                \
            const size_t ra = (size_t)sm_pre[ea] * 256 + pa, rb = (size_t)sm_pre[eb] * 256 + pb;                                                                          \
            const u32x2* xr = (const u32x2*)(X1B + (size_t)m * DM) + F.lane; const u32x2* ya = (const u32x2*)(YB + ra * DM) + F.lane; const u32x2* yb = (const u32x2*)(YB + rb * DM) + F.lane; \
            _Pragma("unroll") for (int j = 0; j < 8; ++j) { rx[bf][j] = xr[64 * j]; ry[bf][j] = ya[64 * j]; rz[bf][j] = yb[64 * j]; } } while (0)
#define P10_DO(bf, u) do { const int m = m0 + (u) * NGW; if (m < S) { const float wa = __uint_as_float(t0[u].z), wb = __uint_as_float(t1[u].y);                             \
            f32x4 v[8]; float s = 0.f;                                                                                                                                      \
            _Pragma("unroll") for (int j = 0; j < 8; ++j) { const u32x2 xw = rx[bf][j], a = ry[bf][j], b = rz[bf][j]; const f32x4 xv = {bf_lo(xw.x), bf_hi(xw.x), bf_lo(xw.y), bf_hi(xw.y)}; \
                const f32x4 fa = {bf_lo(a.x), bf_hi(a.x), bf_lo(a.y), bf_hi(a.y)}, fb = {bf_lo(b.x), bf_hi(b.x), bf_lo(b.y), bf_hi(b.y)};                               \
                v[j] = xv * ALPHA + fa * wa + fb * wb; s += (v[j][0] + v[j][1]) + (v[j][2] + v[j][3]); }                                                                    \
            const float mean = wave_sum(s) * (1.f / DM); float q = 0.f;                                                                                                     \
            _Pragma("unroll") for (int j = 0; j < 8; ++j) { v[j] = v[j] - mean; q += (v[j][0] * v[j][0] + v[j][1] * v[j][1]) + (v[j][2] * v[j][2] + v[j][3] * v[j][3]); }  \
            const float rstd = rsqrtf(wave_sum(q) * (1.f / DM) + LN_EPS);                                                                                                   \
            f32x4* o = (f32x4*)(out + (size_t)m * DM) + F.lane;                                                                                                            \
            _Pragma("unroll") for (int j = 0; j < 8; ++j) { const f32x4 gg = *((const f32x4*)ln2g + F.lane + 64 * j), bb = *((const f32x4*)ln2b + F.lane + 64 * j); o[64 * j] = v[j] * rstd * gg + bb; } } } while (0)
            P10_LOAD(0, 0); P10_LOAD(1, 1); P10_DO(0, 0); P10_LOAD(0, 2); P10_DO(1, 1); P10_LOAD(1, 3); P10_DO(0, 2); P10_DO(1, 3);
#undef P10_LOAD
#undef P10_DO
        }
    }
    STAMP(21);
#if PROBE_SEL >= 0
    xcd_barrier(bar);
    if (blockIdx.x == 0) {
        FRESH();
        const unsigned long long* SB = (const unsigned long long*)(ws + WS_CTL + 512 * KiB);
        LAS int* red = (LAS int*)(F.lds + RING_OFF);
        const int c = F.tid & 255;
#define S_of(j) ((j) < 6 ? 2 * (j) : 2 * (j) + 2)
#define E_of(j) ((j) < 5 ? 2 * (j) + 1 : 2 * (j) + 3)
        const unsigned long long t00 = SB[0];
        long long metric = 0;
#define REDUCE(expr, AVG, MAX) do { __syncthreads(); if (F.tid < 256) red[F.tid] = (int)(expr); __syncthreads(); long long a_ = 0; int m_ = -2000000000; for (int i_ = 0; i_ < 256; ++i_) { a_ += red[i_]; m_ = red[i_] > m_ ? red[i_] : m_; } AVG = (int)(a_ / 256); MAX = m_; } while (0)
#define ST(i) ((long long)(SB[(size_t)c * 32 + (i)] - t00))
        int av, mx, av2, mx2;
        if (PROBE_SEL == 1) { for (int j = 0; j < 10; ++j) { REDUCE(ST(E_of(j)), av, mx); metric += mx - av; } }
        else if (PROBE_SEL == 2) { for (int j = 0; j < 9; ++j) { REDUCE(ST(E_of(j)), av, mx); REDUCE(ST(S_of(j + 1)), av2, mx2); metric += av2 - mx; } }
        else if (PROBE_SEL >= 10 && PROBE_SEL < 20) { const int j = PROBE_SEL - 10; REDUCE(ST(E_of(j)) - ST(S_of(j)), av, mx); metric = av; }
        else if (PROBE_SEL >= 30 && PROBE_SEL < 40) { const int j = PROBE_SEL - 30; REDUCE(ST(E_of(j)), av, mx); metric = mx - av; }
        else if (PROBE_SEL == 50) { REDUCE(ST(22) - ST(4), av, mx); metric = av; }
        else if (PROBE_SEL == 51) { REDUCE(ST(5) - ST(22), av, mx); metric = av; }
        else if (PROBE_SEL == 52) { REDUCE(ST(17) - ST(23), av, mx); metric = av; }
        else if (PROBE_SEL == 53) { REDUCE(ST(22), av, mx); metric = mx - av; }
        else if (PROBE_SEL == 54) { REDUCE(-ST(22), av, mx); metric = mx - av; }
        else if (PROBE_SEL == 55) { REDUCE(ST(22), av, mx); const int thr_ = av + 3000; REDUCE(ST(22) > thr_ ? 25600 : 0, av2, mx2); metric = av2; }
        else if (PROBE_SEL == 57) { REDUCE((ST(24) - ST(4)) * 100 / (long long)SB[(size_t)c * 32 + 25], av, mx); metric = av; }
        else if (PROBE_SEL == 58) { REDUCE((ST(24) - ST(4)) * 100 / (long long)SB[(size_t)c * 32 + 25], av, mx); metric = mx; }
        else if (PROBE_SEL == 59) { REDUCE(-((ST(24) - ST(4)) * 100 / (long long)SB[(size_t)c * 32 + 25]), av, mx); metric = -mx; }
        else if (PROBE_SEL == 61) { REDUCE(SB[(size_t)c * 32 + 26] ? (ST(26) - ST(24)) * 100 / (long long)SB[(size_t)c * 32 + 27] : 200, av, mx); metric = av; }
        else if (PROBE_SEL == 62) { REDUCE(SB[(size_t)c * 32 + 26] ? (ST(26) - ST(24)) * 100 / (long long)SB[(size_t)c * 32 + 27] : 200, av, mx); metric = mx; }
        else if (PROBE_SEL == 63) { REDUCE(SB[(size_t)c * 32 + 26] && SB[(size_t)c * 32 + 27] > 40 ? (ST(26) - ST(24)) * 100 / (long long)SB[(size_t)c * 32 + 27] : 0, av, mx); REDUCE(SB[(size_t)c * 32 + 26] && SB[(size_t)c * 32 + 27] > 40 ? 256 : 0, av2, mx2); metric = av2 > 0 ? (long long)av * 256 / av2 : 0; }
        else if (PROBE_SEL == 60) { metric = 10000; }
#undef REDUCE
#undef ST
        if (metric < 0) metric = 0;
        if (F.tid == 0) { const unsigned long long t1 = __builtin_amdgcn_s_memrealtime(); while ((long long)(__builtin_amdgcn_s_memrealtime() - t1) < metric * PROBE_AMP) __builtin_amdgcn_s_sleep(8); }
        __syncthreads();
    }
#endif
#undef IN
#undef SEAM
#undef gw
#undef FRESH
}

extern "C" void kernel_launch(void* const* d_in, const int* in_sizes, int n_in, void* d_out, int out_size, void* d_ws, size_t ws_size, hipStream_t stream) {
    static int grid = 0;
    if (grid == 0) {
        if (n_in != 22 || in_sizes[0] != S * DM || in_sizes[1] != DM * INC || out_size != S * DM || ws_size < WS_END) {
            fprintf(stderr, "kernel_launch: unexpected shapes (n_in %d, in0 %d, out %d, ws %zu); nothing launched\n", n_in, n_in > 0 ? in_sizes[0] : -1, out_size, ws_size); grid = -1; return; }
        int dev = 0, cus = 0, per_cu = 0;
        if (hipGetDevice(&dev) != hipSuccess || hipDeviceGetAttribute(&cus, hipDeviceAttributeMultiprocessorCount, dev) != hipSuccess) { fprintf(stderr, "kernel_launch: device query failed\n"); grid = -1; return; }
        if (hipFuncSetAttribute((const void*)mk_fwd, hipFuncAttributeMaxDynamicSharedMemorySize, LDS_BYTES) != hipSuccess) { fprintf(stderr, "kernel_launch: hipFuncSetAttribute failed\n"); grid = -1; return; }
        if (hipOccupancyMaxActiveBlocksPerMultiprocessor(&per_cu, (const void*)mk_fwd, NWAVES * 64, LDS_BYTES) != hipSuccess || per_cu < 1) fprintf(stderr, "kernel_launch: occupancy query reports %d\n", per_cu);
        (void)hipGetLastError();
        grid = cus;
        if (grid != 256) fprintf(stderr, "kernel_launch: %d CUs; this build assumes 256\n", grid);
    }
    if (grid < 0) return;
    (void)hipMemsetAsync((char*)d_ws + WS_CTL, 0, CTL_ZERO_BYTES, stream);
    Args a{};
    for (int i = 0; i < 22; ++i) a.in[i] = (const float*)d_in[i];
    a.out = (float*)d_out; a.ws = (unsigned char*)d_ws;
    if (MK_N_LAUNCHES == 1) { a.ph_lo = 0; a.ph_hi = NPHASE; hipLaunchKernelGGL(mk_fwd, dim3(grid), dim3(NWAVES * 64), LDS_BYTES, stream, a); }
    else { for (int p = 0; p < NPHASE; ++p) { a.ph_lo = p; a.ph_hi = p + 1; hipLaunchKernelGGL(mk_fwd, dim3(grid), dim3(NWAVES * 64), LDS_BYTES, stream, a); } }
}
```
